# Optimizing an MI355X kernel written in HIP

```python
import math
import jax
import jax.numpy as jnp
from jax import lax
import numpy as np

D_MODEL = 1024
BATCH = 8
SEQ = 2048
DEPTH = 4
DEC_BATCH = 128
DEC_SEQ = 4
PAST_LEN = 2048
PAGE_SIZE = 128

HEAD_DIM = 64
A_GROUPS = 4
A_WIDTH = A_GROUPS * HEAD_DIM
A_CONV = 3
B_HEADS = 6
B_DK = HEAD_DIM
B_DV = HEAD_DIM
B_WIDTH = B_HEADS * B_DV
B_QKV = 2 * B_HEADS * B_DK + B_WIDTH
B_CONV = 4
GDN_CHUNK = 64
C_PAIRS = ((128, 1), (512, 4), (2048, 16))
C_HPG = 2
C_HEADS = len(C_PAIRS) * C_HPG
C_WIDTH = C_HEADS * HEAD_DIM
ATTN_BLOCK = 128
ROT_DIM = HEAD_DIM // 4
ROPE_THETA = 500000.0
MIX_WIDTH = A_WIDTH + B_WIDTH + C_WIDTH
EPS = 1e-6
NEG = -1e30
IN_SPLITS = (A_WIDTH, A_WIDTH, A_WIDTH, A_WIDTH,
             B_HEADS * B_DK, B_HEADS * B_DK, B_WIDTH, B_WIDTH, B_HEADS, B_HEADS,
             C_WIDTH, C_WIDTH, C_WIDTH, C_WIDTH)
IN_WIDTH = sum(IN_SPLITS)

kernel_name = 'hybrid_conv_deltanet_dilated_step'


def rmsnorm(x, w):
    xf = x.astype(jnp.float32)
    y = xf * lax.rsqrt(jnp.mean(xf * xf, axis=-1, keepdims=True) + EPS) * w.astype(jnp.float32)
    return y.astype(x.dtype)


def l2norm(x):
    return x * lax.rsqrt(jnp.sum(x * x, axis=-1, keepdims=True) + 1e-6)


def split_cols(u):
    out, start = [], 0
    for n in IN_SPLITS:
        out.append(u[..., start:start + n])
        start += n
    return out


def partial_rope(x, pos):
    half = ROT_DIM // 2
    inv_freq = ROPE_THETA ** (-jnp.arange(half, dtype=jnp.float32) * (2.0 / ROT_DIM))
    ang = pos.astype(jnp.float32)[:, None] * inv_freq[None, :]
    cos = jnp.cos(ang)[None, :, None, :]
    sin = jnp.sin(ang)[None, :, None, :]
    xf = x.astype(jnp.float32)
    x1, x2, rest = xf[..., :half], xf[..., half:ROT_DIM], xf[..., ROT_DIM:]
    return jnp.concatenate([x1 * cos - x2 * sin, x2 * cos + x1 * sin, rest], axis=-1).astype(x.dtype)


def causal_dwconv(x, buf, w):
    k_w = w.shape[0]
    t = x.shape[1]
    xp = jnp.concatenate([buf.astype(x.dtype), x], axis=1)
    y = xp[:, 0:t] * w[0]
    for j in range(1, k_w):
        y = y + xp[:, j:j + t] * w[j]
    return y, xp[:, -(k_w - 1):]


def gated_delta_rule(q, k, v, g, beta, s0):
    bsz, t, h, dk = k.shape
    dv = v.shape[-1]
    c = min(GDN_CHUNK, t)
    n = -(-t // c)
    pad = n * c - t

    def chunks(a):
        a = jnp.pad(a, [(0, 0), (0, pad)] + [(0, 0)] * (a.ndim - 2))
        a = a.reshape((bsz, n, c) + a.shape[2:])
        return jnp.moveaxis(a, 3, 1)

    qc, kc, vc, gc, bc = chunks(q), chunks(k), chunks(v), chunks(g), chunks(beta)
    gcum = jnp.cumsum(gc, axis=-1)
    tri = jnp.tril(jnp.ones((c, c), bool))
    strict = jnp.tril(jnp.ones((c, c), bool), -1)
    diff = gcum[..., :, None] - gcum[..., None, :]
    decay = jnp.where(tri, jnp.exp(jnp.where(tri, diff, 0.0)), 0.0)
    kb = kc * bc[..., None]
    lmat = jnp.where(strict, jnp.einsum('bhnid,bhnjd->bhnij', kb, kc) * decay, 0.0)
    eye = jnp.eye(c, dtype=jnp.float32)
    tinv = lax.linalg.triangular_solve(lmat + eye, jnp.broadcast_to(eye, lmat.shape),
                                       left_side=True, lower=True)
    u = tinv @ (vc * bc[..., None])
    w = tinv @ (kb * jnp.exp(gcum)[..., None])
    a_intra = jnp.einsum('bhnid,bhnjd->bhnij', qc, kc) * decay

    def step(s, xs):
        q_i, k_i, u_i, w_i, a_i, g_i = xs
        v_new = u_i - w_i @ s
        o = (q_i * jnp.exp(g_i)[..., None]) @ s + a_i @ v_new
        g_last = g_i[..., -1]
        s = s * jnp.exp(g_last)[..., None, None] + jnp.einsum(
            'bhcd,bhce->bhde', k_i * jnp.exp(g_last[..., None] - g_i)[..., None], v_new)
        return s, o

    xs = tuple(jnp.moveaxis(a, 2, 0) for a in (qc, kc, u, w, a_intra, gcum))
    s_fin, o = lax.scan(step, s0.astype(jnp.float32), xs)
    o = o.transpose(1, 0, 3, 2, 4).reshape(bsz, n * c, h, dv)[:, :t]
    return o, s_fin


def dilated_band_attention(q, k, v, dil, taps):
    bsz, t, h, d = q.shape
    ls = t // dil
    nb = -(-ls // ATTN_BLOCK)
    pad = nb * ATTN_BLOCK - ls

    def streams(a):
        a = a.reshape(bsz, ls, dil, h, d).transpose(0, 2, 1, 3, 4)
        a = jnp.pad(a, ((0, 0), (0, 0), (0, pad), (0, 0), (0, 0)))
        return a.reshape(bsz, dil, nb, ATTN_BLOCK, h, d).astype(jnp.float32)

    def with_prev(a):
        prev = jnp.pad(a[:, :, :-1], ((0, 0), (0, 0), (1, 0), (0, 0), (0, 0), (0, 0)))
        return jnp.concatenate([prev, a], axis=3)

    qs = streams(q)
    kk, vv = with_prev(streams(k)), with_prev(streams(v))
    s = jnp.einsum('brnqhd,brnkhd->brnqhk', qs, kk) * (HEAD_DIM ** -0.5)
    qi = jnp.arange(ATTN_BLOCK)[:, None]
    kj = jnp.arange(2 * ATTN_BLOCK)[None, :]
    dist = ATTN_BLOCK + qi - kj
    band = (dist >= 0) & (dist <= taps)
    blk = jnp.arange(nb)[:, None, None]
    valid = band[None] & ((blk > 0) | (kj >= ATTN_BLOCK)[None])
    s = jnp.where(valid[None, None, :, :, None, :], s, NEG)
    m = jnp.max(s, axis=-1, keepdims=True)
    p = jnp.exp(s - m)
    den = jnp.sum(p, axis=-1)
    o = jnp.einsum('brnqhk,brnkhd->brnqhd', p, vv) / den[..., None]
    lse = m[..., 0] + jnp.log(den)
    o = o.reshape(bsz, dil, nb * ATTN_BLOCK, h, d)[:, :, :ls].transpose(0, 2, 1, 3, 4).reshape(bsz, t, h, d)
    lse = lse.reshape(bsz, dil, nb * ATTN_BLOCK, h)[:, :, :ls].transpose(0, 2, 1, 3).reshape(bsz, t, h)
    return o, lse


def dilated_gather_attention(q, k, v, buf, dil, taps):
    bsz, td, h, d = q.shape
    lb = buf.shape[1]
    rel = jnp.arange(td)[:, None] - jnp.arange(taps + 1)[None, :] * dil
    in_new = rel >= 0
    idx_b = lb + rel
    valid = in_new | (idx_b >= 0)
    past = buf[:, jnp.clip(idx_b, 0, lb - 1)]
    ridx = jnp.clip(rel, 0, td - 1)
    sel = in_new[None, :, :, None, None]
    keys = jnp.where(sel, k[:, ridx], past[:, :, :, 0].astype(k.dtype)).astype(jnp.float32)
    vals = jnp.where(sel, v[:, ridx], past[:, :, :, 1].astype(v.dtype)).astype(jnp.float32)
    s = jnp.einsum('bqhd,bqkhd->bqhk', q.astype(jnp.float32), keys) * (HEAD_DIM ** -0.5)
    s = jnp.where(valid[None, :, None, :], s, NEG)
    m = jnp.max(s, axis=-1, keepdims=True)
    p = jnp.exp(s - m)
    den = jnp.sum(p, axis=-1)
    o = jnp.einsum('bqhk,bqkhd->bqhd', p, vals) / den[..., None]
    lse = m[..., 0] + jnp.log(den)
    return o, lse


def mixer_sublayer(hn, pos, buf_a, buf_b, s0, kv_bufs, w_in_l, w_out_l, conv_a_w_l, conv_b_w_l,
                   a_log_l, dt_bias_l, gdn_norm_w_l):
    bsz, t, _ = hn.shape
    u = hn @ w_in_l
    (a_x, a_cg, a_bg, a_z, b_q, b_k, b_v, b_z, b_a, b_b, c_q, c_k, c_v, c_z) = split_cols(u)

    a_conv, buf_a_new = causal_dwconv(a_cg * a_x, buf_a, conv_a_w_l)
    y_a = a_bg * a_conv * jax.nn.silu(a_z)

    qkv, buf_b_new = causal_dwconv(jnp.concatenate([b_q, b_k, b_v], axis=-1), buf_b, conv_b_w_l)
    qkv = jax.nn.silu(qkv).astype(jnp.float32)
    nqk = B_HEADS * B_DK
    gq = l2norm(qkv[..., :nqk].reshape(bsz, t, B_HEADS, B_DK)) * (B_DK ** -0.5)
    gk = l2norm(qkv[..., nqk:2 * nqk].reshape(bsz, t, B_HEADS, B_DK))
    gv = qkv[..., 2 * nqk:].reshape(bsz, t, B_HEADS, B_DV)
    g = -jnp.exp(a_log_l.astype(jnp.float32)) * jax.nn.softplus(
        b_a.astype(jnp.float32) + dt_bias_l.astype(jnp.float32))
    beta = jax.nn.sigmoid(b_b.astype(jnp.float32))
    o_b, s_new = gated_delta_rule(gq, gk, gv, g, beta, s0)
    y_b = rmsnorm(o_b, gdn_norm_w_l).reshape(bsz, t, B_WIDTH).astype(hn.dtype) * jax.nn.silu(b_z)

    cq = partial_rope(c_q.reshape(bsz, t, C_HEADS, HEAD_DIM), pos)
    ck = partial_rope(c_k.reshape(bsz, t, C_HEADS, HEAD_DIM), pos)
    cv = c_v.reshape(bsz, t, C_HEADS, HEAD_DIM)
    outs, lses, kv_new = [], [], []
    for gi, (win, dil) in enumerate(C_PAIRS):
        taps = win // dil
        qg = cq[:, :, gi * C_HPG:(gi + 1) * C_HPG]
        kg = ck[:, :, gi * C_HPG:(gi + 1) * C_HPG]
        vg = cv[:, :, gi * C_HPG:(gi + 1) * C_HPG]
        kv_rows = jnp.stack([kg, vg], axis=2)
        if kv_bufs is None:
            o, lse = dilated_band_attention(qg, kg, vg, dil, taps)
            kv_new.append(kv_rows[:, -min(win, t):])
        else:
            o, lse = dilated_gather_attention(qg, kg, vg, kv_bufs[gi], dil, taps)
            kv_new.append(kv_rows)
        outs.append(o)
        lses.append(lse)
    alpha = jax.nn.softmax(jnp.stack(lses, axis=2), axis=2)
    o_c = (jnp.stack(outs, axis=2) * alpha[..., None]).reshape(bsz, t, C_WIDTH).astype(hn.dtype)
    y_c = o_c * jax.nn.silu(c_z)

    mix = jnp.concatenate([y_a, y_b, y_c], axis=-1)
    return mix @ w_out_l, buf_a_new, buf_b_new, s_new, kv_new


def trunk(x, c, pos, conv_a_state, conv_b_state, gdn_state, kv_caches, w_in, w_out, w_ada, b_ada,
          norm_w, conv_a_w, conv_b_w, a_log, dt_bias, gdn_norm_w, final_norm_w, w_ada_final, b_ada_final):
    bsz = x.shape[0]
    new_a, new_b, new_g = [], [], []
    new_kv = [[] for _ in C_PAIRS]
    for l in range(DEPTH):
        if conv_a_state is None:
            buf_a = jnp.zeros((bsz, A_CONV - 1, A_WIDTH), x.dtype)
            buf_b = jnp.zeros((bsz, B_CONV - 1, B_QKV), x.dtype)
            s0 = jnp.zeros((bsz, B_HEADS, B_DK, B_DV), jnp.float32)
            kv_bufs = None
        else:
            buf_a = conv_a_state[l]
            buf_b = conv_b_state[l]
            s0 = gdn_state[l]
            kv_bufs = tuple(cc[l] for cc in kv_caches)
        shift, scale, gate = jnp.split(c @ w_ada[l] + b_ada[l], 3, axis=-1)
        hn = rmsnorm(x, norm_w[l]) * (1 + scale[:, None]) + shift[:, None]
        out, buf_a, buf_b, s_new, kv_rows = mixer_sublayer(
            hn, pos, buf_a, buf_b, s0, kv_bufs, w_in[l], w_out[l], conv_a_w[l], conv_b_w[l],
            a_log[l], dt_bias[l], gdn_norm_w[l])
        x = x + (1 + gate[:, None]) * out
        new_a.append(buf_a)
        new_b.append(buf_b)
        new_g.append(s_new)
        for gi in range(len(C_PAIRS)):
            new_kv[gi].append(kv_rows[gi])
    shift, scale = jnp.split(c @ w_ada_final + b_ada_final, 2, axis=-1)
    y = rmsnorm(x, final_norm_w) * (1 + scale[:, None]) + shift[:, None]
    return (y, jnp.stack(new_a), jnp.stack(new_b), jnp.stack(new_g),
            [jnp.stack(r) for r in new_kv])


def setup_inputs(seed: int = 0) -> dict:
    key = jax.random.key(seed)
    ks = jax.random.split(key, 24)
    f32 = jnp.float32

    def nrm(k, shape, s):
        return jax.random.normal(k, shape, f32) * s

    def kv(k, win):
        return nrm(k, (DEPTH, DEC_BATCH, min(win, PAST_LEN), 2, C_HPG, HEAD_DIM), 1.0)

    dt = jnp.exp(jax.random.uniform(ks[18], (DEPTH, B_HEADS), f32, math.log(1e-3), math.log(1e-1)))
    return {
        'x_prompt': nrm(ks[0], (BATCH, SEQ, D_MODEL), 1.0),
        'x_sample': nrm(ks[1], (DEC_BATCH, DEC_SEQ, D_MODEL), 1.0),
        'state_conv_a': nrm(ks[2], (DEPTH, DEC_BATCH, A_CONV - 1, A_WIDTH), 1.0),
        'state_conv_b': nrm(ks[3], (DEPTH, DEC_BATCH, B_CONV - 1, B_QKV), 1.0),
        'state_gdn': nrm(ks[4], (DEPTH, DEC_BATCH, B_HEADS, B_DK, B_DV), 0.1),
        'cache_kv_w128': kv(ks[5], C_PAIRS[0][0]),
        'cache_kv_w512': kv(ks[6], C_PAIRS[1][0]),
        'cache_kv_w2048': kv(ks[7], C_PAIRS[2][0]),
        'c_prompt': nrm(ks[8], (BATCH, D_MODEL), 1.0),
        'c_sample': nrm(ks[9], (DEC_BATCH, D_MODEL), 1.0),
        'w_in': nrm(ks[10], (DEPTH, D_MODEL, IN_WIDTH), D_MODEL ** -0.5),
        'w_out': nrm(ks[11], (DEPTH, MIX_WIDTH, D_MODEL), MIX_WIDTH ** -0.5),
        'w_ada': nrm(ks[12], (DEPTH, D_MODEL, 3 * D_MODEL), 0.1 * D_MODEL ** -0.5),
        'b_ada': nrm(ks[13], (DEPTH, 3 * D_MODEL), 0.01),
        'norm_w': 1.0 + nrm(ks[14], (DEPTH, D_MODEL), 0.02),
        'conv_a_w': nrm(ks[15], (DEPTH, A_CONV, A_WIDTH), A_CONV ** -0.5),
        'conv_b_w': nrm(ks[16], (DEPTH, B_CONV, B_QKV), B_CONV ** -0.5),
        'a_log': jnp.log(jax.random.uniform(ks[17], (DEPTH, B_HEADS), f32, 1.0, 16.0)),
        'dt_bias': dt + jnp.log(-jnp.expm1(-dt)),
        'gdn_norm_w': 1.0 + nrm(ks[19], (DEPTH, B_DV), 0.02),
        'final_norm_w': 1.0 + nrm(ks[20], (D_MODEL,), 0.02),
        'w_ada_final': nrm(ks[21], (D_MODEL, 2 * D_MODEL), 0.1 * D_MODEL ** -0.5),
        'b_ada_final': nrm(ks[22], (2 * D_MODEL,), 0.01),
    }


def reference(x_prompt, x_sample, state_conv_a, state_conv_b, state_gdn, cache_kv_w128, cache_kv_w512,
              cache_kv_w2048, c_prompt, c_sample, w_in, w_out, w_ada, b_ada, norm_w, conv_a_w, conv_b_w,
              a_log, dt_bias, gdn_norm_w, final_norm_w, w_ada_final, b_ada_final):
    pos_p = jnp.arange(x_prompt.shape[1])
    y_prompt, ca_p, cb_p, g_p, kv_p = trunk(
        x_prompt, c_prompt, pos_p, None, None, None, None, w_in, w_out, w_ada, b_ada, norm_w,
        conv_a_w, conv_b_w, a_log, dt_bias, gdn_norm_w, final_norm_w, w_ada_final, b_ada_final)
    pos_s = PAST_LEN + jnp.arange(x_sample.shape[1])
    y_sample, ca_s, cb_s, g_s, kv_s = trunk(
        x_sample, c_sample, pos_s, state_conv_a, state_conv_b, state_gdn,
        (cache_kv_w128, cache_kv_w512, cache_kv_w2048), w_in, w_out, w_ada, b_ada, norm_w,
        conv_a_w, conv_b_w, a_log, dt_bias, gdn_norm_w, final_norm_w, w_ada_final, b_ada_final)
    return (y_prompt, y_sample, ca_p, ca_s, cb_p, cb_s, g_p, g_s,
            kv_p[0], kv_s[0], kv_p[1], kv_s[1], kv_p[2], kv_s[2])
```

```cpp
#include <hip/hip_runtime.h>
#include <cstdio>
#include <cstdint>
namespace pg8 {
#define PG8_LAS __attribute__((address_space(3)))
typedef unsigned short bf16_t;
typedef short bf16x8 __attribute__((ext_vector_type(8)));
typedef float f32x4 __attribute__((ext_vector_type(4)));
typedef unsigned u32x4 __attribute__((ext_vector_type(4)));
constexpr int BM = 256, BK = 64, HALF = 128, HTB = HALF * BK * 2  , STAGE_BYTES = 8 * HTB, NXCD = 8, WGM = 8;

__host__ __device__ __forceinline__ int lds_byte(int r, int c) { const int st = (r >> 4) * 2 + (c >> 5), rr = r & 15, cc = c & 31, ob = rr * 64 + cc * 2; return st * 1024 + (ob ^ (((ob >> 9) & 1) << 5)); }
__host__ __device__ __forceinline__ void stage_rc(int b, int& R, int& C) { const int st = b / 1024, sb = b % 1024, swz = sb ^ (((sb >> 9) & 1) << 5); R = (st >> 1) * 16 + swz / 64; C = (st & 1) * 32 + (swz % 64) / 2; }
__host__ __device__ __forceinline__ int perm32(int rho) { const int n = rho >> 4, i = rho & 15; return 8 * (i >> 2) + 4 * n + (i & 3); }

struct Unit { int pm, pn; };
struct Gemm { const bf16_t* A; const bf16_t* Bt; int M, N, K; };

struct StaticOrder {
    int nM, nN, nwg, G, c;
    __host__ __device__ void init(int M, int N, int G_, int c_) { nM = M / BM; nN = N / BM; nwg = nM * nN; G = G_; c = c_; }
    __host__ __device__ bool next(int i, Unit& u) const {
        const long L = (long)i * G + c; if (L >= nwg) return false;
        int wgid = (int)L; { const int q = nwg / NXCD, r = nwg % NXCD, xcd = wgid % NXCD, off = wgid / NXCD; wgid = (xcd < r ? xcd * (q + 1) : r * (q + 1) + (xcd - r) * q) + off; }
        const int nig = WGM * nN, gid = wgid / nig, fm = gid * WGM, gsz = (nM - fm) < WGM ? (nM - fm) : WGM;
        u.pm = fm + ((wgid % nig) % gsz); u.pn = (wgid % nig) / gsz; return true;
    }
    __device__ __forceinline__ void a_ready(const Unit&) const {}
    __device__ __forceinline__ void done(const Unit&) const {}
};

__device__ __forceinline__ unsigned cvt_pk_bf16(float lo, float hi) { unsigned r; asm volatile("v_cvt_pk_bf16_f32 %0, %1, %2" : "=v"(r) : "v"(lo), "v"(hi)); return r; }
template <class Epi, class Sched, bool ALIGN_EPI = false, bool SP2 = false>
__device__ __forceinline__ void gemm_phase(PG8_LAS unsigned char* lds, const Gemm g, const Sched& S, const Epi& E) {
    int tid_ = threadIdx.x; asm volatile("" : "+v"(tid_));
    const int tid = tid_, wid = __builtin_amdgcn_readfirstlane(tid >> 6), lane = tid & 63, wr = wid >> 2, wc = wid & 3, fr = lane & 15, fq = lane >> 4;
    const int K = g.K, nt = K / BK;
    unsigned voffA[2], voffB[2];
#pragma unroll
    for (int i = 0; i < 2; ++i) { int R, C; stage_rc(tid * 16 + i * 8192, R, C); const int Rb = Epi::PERM ? ((R & ~31) + perm32(R & 31)) : R;
        voffA[i] = (unsigned)(R * K + C) * 2u; voffB[i] = (unsigned)(Rb * K + C) * 2u; }
    const size_t kstep = (size_t)(BK * 2);
    const size_t hstep = (size_t)HALF * K * 2;
    const size_t tstep = 2 * hstep;
    const unsigned ldsw = (unsigned)wid * 1024u;
    const int aoff = lds_byte(wr * 64 + fr, fq * 8), boff = lds_byte(wc * 32 + fr, fq * 8);
#define PG8_SA(b, h) (((b) * 2 + (h)) * HTB)
#define PG8_SB(b, h) ((4 + (b) * 2 + (h)) * HTB)
#define PG8_STAGE(bufoff, gbase, voff) do { _Pragma("unroll") for (int _i = 0; _i < 2; ++_i) \
        __builtin_amdgcn_global_load_lds((const unsigned*)((const char*)(gbase) + (voff)[_i]), (PG8_LAS unsigned*)(lds + (bufoff) + ldsw + _i * 8192), 16, 0, 0); } while (0)
#define PG8_LDA(dst, b, h) do { _Pragma("unroll") for (int m = 0; m < 4; ++m) _Pragma("unroll") for (int k = 0; k < 2; ++k) dst[m][k] = *(const PG8_LAS bf16x8*)(lds + PG8_SA(b, h) + aoff + m * 2048 + k * 1024); } while (0)
#define PG8_LDB(dst, b, h) do { _Pragma("unroll") for (int n = 0; n < 2; ++n) _Pragma("unroll") for (int k = 0; k < 2; ++k) dst[n][k] = *(const PG8_LAS bf16x8*)(lds + PG8_SB(b, h) + boff + n * 2048 + k * 1024); } while (0)
#define PG8_MMA(ai, bj, At, Bt) do { __builtin_amdgcn_s_setprio(1); _Pragma("unroll") for (int m = 0; m < 4; ++m) _Pragma("unroll") for (int n = 0; n < 2; ++n) _Pragma("unroll") for (int k = 0; k < 2; ++k) \
        acc[ai][bj][m][n] = __builtin_amdgcn_mfma_f32_16x16x32_bf16(Bt[n][k], At[m][k], acc[ai][bj][m][n], 0, 0, 0); __builtin_amdgcn_s_setprio(0); } while (0)
#define PG8_WAIT_V(n) asm volatile("s_waitcnt vmcnt(" #n ")" ::: "memory")
#define PG8_WAIT_L(n) asm volatile("s_waitcnt lgkmcnt(" #n ")" ::: "memory")
#define PG8_BAR __builtin_amdgcn_s_barrier()
#define PG8_SCHED __builtin_amdgcn_sched_barrier(0)
    Unit cur, nxt; int ui = 0;
    if (!S.next(0, cur)) return;
    f32x4 acc[2][2][4][2];
#pragma unroll
    for (int a = 0; a < 2; ++a)
#pragma unroll
        for (int b = 0; b < 2; ++b)
#pragma unroll
            for (int m = 0; m < 4; ++m)
#pragma unroll
                for (int n = 0; n < 2; ++n) acc[a][b][m][n] = (f32x4){0.f, 0.f, 0.f, 0.f};
    bf16x8 At[4][2], B0[2][2], B1[2][2];
    const char* cA = (const char*)g.A + (size_t)cur.pm * tstep; const char* cB = (const char*)g.Bt + (size_t)cur.pn * tstep;
    S.a_ready(cur);
    if constexpr (SP2) {
        PG8_STAGE(PG8_SB(0, 0), cB, voffB); PG8_STAGE(PG8_SB(0, 1), cB + hstep, voffB); PG8_STAGE(PG8_SA(0, 0), cA, voffA); PG8_STAGE(PG8_SA(0, 1), cA + hstep, voffA);
        if (wr == 1) PG8_BAR;
        PG8_WAIT_V(2); PG8_BAR;
        PG8_STAGE(PG8_SB(1, 0), cB + kstep, voffB); PG8_STAGE(PG8_SA(1, 0), cA + kstep, voffA); PG8_STAGE(PG8_SB(1, 1), cB + hstep + kstep, voffB);
        PG8_WAIT_V(6); PG8_BAR;
    } else {
        PG8_STAGE(PG8_SB(0, 0), cB, voffB); PG8_STAGE(PG8_SA(0, 0), cA, voffA); PG8_STAGE(PG8_SB(0, 1), cB + hstep, voffB); PG8_STAGE(PG8_SA(0, 1), cA + hstep, voffA);
        if (wr == 1) PG8_BAR;
        PG8_WAIT_V(4); PG8_BAR;
        PG8_STAGE(PG8_SB(1, 0), cB + kstep, voffB); PG8_STAGE(PG8_SA(1, 0), cA + kstep, voffA); PG8_STAGE(PG8_SB(1, 1), cB + hstep + kstep, voffB);
        PG8_WAIT_V(6); PG8_BAR;
    }
    for (;;) {
        const bool has_next = S.next(ui + 1, nxt);
        const char* nA = has_next ? (const char*)g.A + (size_t)nxt.pm * tstep : cA; const char* nB = has_next ? (const char*)g.Bt + (size_t)nxt.pn * tstep : cB;
        for (int t = 0; t < nt; t += 2) {
            const bool last = (t == nt - 2);
            const char* a1 = cA + (size_t)(t + 1) * kstep;
            const char* a2 = last ? nA : cA + (size_t)(t + 2) * kstep; const char* b2 = last ? nB : cB + (size_t)(t + 2) * kstep;
            const char* a3 = a2 + kstep; const char* b3 = b2 + kstep;
            if (last && has_next) S.a_ready(nxt);
            if constexpr (SP2) {
            PG8_LDB(B0, 0, 0); PG8_LDB(B1, 0, 1); PG8_SCHED; PG8_LDA(At, 0, 0); PG8_STAGE(PG8_SA(1, 1), a1 + hstep, voffA);
            PG8_WAIT_V(8); PG8_WAIT_L(0); PG8_BAR; PG8_MMA(0, 0, At, B0); PG8_MMA(0, 1, At, B1); PG8_BAR; PG8_SCHED;
            PG8_LDA(At, 0, 1); PG8_STAGE(PG8_SB(0, 0), b2, voffB); PG8_STAGE(PG8_SB(0, 1), b2 + hstep, voffB); PG8_STAGE(PG8_SA(0, 0), a2, voffA);
            PG8_WAIT_V(8); PG8_WAIT_L(0); PG8_BAR; PG8_MMA(1, 0, At, B0); PG8_MMA(1, 1, At, B1); PG8_BAR; PG8_SCHED;
            PG8_LDB(B0, 1, 0); PG8_LDB(B1, 1, 1); PG8_SCHED; PG8_LDA(At, 1, 0); PG8_STAGE(PG8_SA(0, 1), a2 + hstep, voffA);
            PG8_WAIT_V(8); PG8_WAIT_L(0); PG8_BAR; PG8_MMA(0, 0, At, B0); PG8_MMA(0, 1, At, B1); PG8_BAR; PG8_SCHED;
            PG8_LDA(At, 1, 1); PG8_STAGE(PG8_SB(1, 0), b3, voffB); PG8_STAGE(PG8_SB(1, 1), b3 + hstep, voffB); PG8_STAGE(PG8_SA(1, 0), a3, voffA);
            PG8_WAIT_V(8); PG8_WAIT_L(0); PG8_BAR; PG8_MMA(1, 0, At, B0); PG8_MMA(1, 1, At, B1); PG8_BAR; PG8_SCHED;
            } else {
            PG8_LDB(B0, 0, 0); PG8_SCHED; PG8_LDA(At, 0, 0); PG8_STAGE(PG8_SA(1, 1), a1 + hstep, voffA);
            PG8_WAIT_L(8); PG8_BAR; PG8_WAIT_L(0); PG8_MMA(0, 0, At, B0); PG8_BAR; PG8_SCHED;
            PG8_LDB(B1, 0, 1); PG8_STAGE(PG8_SB(0, 0), b2, voffB);
            PG8_BAR; PG8_WAIT_L(0); PG8_MMA(0, 1, At, B1); PG8_BAR;
            PG8_LDA(At, 0, 1); PG8_STAGE(PG8_SA(0, 0), a2, voffA);
            PG8_BAR; PG8_WAIT_L(0); PG8_MMA(1, 0, At, B0); PG8_BAR; PG8_SCHED;
            PG8_STAGE(PG8_SB(0, 1), b2 + hstep, voffB);
            PG8_WAIT_V(6); PG8_BAR; PG8_MMA(1, 1, At, B1); PG8_BAR;
            PG8_LDB(B0, 1, 0); PG8_SCHED; PG8_LDA(At, 1, 0); PG8_STAGE(PG8_SA(0, 1), a2 + hstep, voffA);
            PG8_WAIT_L(8); PG8_BAR; PG8_WAIT_L(0); PG8_MMA(0, 0, At, B0); PG8_BAR; PG8_SCHED;
            PG8_LDB(B1, 1, 1); PG8_STAGE(PG8_SB(1, 0), b3, voffB);
            PG8_BAR; PG8_WAIT_L(0); PG8_MMA(0, 1, At, B1); PG8_BAR;
            PG8_LDA(At, 1, 1); PG8_STAGE(PG8_SA(1, 0), a3, voffA);
            PG8_BAR; PG8_WAIT_L(0); PG8_MMA(1, 0, At, B0); PG8_BAR; PG8_SCHED;
            PG8_STAGE(PG8_SB(1, 1), b3 + hstep, voffB);
            PG8_WAIT_V(6); PG8_BAR; PG8_MMA(1, 1, At, B1); PG8_BAR;
            }
        }
        if constexpr (ALIGN_EPI) { if (wr == 0) PG8_BAR; }
        if constexpr (!Epi::AFTER_DRAIN) { E(acc, cur, wr, wc, fr, fq); S.done(cur); }
        if (!has_next) break;
#pragma unroll
        for (int a = 0; a < 2; ++a)
#pragma unroll
            for (int b = 0; b < 2; ++b)
#pragma unroll
                for (int m = 0; m < 4; ++m)
#pragma unroll
                    for (int n = 0; n < 2; ++n) acc[a][b][m][n] = (f32x4){0.f, 0.f, 0.f, 0.f};
        cur = nxt; cA = nA; cB = nB; ++ui;
        if constexpr (ALIGN_EPI) { if (wr == 1) PG8_BAR; }
    }
    PG8_WAIT_V(0);
    if constexpr (!ALIGN_EPI) { if (wr == 0) PG8_BAR; }
    PG8_BAR;
    if constexpr (Epi::AFTER_DRAIN) { E.fused(acc, cur, wr, wc, fr, fq, lds, wid, lane); S.done(cur); }
#undef PG8_SA
#undef PG8_SB
#undef PG8_STAGE
#undef PG8_LDA
#undef PG8_LDB
#undef PG8_MMA
#undef PG8_WAIT_V
#undef PG8_WAIT_L
#undef PG8_BAR
#undef PG8_SCHED
}
}
namespace pg8 {
struct EpiU { static constexpr bool PERM = true, AFTER_DRAIN = false; bf16_t* O; int ldc;
    __device__ __forceinline__ void operator()(const f32x4 (&acc)[2][2][4][2], const Unit& u, int wr, int wc, int fr, int fq) const {
        const int row0 = u.pm * BM + wr * 64 + fr, col0 = u.pn * BM + wc * 32 + 8 * fq;
#pragma unroll
        for (int ai = 0; ai < 2; ++ai)
#pragma unroll
            for (int m = 0; m < 4; ++m) { bf16_t* rowp = O + (size_t)(row0 + ai * HALF + m * 16) * ldc + col0;
#pragma unroll
                for (int bj = 0; bj < 2; ++bj) { const f32x4 v0 = acc[ai][bj][m][0], v1 = acc[ai][bj][m][1];
                    u32x4 w; w.x = cvt_pk_bf16(v0[0], v0[1]); w.y = cvt_pk_bf16(v0[2], v0[3]); w.z = cvt_pk_bf16(v1[0], v1[1]); w.w = cvt_pk_bf16(v1[2], v1[3]);
                    *(u32x4*)(rowp + bj * HALF) = w; } }
    }
};
struct EpiMod { static constexpr bool PERM = false, AFTER_DRAIN = false; float* O; const float* b_ada; const float* b_fin;
    __device__ __forceinline__ void operator()(const f32x4 (&acc)[2][2][4][2], const Unit& u, int wr, int wc, int fr, int fq) const {
        const int colt = u.pn * BM; const float* bias = colt < 12288 ? b_ada + colt : b_fin + (colt - 12288);
        const int cl = wc * 32 + 4 * fq;
#pragma unroll
        for (int ai = 0; ai < 2; ++ai)
#pragma unroll
            for (int m = 0; m < 4; ++m) { const int row = ai * HALF + wr * 64 + m * 16 + fr;
                if (row < 136) {
#pragma unroll
                    for (int bj = 0; bj < 2; ++bj)
#pragma unroll
                        for (int n = 0; n < 2; ++n) { const int c = cl + bj * HALF + n * 16; const f32x4 bv = *(const f32x4*)(bias + c);
                            *(f32x4*)(O + (size_t)row * 14336 + colt + c) = acc[ai][bj][m][n] + bv; } } }
    }
};
struct EpiRes { static constexpr bool PERM = false, AFTER_DRAIN = false; const float* base_p; const float* base_s; float* X; const float* gate0;
    __device__ __forceinline__ void operator()(const f32x4 (&acc)[2][2][4][2], const Unit& u, int wr, int wc, int fr, int fq) const {
        const int cl = u.pn * BM + wc * 32 + 4 * fq;
#pragma unroll
        for (int ai = 0; ai < 2; ++ai)
#pragma unroll
            for (int m = 0; m < 4; ++m) { const int row = u.pm * BM + ai * HALF + wr * 64 + m * 16 + fr;
                const float* b = row < 16384 ? base_p + (size_t)row * 1024 : base_s + (size_t)(row - 16384) * 1024;
                const int brow = row < 16384 ? (row >> 11) : 8 + ((row - 16384) >> 2);
                const float* g = gate0 + (size_t)brow * 14336; float* o = X + (size_t)row * 1024;
#pragma unroll
                for (int bj = 0; bj < 2; ++bj)
#pragma unroll
                    for (int n = 0; n < 2; ++n) { const int c = cl + bj * HALF + n * 16; const f32x4 bv = *(const f32x4*)(b + c), gv = *(const f32x4*)(g + c);
                        *(f32x4*)(o + c) = bv + (gv + 1.0f) * acc[ai][bj][m][n]; } }
    }
};
}
using pg8::bf16_t; using pg8::bf16x8; using pg8::f32x4; using pg8::u32x4;
#ifdef HOST_EMU
#define DEVFN static inline
#define LDSQ
#define GASQ
#else
#define DEVFN __device__ __forceinline__
#define LDSQ __attribute__((address_space(3)))
#define GASQ __attribute__((address_space(1)))
#endif
typedef short s16x4 __attribute__((ext_vector_type(4)));
typedef float f32x2 __attribute__((ext_vector_type(2)));
typedef unsigned u32x2 __attribute__((ext_vector_type(2)));

constexpr int D_MODEL = 1024, SEQ = 2048, NBP = 8, NBS = 128, DSEQ = 4, DEPTH = 4;
constexpr int M_P = NBP * SEQ, M_S = NBS * DSEQ, M_T = M_P + M_S;
constexpr int IN_W = 4108, NU = 4096, NBROW = NBP + NBS;
constexpr int NMOD = 4 * 3072 + 2048;
constexpr int UC_AX = 0, UC_ACG = 256, UC_ABG = 512, UC_AZ = 768, UC_BQ = 1024, UC_BK = 1408, UC_BV = 1792, UC_BZ = 2176, UC_CQ = 2560, UC_CK = 2944, UC_CV = 3328, UC_CZ = 3712;
constexpr size_t MiB = 1u << 20;
constexpr size_t WS_CTL = 0, CTL_ZERO_BYTES = 1 * MiB;
constexpr size_t WS_WIN = 2 * MiB;
constexpr size_t WS_WOUT = 34 * MiB;
constexpr size_t WS_WADA = 42 * MiB;
constexpr size_t WS_WAB = 70 * MiB;
constexpr size_t WS_ROPE = 71 * MiB;
constexpr size_t WS_CB = 72 * MiB;
constexpr size_t WS_MOD = 73 * MiB;
constexpr size_t WS_AB = 82 * MiB;
constexpr size_t WS_LSE = 84 * MiB;
constexpr size_t WS_GSC = 86 * MiB;
constexpr size_t WS_X = 96 * MiB;
constexpr size_t WS_HN = 162 * MiB;
constexpr size_t WS_MIX = 196 * MiB;
constexpr size_t WS_OC = 230 * MiB;
constexpr size_t WS_U = 256 * MiB;
constexpr size_t WS_GDN = 400 * MiB;
constexpr size_t GDN_CHUNK_BYTES = 49152;
constexpr size_t WS_END = 480 * MiB;
constexpr size_t O_YP = 0, O_YS = 16777216, O_CAP = 17301504, O_CAS = 17317888, O_CBP = 17580032, O_CBS = 17690624, O_GP = 19460096, O_GS = 20246528,
                 O_K128P = 32829440, O_K128S = 33878016, O_K512P = 34402304, O_K512S = 38596608, O_K2048P = 39120896, O_K2048S = 55898112, O_END = 56422400;

DEVFN float bf_lo(unsigned u) { return __builtin_bit_cast(float, u << 16); }
DEVFN float bf_hi(unsigned u) { return __builtin_bit_cast(float, u & 0xffff0000u); }
DEVFN float bf2f(bf16_t h) { return __builtin_bit_cast(float, (unsigned)h << 16); }
DEVFN unsigned f2bf(float f) { unsigned u = __builtin_bit_cast(unsigned, f); return (u + 0x7fffu + ((u >> 16) & 1u)) >> 16; }
DEVFN unsigned pk2(float lo, float hi) { return f2bf(lo) | (f2bf(hi) << 16); }
DEVFN void unpack8(u32x4 v, float* f) { f[0] = bf_lo(v.x); f[1] = bf_hi(v.x); f[2] = bf_lo(v.y); f[3] = bf_hi(v.y); f[4] = bf_lo(v.z); f[5] = bf_hi(v.z); f[6] = bf_lo(v.w); f[7] = bf_hi(v.w); }
DEVFN u32x4 pack8(const float* f) { u32x4 v; v.x = pk2(f[0], f[1]); v.y = pk2(f[2], f[3]); v.z = pk2(f[4], f[5]); v.w = pk2(f[6], f[7]); return v; }
DEVFN float silu_f(float x) { return x / (1.f + expf(-x)); }
DEVFN float sigmoid_f(float x) { return 1.f / (1.f + expf(-x)); }
DEVFN float softplus_f(float x) { return x > 20.f ? x : log1pf(expf(x)); }

struct Args { const float* in[23]; float* out_; unsigned char* ws_; };
struct Ctx {
    int tid, lane, wave, cu, ncu;
    LDSQ unsigned char* lds;
    const Args* a;
};
#define x_prompt a->in[0]
#define x_sample a->in[1]
#define st_conv_a a->in[2]
#define st_conv_b a->in[3]
#define st_gdn a->in[4]
#define kv128 a->in[5]
#define kv512 a->in[6]
#define kv2048 a->in[7]
#define c_prompt a->in[8]
#define c_sample a->in[9]
#define w_in a->in[10]
#define w_out a->in[11]
#define w_ada a->in[12]
#define b_ada a->in[13]
#define norm_w a->in[14]
#define conv_a_w a->in[15]
#define conv_b_w a->in[16]
#define a_log a->in[17]
#define dt_bias a->in[18]
#define gdn_norm_w a->in[19]
#define final_norm_w a->in[20]
#define w_ada_final a->in[21]
#define b_ada_final a->in[22]
#define outp a->out_
#define wsp a->ws_
#define WSP(T, off) ((T*)(C.wsp + (off)))
#define LAS __attribute__((address_space(3)))
#define XB_TMO      128
#define XB_XCNT(j)  (256  + 64 * (j))
#define XB_XSUB(j)  (1280 + 64 * (j))
#define XB_XGEN(j)  (2304 + 64 * (j))
#define XB_TOP      3328
#define XB_TOPGEN   3392
#define XCD_BAR_WORDS 3456
#define XB_SPIN_CAP (1u << 18)

__device__ __forceinline__ unsigned xb_ld(unsigned* p)              { return __hip_atomic_load(p, __ATOMIC_RELAXED, __HIP_MEMORY_SCOPE_AGENT); }
__device__ __forceinline__ unsigned xb_add(unsigned* p, unsigned v) { return __hip_atomic_fetch_add(p, v, __ATOMIC_RELAXED, __HIP_MEMORY_SCOPE_AGENT); }
__device__ __forceinline__ unsigned xb_xcc_id() { return (unsigned)__builtin_amdgcn_s_getreg((3 << 11) | 20) & 0xFu; }
#define XB_SPIN(cond, bar) do { unsigned _sp = 0; while (cond) { __builtin_amdgcn_s_sleep(1); \
    if ((++_sp & 255u) == 0u) { if (xb_ld(&(bar)[XB_TMO])) break; if (_sp > XB_SPIN_CAP) { atomicAdd(&(bar)[XB_TMO], 1u); break; } } } } while (0)

struct XcdBarrier {
    unsigned* bar; unsigned x;
    volatile LAS unsigned* st;
};

__device__ __forceinline__ XcdBarrier xcd_barrier_post(unsigned* bar, volatile LAS unsigned* st) {
    XcdBarrier b; b.bar = bar; b.x = xb_xcc_id(); b.st = st;
    if (threadIdx.x == 0) (void)xb_add(&bar[XB_XCNT(b.x)], 1u);
    return b;
}
__device__ __forceinline__ void xcd_barrier_complete(unsigned* bar, unsigned x, unsigned& nloc, unsigned& nx) {
    const unsigned G = gridDim.x * gridDim.y * gridDim.z;
    unsigned sum, cnt, mine, sp = 0u;
    for (;;) {
        sum = 0u; cnt = 0u; mine = 0u;
#pragma unroll
        for (unsigned j = 0; j < 16; ++j) { const unsigned c = xb_ld(&bar[XB_XCNT(j)]); sum += c; cnt += (c > 0u) ? 1u : 0u; mine = (j == x) ? c : mine; }
        if (sum == G) break;
        __builtin_amdgcn_s_sleep(1);
        if ((++sp & 255u) == 0u) { if (xb_ld(&bar[XB_TMO])) break; if (sp > XB_SPIN_CAP) { atomicAdd(&bar[XB_TMO], 1u); break; } }
    }
    nloc = mine > 0u ? mine : 1u; nx = cnt > 0u ? cnt : 1u;
}

__device__ __forceinline__ void xcd_barrier(const XcdBarrier& b) {
    asm volatile("s_waitcnt vmcnt(0)" ::: "memory");
    __syncthreads();
    if (threadIdx.x == 0) {
        unsigned* bar = b.bar;
        __builtin_amdgcn_s_waitcnt(0);
        unsigned nloc = b.st[0], nx = b.st[1];
        if (nloc == 0u) { xcd_barrier_complete(bar, b.x, nloc, nx); b.st[0] = nloc; b.st[1] = nx; }
        const unsigned old = xb_add(&bar[XB_XSUB(b.x)], 1u);
        const unsigned gen = old / nloc;
        if (old + 1u == (gen + 1u) * nloc) {
            __builtin_amdgcn_fence(__ATOMIC_RELEASE, "agent");
            asm volatile("s_waitcnt vmcnt(0)" ::: "memory");
            const unsigned og = xb_add(&bar[XB_TOP], 1u);
            const unsigned tg = og / nx;
            if (og + 1u == (tg + 1u) * nx) xb_add(&bar[XB_TOPGEN], 1u);
            else XB_SPIN(xb_ld(&bar[XB_TOPGEN]) == tg, bar);
            __builtin_amdgcn_fence(__ATOMIC_ACQUIRE, "agent");
            xb_add(&bar[XB_XGEN(b.x)], 1u);
            asm volatile("s_waitcnt vmcnt(0)" ::: "memory");
        } else {
            XB_SPIN(xb_ld(&bar[XB_XGEN(b.x)]) == gen, bar);
            __builtin_amdgcn_fence(__ATOMIC_ACQUIRE, "agent");
            asm volatile("s_waitcnt vmcnt(0)" ::: "memory");
        }
    }
    __syncthreads();
}
#define SYNC() __syncthreads()
#define WAVE_LDS_FENCE() do { asm volatile("s_waitcnt lgkmcnt(0)" ::: "memory"); } while (0)
#define COMPILER_MEM_FENCE() asm volatile("" ::: "memory")
#define FAST_SIN(x) __sinf(x)
#define FAST_COS(x) __cosf(x)
DEVFN f32x4 mfma16(bf16x8 a, bf16x8 b, f32x4 c) { return __builtin_amdgcn_mfma_f32_16x16x32_bf16(a, b, c, 0, 0, 0); }
DEVFN float shfl_xor_f(float v, int m) { return __shfl_xor(v, m); }
DEVFN float shfl_f(float v, int src) { return __shfl(v, src); }
DEVFN float shfl_up_f(float v, int d) { return __shfl_up(v, d); }
DEVFN Ctx relaunder(const Ctx& C0) {
    Ctx C = C0; int tid = C0.tid; asm volatile("" : "+v"(tid)); C.tid = tid; C.lane = tid & 63; C.wave = __builtin_amdgcn_readfirstlane(tid >> 6); return C;
}
DEVFN float FMA_OP(float a, float b, float c) { float r; asm("v_fma_f32 %0, %1, %2, %3" : "=v"(r) : "v"(a), "v"(b), "v"(c)); return r; }
DEVFN float wave_sum(float v) {
#pragma unroll
    for (int o = 1; o < 64; o <<= 1) v += shfl_xor_f(v, o);
    return v;
}
DEVFN void p0_transpose_item(const float* W, int N, int nsrc0, bf16_t* WT, int ndst0, int k0, LDSQ float* scr, int lane) {
#pragma unroll 8
    for (int i = 0; i < 32; ++i) { const int kk = 2 * i + (lane >> 5); scr[kk * 33 + (lane & 31)] = W[(size_t)(k0 + kk) * N + nsrc0 + (lane & 31)]; }
    WAVE_LDS_FENCE();
    const int c = lane & 7;
#pragma unroll
    for (int j = 0; j < 4; ++j) { const int n = (lane >> 3) + 8 * j; const LDSQ float* s = scr + (8 * c) * 33 + n;
        u32x4 o; o.x = pk2(s[0 * 33], s[1 * 33]); o.y = pk2(s[2 * 33], s[3 * 33]); o.z = pk2(s[4 * 33], s[5 * 33]); o.w = pk2(s[6 * 33], s[7 * 33]);
        *(u32x4*)(WT + (size_t)(ndst0 + n) * 1024 + k0 + 8 * c) = o; }
    WAVE_LDS_FENCE();
}
DEVFN void phase_p0a(const Ctx& C) {
    LDSQ float* scr = (LDSQ float*)(C.lds + C.wave * 16384);
    const int gw = C.cu * 8 + C.wave, NGW = C.ncu * 8;
    bf16_t* WIN = WSP(bf16_t, WS_WIN); bf16_t* WOUT = WSP(bf16_t, WS_WOUT); bf16_t* WADA = WSP(bf16_t, WS_WADA);
    constexpr int I_IN = 4 * 16 * 128, I_OUT = 4 * 16 * 32, I_ADA = 4 * 16 * 96, I_FIN = 16 * 64;
    for (int it = gw; it < I_IN + I_OUT + I_ADA + I_FIN; it += NGW) {
        int r = it;
        if (r < I_IN) { const int l = r / 2048, rr = r % 2048, kb = rr / 128, nb = rr % 128, nd = 32 * nb, ns = nd < 2560 ? nd : nd + 12;
            p0_transpose_item(C.w_in + (size_t)l * 1024 * IN_W, IN_W, ns, WIN + (size_t)l * 4096 * 1024, nd, 64 * kb, scr, C.lane); continue; }
        r -= I_IN;
        if (r < I_OUT) { const int l = r / 512, rr = r % 512, kb = rr / 32, nb = rr % 32;
            p0_transpose_item(C.w_out + (size_t)l * 1024 * 1024, 1024, 32 * nb, WOUT + (size_t)l * 1024 * 1024, 32 * nb, 64 * kb, scr, C.lane); continue; }
        r -= I_OUT;
        if (r < I_ADA) { const int l = r / 1536, rr = r % 1536, kb = rr / 96, nb = rr % 96;
            p0_transpose_item(C.w_ada + (size_t)l * 1024 * 3072, 3072, 32 * nb, WADA + (size_t)l * 3072 * 1024, 32 * nb, 64 * kb, scr, C.lane); continue; }
        r -= I_ADA;
        { const int kb = r / 64, nb = r % 64;
            p0_transpose_item(C.w_ada_final, 2048, 32 * nb, WADA + (size_t)12288 * 1024, 32 * nb, 64 * kb, scr, C.lane); }
    }
    const int gt = C.cu * 512 + C.tid, NGT = C.ncu * 512;
    float* WAB = WSP(float, WS_WAB);
    for (int i = gt; i < 4 * 12 * 1024; i += NGT) { const int l = i / 12288, j = (i / 1024) % 12, k = i % 1024; WAB[i] = C.w_in[((size_t)l * 1024 + k) * IN_W + 2560 + j]; }
    unsigned* CB = WSP(unsigned, WS_CB);
    for (int i = gt; i < 256 * 512; i += NGT) { const int row = i / 512, c = 2 * (i % 512); float a = 0.f, b = 0.f;
        if (row < NBP) { a = C.c_prompt[row * 1024 + c]; b = C.c_prompt[row * 1024 + c + 1]; }
        else if (row < NBROW) { a = C.c_sample[(row - NBP) * 1024 + c]; b = C.c_sample[(row - NBP) * 1024 + c + 1]; }
        CB[i] = pk2(a, b); }
    float* ROPE = WSP(float, WS_ROPE);
    for (int i = gt; i < 2052 * 8; i += NGT) { const int pos = i >> 3, j = i & 7;
        const float invf[8] = {1.0f, 0.1939227432012558f, 0.03760603070259094f, 0.007292664609849453f, 0.0014142135623842478f, 0.00027424818836152554f, 5.3182957344688475e-05f, 1.0313385246263351e-05f};
        float fr = 1.0f;
#pragma unroll
        for (int q = 0; q < 8; ++q) fr = (j == q) ? invf[q] : fr;
        const float ang = (float)pos * fr;
        const double a = (double)ang, tw = 6.283185307179586476925;
        const double kq = __builtin_floor(a / tw + 0.5); const float red = (float)(a - kq * tw);
        ROPE[pos * 16 + j] = FAST_COS(red); ROPE[pos * 16 + 8 + j] = FAST_SIN(red); }
}
DEVFN int brow_of(int m) { return m < M_P ? (m >> 11) : NBP + ((m - M_P) >> 2); }
DEVFN const float* xrow_l0(const Ctx& C, int m) { return m < M_P ? C.x_prompt + (size_t)m * 1024 : C.x_sample + (size_t)(m - M_P) * 1024; }
DEVFN void phase_norm(const Ctx& C, int l) {
    const int gw = C.cu * 8 + C.wave, NGW = C.ncu * 8;
    const float* X = WSP(float, WS_X); bf16_t* HN = WSP(bf16_t, WS_HN); float* AB = WSP(float, WS_AB);
    const float* MOD = WSP(float, WS_MOD); const float* WAB = WSP(float, WS_WAB) + l * 12 * 1024;
    const f32x4* nw = (const f32x4*)(C.norm_w + l * 1024) + C.lane;
    for (int m = gw; m < M_T; m += NGW) {
        const f32x4* xr = (const f32x4*)(l == 0 ? xrow_l0(C, m) : X + (size_t)m * 1024) + C.lane;
        const float* mod = MOD + (size_t)brow_of(m) * NMOD + l * 3072;
        f32x4 v[4]; float s = 0.f;
#pragma unroll
        for (int j = 0; j < 4; ++j) { v[j] = xr[64 * j]; s += (v[j].x * v[j].x + v[j].y * v[j].y) + (v[j].z * v[j].z + v[j].w * v[j].w); }
        const float rstd = 1.f / sqrtf(wave_sum(s) * (1.f / 1024.f) + 1e-6f);
#pragma unroll
        for (int j = 0; j < 4; ++j) { const f32x4 w = nw[64 * j], sh = ((const f32x4*)mod)[64 * j + C.lane], sc = ((const f32x4*)(mod + 1024))[64 * j + C.lane];
            v[j] = v[j] * rstd * w * (sc + 1.0f) + sh; }
        u32x2* o8 = (u32x2*)(HN + (size_t)m * 1024) + C.lane;
#pragma unroll
        for (int j = 0; j < 4; ++j) { u32x2 o; o.x = pk2(v[j].x, v[j].y); o.y = pk2(v[j].z, v[j].w); o8[64 * j] = o; }
        float myab = 0.f;
#pragma unroll
        for (int q = 0; q < 12; ++q) { float d = 0.f;
#pragma unroll
            for (int j = 0; j < 4; ++j) { const f32x4 w = ((const f32x4*)(WAB + q * 1024))[64 * j + C.lane]; d += (v[j].x * w.x + v[j].y * w.y) + (v[j].z * w.z + v[j].w * w.w); }
            d = wave_sum(d); myab = (C.lane == q) ? d : myab; }
        if (C.lane < 12) AB[(size_t)m * 16 + C.lane] = myab;
    }
}
DEVFN void phase_final(const Ctx& C) {
    const int gw = C.cu * 8 + C.wave, NGW = C.ncu * 8;
    const float* X = WSP(float, WS_X); const float* MOD = WSP(float, WS_MOD);
    const f32x4* nw = (const f32x4*)C.final_norm_w + C.lane;
    for (int m = gw; m < M_T; m += NGW) {
        const f32x4* xr = (const f32x4*)(X + (size_t)m * 1024) + C.lane;
        const float* mod = MOD + (size_t)brow_of(m) * NMOD + 12288;
        f32x4 v[4]; float s = 0.f;
#pragma unroll
        for (int j = 0; j < 4; ++j) { v[j] = xr[64 * j]; s += (v[j].x * v[j].x + v[j].y * v[j].y) + (v[j].z * v[j].z + v[j].w * v[j].w); }
        const float rstd = 1.f / sqrtf(wave_sum(s) * (1.f / 1024.f) + 1e-6f);
        f32x4* o = (f32x4*)(C.outp + (m < M_P ? O_YP + (size_t)m * 1024 : O_YS + (size_t)(m - M_P) * 1024)) + C.lane;
#pragma unroll
        for (int j = 0; j < 4; ++j) { const f32x4 w = nw[64 * j], sh = ((const f32x4*)mod)[64 * j + C.lane], sc = ((const f32x4*)(mod + 1024))[64 * j + C.lane];
            o[64 * j] = v[j] * rstd * w * (sc + 1.0f) + sh; }
    }
}
DEVFN bf16x8 lds_frag(const LDSQ bf16_t* base, int ld, int row, int col) { return *(const LDSQ bf16x8*)(base + row * ld + col); }
DEVFN bf16x8 glb_frag(const bf16_t* base, int ld, int row, int col) { return *(const bf16x8*)(base + (size_t)row * ld + col); }
DEVFN bf16x8 zero_frag() { bf16x8 z = {0, 0, 0, 0, 0, 0, 0, 0}; return z; }
DEVFN u32x2 pack4(f32x4 v) { u32x2 o; o.x = pk2(v.x, v.y); o.y = pk2(v.z, v.w); return o; }
constexpr int LDP = 72;
constexpr float NEG_BIG = -1e30f;

DEVFN void conv_a_item(const Ctx& C, int l, int item) {
    const bf16_t* U = WSP(bf16_t, WS_U); bf16_t* MIX = WSP(bf16_t, WS_MIX);
    const int rl = C.tid >> 5, ch = (C.tid & 31) * 8;
    float w[3][8];
#pragma unroll
    for (int j = 0; j < 3; ++j)
#pragma unroll
        for (int e = 0; e < 8; ++e) w[j][e] = C.conv_a_w[(l * 3 + j) * 256 + ch + e];
    for (int pass = 0; pass < 4; ++pass) {
        const int m = item * 64 + pass * 16 + rl;
        const bool smp = m >= M_P; const int b = smp ? (m - M_P) >> 2 : m >> 11, t = smp ? (m - M_P) & 3 : m & 2047;
        float P[3][8];
#pragma unroll
        for (int j = 0; j < 3; ++j) { const int tt = t - 2 + j;
            if (tt >= 0) { const size_t r = (size_t)(m - 2 + j) * NU; float a[8], c[8];
                unpack8(*(const u32x4*)(U + r + UC_AX + ch), a); unpack8(*(const u32x4*)(U + r + UC_ACG + ch), c);
#pragma unroll
                for (int e = 0; e < 8; ++e) P[j][e] = a[e] * c[e]; }
            else if (smp) { const float* s = C.st_conv_a + ((size_t)(l * NBS + b) * 2 + (tt + 2)) * 256 + ch;
#pragma unroll
                for (int e = 0; e < 8; ++e) P[j][e] = s[e]; }
            else {
#pragma unroll
                for (int e = 0; e < 8; ++e) P[j][e] = 0.f; } }
        float bg[8], z[8], y[8];
        unpack8(*(const u32x4*)(U + (size_t)m * NU + UC_ABG + ch), bg); unpack8(*(const u32x4*)(U + (size_t)m * NU + UC_AZ + ch), z);
#pragma unroll
        for (int e = 0; e < 8; ++e) y[e] = bg[e] * (w[0][e] * P[0][e] + w[1][e] * P[1][e] + w[2][e] * P[2][e]) * silu_f(z[e]);
        *(u32x4*)(MIX + (size_t)m * 1024 + ch) = pack8(y);
        const int last = smp ? 4 : 2048;
        if (t >= last - 2) { float* o = C.outp + (smp ? O_CAS + ((size_t)(l * NBS + b) * 2 + (t - 2)) * 256 : O_CAP + ((size_t)(l * NBP + b) * 2 + (t - 2046)) * 256) + ch;
#pragma unroll
            for (int e = 0; e < 8; ++e) o[e] = P[2][e]; }
    }
}

constexpr int GP_KN = 0, GP_QN = 9216, GP_VBT = 18432, GP_KBGT = 27648, GP_KDT = 36864, GP_LB = 46080, GP_TR = 55296, GP_TT = 64512, GP_AM = 73728, GP_WM = 82944,
              GP_LF = 92160  , GP_PT = 109568  , GP_QT = 112128  , GP_G = 114688  ;
DEVFN void gdn_prep_item(const Ctx& C, int l, int item) {
    const int b = item / 192, h = (item / 32) % 6, n = item % 32;
    const int lane = C.lane, quad = lane >> 4, l15 = lane & 15, wave = C.wave;
    const bf16_t* U = WSP(bf16_t, WS_U); const float* AB = WSP(float, WS_AB);
    unsigned char* cbase = C.wsp + WS_GDN + (size_t)item * GDN_CHUNK_BYTES;
    bf16_t* gWm = (bf16_t*)cbase; bf16_t* gQG = (bf16_t*)(cbase + 8192); bf16_t* gAm = (bf16_t*)(cbase + 16384); bf16_t* gKDt = (bf16_t*)(cbase + 24576); float* gUt = (float*)(cbase + 32768);
    LDSQ bf16_t* Kn = (LDSQ bf16_t*)(C.lds + GP_KN); LDSQ bf16_t* Qn = (LDSQ bf16_t*)(C.lds + GP_QN); LDSQ bf16_t* VbT = (LDSQ bf16_t*)(C.lds + GP_VBT);
    LDSQ bf16_t* KbgT = (LDSQ bf16_t*)(C.lds + GP_KBGT); LDSQ bf16_t* KDt = (LDSQ bf16_t*)(C.lds + GP_KDT); LDSQ bf16_t* Lb = (LDSQ bf16_t*)(C.lds + GP_LB);
    LDSQ bf16_t* Tr = (LDSQ bf16_t*)(C.lds + GP_TR); LDSQ bf16_t* Tt = (LDSQ bf16_t*)(C.lds + GP_TT); LDSQ bf16_t* Am = (LDSQ bf16_t*)(C.lds + GP_AM); LDSQ bf16_t* Wm = (LDSQ bf16_t*)(C.lds + GP_WM);
    LDSQ float* Lf = (LDSQ float*)(C.lds + GP_LF); LDSQ bf16_t* PT = (LDSQ bf16_t*)(C.lds + GP_PT); LDSQ bf16_t* QT = (LDSQ bf16_t*)(C.lds + GP_QT);
    LDSQ float* gl = (LDSQ float*)(C.lds + GP_G); LDSQ float* gcl = gl + 64; LDSQ float* betal = gl + 128;
    const int i = C.tid >> 3, cg = C.tid & 7, t = 64 * n + i;
    const size_t row = (size_t)b * 2048 + t;
    float q[8], k[8], v[8], xq[8], xk[8], xv[8];
#pragma unroll
    for (int e = 0; e < 8; ++e) { q[e] = 0.f; k[e] = 0.f; v[e] = 0.f; xq[e] = 0.f; xk[e] = 0.f; xv[e] = 0.f; }
    const int cq = h * 64 + 8 * cg;
#pragma unroll
    for (int j = 0; j < 4; ++j) { const int tt = t - 3 + j;
        if (tt >= 0) { const bf16_t* ur = U + (row - 3 + j) * NU + cq;
            unpack8(*(const u32x4*)(ur + UC_BQ), xq); unpack8(*(const u32x4*)(ur + UC_BK), xk); unpack8(*(const u32x4*)(ur + UC_BV), xv);
            const float* wr_ = C.conv_b_w + (size_t)(l * 4 + j) * 1152 + cq;
#pragma unroll
            for (int e = 0; e < 8; ++e) { q[e] += xq[e] * wr_[e]; k[e] += xk[e] * wr_[384 + e]; v[e] += xv[e] * wr_[768 + e]; } } }
    if (n == 31 && i >= 61) { float* o = C.outp + O_CBP + ((size_t)(l * NBP + b) * 3 + (i - 61)) * 1152 + cq;
#pragma unroll
        for (int e = 0; e < 8; ++e) { o[e] = xq[e]; o[384 + e] = xk[e]; o[768 + e] = xv[e]; } }
    float sq = 0.f, sk = 0.f;
#pragma unroll
    for (int e = 0; e < 8; ++e) { q[e] = silu_f(q[e]); k[e] = silu_f(k[e]); v[e] = silu_f(v[e]); sq += q[e] * q[e]; sk += k[e] * k[e]; }
    sq += shfl_xor_f(sq, 1); sq += shfl_xor_f(sq, 2); sq += shfl_xor_f(sq, 4);
    sk += shfl_xor_f(sk, 1); sk += shfl_xor_f(sk, 2); sk += shfl_xor_f(sk, 4);
    const float rq = 0.125f / sqrtf(sq + 1e-6f), rk = 1.0f / sqrtf(sk + 1e-6f);
#pragma unroll
    for (int e = 0; e < 8; ++e) { q[e] *= rq; k[e] *= rk; }
    if (cg == 0) { const float ga = AB[row * 16 + h], gb = AB[row * 16 + 6 + h];
        gl[i] = -expf(C.a_log[l * 6 + h]) * softplus_f(ga + C.dt_bias[l * 6 + h]); betal[i] = sigmoid_f(gb); }
    for (int e = C.tid; e < 2 * 64 * LDP / 2; e += 512) ((LDSQ unsigned*)Tr)[e] = 0u;
    SYNC();
    if (wave == 0) { float x = gl[lane];
#pragma unroll
        for (int d = 1; d < 64; d <<= 1) { const float y = shfl_up_f(x, d); if (lane >= d) x += y; }
        gcl[lane] = x; }
    SYNC();
    const float gci = gcl[i], glast = gcl[63], bi = betal[i];
    const float egc = expf(gci), ekd = expf(glast - gci);
    {
        float tq[8];
#pragma unroll
        for (int e = 0; e < 8; ++e) tq[e] = q[e] * egc;
        *(u32x4*)(gQG + i * 64 + 8 * cg) = pack8(tq);
        *(LDSQ u32x4*)(Kn + i * LDP + 8 * cg) = pack8(k); *(LDSQ u32x4*)(Qn + i * LDP + 8 * cg) = pack8(q);
#pragma unroll
        for (int e = 0; e < 8; ++e) { const int d = 8 * cg + e;
            VbT[d * LDP + i] = (bf16_t)f2bf(v[e] * bi); KbgT[d * LDP + i] = (bf16_t)f2bf(k[e] * bi * egc); KDt[d * LDP + i] = (bf16_t)f2bf(k[e] * ekd); }
    }
    SYNC();
#pragma unroll 1
    for (int jj = 0; jj < 4; ++jj) { const int job = wave * 4 + jj, type = job >> 4, it = (job & 15) >> 2, jt = job & 3;
        if (it < jt) { if (type == 1) {
#pragma unroll
                for (int r = 0; r < 4; ++r) Am[(16 * it + 4 * quad + r) * LDP + 16 * jt + l15] = 0; }
            continue; }
        f32x4 acc = {0.f, 0.f, 0.f, 0.f};
#pragma unroll
        for (int s = 0; s < 2; ++s) { const bf16x8 a = lds_frag(type ? Qn : Kn, LDP, 16 * it + l15, 32 * s + 8 * quad), bb = lds_frag(Kn, LDP, 16 * jt + l15, 32 * s + 8 * quad);
            acc = mfma16(a, bb, acc); }
        const int jc = 16 * jt + l15; const float gj = gcl[jc];
#pragma unroll
        for (int r = 0; r < 4; ++r) { const int ir = 16 * it + 4 * quad + r; const float gi = gcl[ir];
            if (type == 0) { const float val = (ir > jc) ? betal[ir] * acc[r] * expf(gi - gj) : 0.f; Lf[ir * 68 + jc] = val; Lb[ir * LDP + jc] = (bf16_t)f2bf(val); }
            else { const float val = (ir >= jc) ? acc[r] * expf(gi - gj) : 0.f; Am[ir * LDP + jc] = (bf16_t)f2bf(val); } }
    }
    SYNC();
    if (wave == 0) { const int blk = quad, c = l15; float x[16];
#pragma unroll
        for (int ii = 0; ii < 16; ++ii) { float s = (ii == c) ? 1.f : 0.f;
#pragma unroll
            for (int jx = 0; jx < ii; ++jx) s -= Lf[(16 * blk + ii) * 68 + 16 * blk + jx] * x[jx];
            x[ii] = s; }
#pragma unroll
        for (int ii = 0; ii < 16; ++ii) Tr[(16 * blk + ii) * LDP + 16 * blk + c] = (bf16_t)f2bf(x[ii]);
        *(LDSQ u32x4*)(Tt + (16 * blk + c) * LDP + 16 * blk) = pack8(x); *(LDSQ u32x4*)(Tt + (16 * blk + c) * LDP + 16 * blk + 8) = pack8(x + 8); }
    SYNC();
    if (wave < 2) { const int rb = 2 * wave + 1, cb = 2 * wave; LDSQ bf16_t* pt = PT + wave * 16 * 40;
        bf16x8 a = quad < 2 ? lds_frag(Lb, LDP, 16 * rb + l15, 16 * cb + 8 * quad) : zero_frag();
        bf16x8 bb = quad < 2 ? lds_frag(Tt, LDP, 16 * cb + l15, 16 * cb + 8 * quad) : zero_frag();
        f32x4 z = {0.f, 0.f, 0.f, 0.f}; f32x4 p = mfma16(a, bb, z);
        *(LDSQ u32x2*)(pt + l15 * 40 + 4 * quad) = pack4(p);
        WAVE_LDS_FENCE();
        a = quad < 2 ? lds_frag(Tr, LDP, 16 * rb + l15, 16 * rb + 8 * quad) : zero_frag();
        bb = quad < 2 ? lds_frag(pt, 40, l15, 8 * quad) : zero_frag();
        f32x4 r4 = mfma16(a, bb, z); r4 = -r4;
#pragma unroll
        for (int r = 0; r < 4; ++r) Tr[(16 * rb + 4 * quad + r) * LDP + 16 * cb + l15] = (bf16_t)f2bf(r4[r]);
        *(LDSQ u32x2*)(Tt + (16 * cb + l15) * LDP + 16 * rb + 4 * quad) = pack4(r4); }
    SYNC();
    if (wave < 4) { const int it2 = wave >> 1, jt2 = wave & 1;
        const bf16x8 a = lds_frag(Lb, LDP, 32 + 16 * it2 + l15, 8 * quad), bb = lds_frag(Tt, LDP, 16 * jt2 + l15, 8 * quad);
        f32x4 z = {0.f, 0.f, 0.f, 0.f}; const f32x4 p = mfma16(a, bb, z);
        *(LDSQ u32x2*)(QT + (16 * jt2 + l15) * 40 + 16 * it2 + 4 * quad) = pack4(p); }
    SYNC();
    if (wave < 4) { const int it2 = wave >> 1, jt2 = wave & 1;
        const bf16x8 a = lds_frag(Tr, LDP, 32 + 16 * it2 + l15, 32 + 8 * quad), bb = lds_frag(QT, 40, 16 * jt2 + l15, 8 * quad);
        f32x4 z = {0.f, 0.f, 0.f, 0.f}; f32x4 r4 = mfma16(a, bb, z); r4 = -r4;
#pragma unroll
        for (int r = 0; r < 4; ++r) Tr[(32 + 16 * it2 + 4 * quad + r) * LDP + 16 * jt2 + l15] = (bf16_t)f2bf(r4[r]);
        *(LDSQ u32x2*)(Tt + (16 * jt2 + l15) * LDP + 32 + 16 * it2 + 4 * quad) = pack4(r4); }
    SYNC();
#pragma unroll 1
    for (int jj = 0; jj < 4; ++jj) { const int job = wave * 4 + jj, type = job >> 4, it = (job & 15) >> 2, nt = job & 3;
        f32x4 acc = {0.f, 0.f, 0.f, 0.f};
#pragma unroll
        for (int s = 0; s < 2; ++s) { const bf16x8 a = lds_frag(Tr, LDP, 16 * it + l15, 32 * s + 8 * quad), bb = lds_frag(type ? KbgT : VbT, LDP, 16 * nt + l15, 32 * s + 8 * quad);
            acc = mfma16(a, bb, acc); }
        if (type == 0) *(f32x4*)(gUt + (16 * nt + l15) * 64 + 16 * it + 4 * quad) = acc;
        else {
#pragma unroll
            for (int r = 0; r < 4; ++r) Wm[(16 * it + 4 * quad + r) * LDP + 16 * nt + l15] = (bf16_t)f2bf(acc[r]); } }
    SYNC();
    { const int r = C.tid >> 3, c8 = (C.tid & 7) * 8;
        *(u32x4*)(gWm + r * 64 + c8) = *(const LDSQ u32x4*)(Wm + r * LDP + c8);
        *(u32x4*)(gAm + r * 64 + c8) = *(const LDSQ u32x4*)(Am + r * LDP + c8);
        *(u32x4*)(gKDt + r * 64 + c8) = *(const LDSQ u32x4*)(KDt + r * LDP + c8);
        if (C.tid == 0) WSP(float, WS_GSC)[item] = expf(glast); }
    SYNC();
}

constexpr int SC_ST = 0  , SC_VT = 9216  , SC_SSQ = 18432  ;
DEVFN void gdn_scan_unit(const Ctx& C, int l, int unit) {
    const int b = unit / 6, h = unit % 6;
    const int lane = C.lane, quad = lane >> 4, l15 = lane & 15, w = C.wave;
    const bf16_t* U = WSP(bf16_t, WS_U); bf16_t* MIX = WSP(bf16_t, WS_MIX); const float* GSC = WSP(float, WS_GSC);
    LDSQ bf16_t* ST = (LDSQ bf16_t*)(C.lds + SC_ST) + (w & 3) * 16 * LDP; LDSQ bf16_t* VT = (LDSQ bf16_t*)(C.lds + SC_VT) + (w & 3) * 16 * LDP;
    LDSQ float* ssq = (LDSQ float*)(C.lds + SC_SSQ);
    const bool act = w < 4;
    f32x4 S[4];
#pragma unroll
    for (int kt = 0; kt < 4; ++kt) S[kt] = (f32x4){0.f, 0.f, 0.f, 0.f};
    if (act) {
#pragma unroll
        for (int kt = 0; kt < 4; ++kt) *(LDSQ u32x2*)(ST + l15 * LDP + 16 * kt + 4 * quad) = (u32x2){0u, 0u}; }
    const float nw = C.gdn_norm_w[l * 64 + 16 * (w & 3) + l15];
    SYNC();
#pragma unroll 1
    for (int n = 0; n < 32; ++n) {
        const int item = unit * 32 + n;
        const unsigned char* cbase = C.wsp + WS_GDN + (size_t)item * GDN_CHUNK_BYTES;
        const bf16_t* gWm = (const bf16_t*)cbase; const bf16_t* gQG = (const bf16_t*)(cbase + 8192); const bf16_t* gAm = (const bf16_t*)(cbase + 16384); const bf16_t* gKDt = (const bf16_t*)(cbase + 24576);
        const float* gUt = (const float*)(cbase + 32768);
        f32x4 o[4];
        if (act) {
            f32x4 vn[4];
#pragma unroll
            for (int it = 0; it < 4; ++it) { f32x4 acc = {0.f, 0.f, 0.f, 0.f};
#pragma unroll
                for (int s = 0; s < 2; ++s) acc = mfma16(glb_frag(gWm, 64, 16 * it + l15, 32 * s + 8 * quad), lds_frag(ST, LDP, l15, 32 * s + 8 * quad), acc);
                const f32x4 u4 = *(const f32x4*)(gUt + (16 * w + l15) * 64 + 16 * it + 4 * quad);
                vn[it] = u4 - acc;
                *(LDSQ u32x2*)(VT + l15 * LDP + 16 * it + 4 * quad) = pack4(vn[it]); }
            WAVE_LDS_FENCE();
#pragma unroll
            for (int it = 0; it < 4; ++it) { f32x4 acc = {0.f, 0.f, 0.f, 0.f};
#pragma unroll
                for (int s = 0; s < 2; ++s) acc = mfma16(glb_frag(gQG, 64, 16 * it + l15, 32 * s + 8 * quad), lds_frag(ST, LDP, l15, 32 * s + 8 * quad), acc);
#pragma unroll
                for (int s = 0; s < 2; ++s) acc = mfma16(glb_frag(gAm, 64, 16 * it + l15, 32 * s + 8 * quad), lds_frag(VT, LDP, l15, 32 * s + 8 * quad), acc);
                o[it] = acc; }
            const float dec = GSC[item];
#pragma unroll
            for (int kt = 0; kt < 4; ++kt) { f32x4 acc = S[kt] * dec;
#pragma unroll
                for (int s = 0; s < 2; ++s) acc = mfma16(glb_frag(gKDt, 64, 16 * kt + l15, 32 * s + 8 * quad), lds_frag(VT, LDP, l15, 32 * s + 8 * quad), acc);
                S[kt] = acc; }
            WAVE_LDS_FENCE();
#pragma unroll
            for (int kt = 0; kt < 4; ++kt) *(LDSQ u32x2*)(ST + l15 * LDP + 16 * kt + 4 * quad) = pack4(S[kt]);
#pragma unroll
            for (int it = 0; it < 4; ++it)
#pragma unroll
                for (int r = 0; r < 4; ++r) { float s2 = o[it][r] * o[it][r];
                    s2 += shfl_xor_f(s2, 1); s2 += shfl_xor_f(s2, 2); s2 += shfl_xor_f(s2, 4); s2 += shfl_xor_f(s2, 8);
                    if (l15 == 0) ssq[w * 64 + 16 * it + 4 * quad + r] = s2; }
        }
        SYNC();
        if (act) {
#pragma unroll
            for (int it = 0; it < 4; ++it)
#pragma unroll
                for (int r = 0; r < 4; ++r) { const int ir = 16 * it + 4 * quad + r; const float tot = ssq[ir] + ssq[64 + ir] + ssq[128 + ir] + ssq[192 + ir];
                    const float rstd = 1.0f / sqrtf(tot * (1.f / 64.f) + 1e-6f);
                    const size_t m = (size_t)b * 2048 + 64 * n + ir; const int dv = 16 * w + l15;
                    const float z = bf2f(U[m * NU + UC_BZ + h * 64 + dv]);
                    MIX[m * 1024 + 256 + h * 64 + dv] = (bf16_t)f2bf(o[it][r] * rstd * nw * silu_f(z)); }
        }
        SYNC();
    }
    if (act) { float* og = C.outp + O_GP + ((size_t)(l * NBP + b) * 6 + h) * 4096;
#pragma unroll
        for (int kt = 0; kt < 4; ++kt)
#pragma unroll
            for (int r = 0; r < 4; ++r) og[(16 * kt + 4 * quad + r) * 64 + 16 * w + l15] = S[kt][r]; }
}

DEVFN void gdn_sample_item(const Ctx& C, int l, int witem, LDSQ float* kq) {
    const int b = witem / 6, h = witem % 6, d = C.lane, m0 = M_P + 4 * b;
    const bf16_t* U = WSP(bf16_t, WS_U); bf16_t* MIX = WSP(bf16_t, WS_MIX); const float* AB = WSP(float, WS_AB);
    float qv[4], kv[4], vv[4];
    {
        float xp[3][7];
#pragma unroll
        for (int c = 0; c < 3; ++c) { const int ch = c * 384 + h * 64 + d;
#pragma unroll
            for (int j = 0; j < 3; ++j) xp[c][j] = C.st_conv_b[((size_t)(l * NBS + b) * 3 + j) * 1152 + ch];
#pragma unroll
            for (int i = 0; i < 4; ++i) xp[c][3 + i] = bf2f(U[(size_t)(m0 + i) * NU + (c == 0 ? UC_BQ : c == 1 ? UC_BK : UC_BV) + h * 64 + d]);
#pragma unroll
            for (int j = 0; j < 3; ++j) C.outp[O_CBS + ((size_t)(l * NBS + b) * 3 + j) * 1152 + ch] = xp[c][4 + j];
            float wt[4];
#pragma unroll
            for (int j = 0; j < 4; ++j) wt[j] = C.conv_b_w[(size_t)(l * 4 + j) * 1152 + ch];
#pragma unroll
            for (int i = 0; i < 4; ++i) { const float y = silu_f(wt[0] * xp[c][i] + wt[1] * xp[c][i + 1] + wt[2] * xp[c][i + 2] + wt[3] * xp[c][i + 3]);
                if (c == 0) qv[i] = y; else if (c == 1) kv[i] = y; else vv[i] = y; } }
    }
#pragma unroll
    for (int i = 0; i < 4; ++i) { const float sq = wave_sum(qv[i] * qv[i]), sk = wave_sum(kv[i] * kv[i]); qv[i] *= 0.125f / sqrtf(sq + 1e-6f); kv[i] *= 1.0f / sqrtf(sk + 1e-6f); }
    float S[64];
    const float* s0 = C.st_gdn + ((size_t)(l * NBS + b) * 6 + h) * 4096 + d;
#pragma unroll
    for (int dk = 0; dk < 64; ++dk) S[dk] = s0[dk * 64];
    const float alog = -expf(C.a_log[l * 6 + h]), dtb = C.dt_bias[l * 6 + h], nw = C.gdn_norm_w[l * 64 + d];
#pragma unroll 1
    for (int i = 0; i < 4; ++i) {
        const float g = alog * softplus_f(AB[(size_t)(m0 + i) * 16 + h] + dtb), beta = sigmoid_f(AB[(size_t)(m0 + i) * 16 + 6 + h]);
        const float eg = expf(g);
        float qi = qv[0], ki = kv[0], vi = vv[0];
#pragma unroll
        for (int j = 1; j < 4; ++j) { qi = (i == j) ? qv[j] : qi; ki = (i == j) ? kv[j] : ki; vi = (i == j) ? vv[j] : vi; }
        WAVE_LDS_FENCE();
        kq[d] = ki; kq[64 + d] = qi;
        WAVE_LDS_FENCE();
        float ks0 = 0.f, ks1 = 0.f, ks2 = 0.f, ks3 = 0.f;
#pragma unroll
        for (int d0 = 0; d0 < 64; d0 += 4) { const f32x4 ka = *(const LDSQ f32x4*)(kq + d0);
            ks0 = FMA_OP(ka.x, S[d0], ks0); ks1 = FMA_OP(ka.y, S[d0 + 1], ks1); ks2 = FMA_OP(ka.z, S[d0 + 2], ks2); ks3 = FMA_OP(ka.w, S[d0 + 3], ks3); }
        const float vn = beta * (vi - eg * ((ks0 + ks1) + (ks2 + ks3)));
        float o0 = 0.f, o1 = 0.f, o2 = 0.f, o3 = 0.f;
#pragma unroll
        for (int d0 = 0; d0 < 64; d0 += 4) { const f32x4 ka = *(const LDSQ f32x4*)(kq + d0), qa = *(const LDSQ f32x4*)(kq + 64 + d0);
            S[d0] = FMA_OP(eg, S[d0], ka.x * vn); S[d0 + 1] = FMA_OP(eg, S[d0 + 1], ka.y * vn); S[d0 + 2] = FMA_OP(eg, S[d0 + 2], ka.z * vn); S[d0 + 3] = FMA_OP(eg, S[d0 + 3], ka.w * vn);
            o0 = FMA_OP(qa.x, S[d0], o0); o1 = FMA_OP(qa.y, S[d0 + 1], o1); o2 = FMA_OP(qa.z, S[d0 + 2], o2); o3 = FMA_OP(qa.w, S[d0 + 3], o3); }
        const float o = (o0 + o1) + (o2 + o3);
        const float ssq = wave_sum(o * o); const float rstd = 1.0f / sqrtf(ssq * (1.f / 64.f) + 1e-6f);
        const float z = bf2f(U[(size_t)(m0 + i) * NU + UC_BZ + h * 64 + d]);
        MIX[(size_t)(m0 + i) * 1024 + 256 + h * 64 + d] = (bf16_t)f2bf(o * rstd * nw * silu_f(z));
    }
    float* so = C.outp + O_GS + ((size_t)(l * NBS + b) * 6 + h) * 4096 + d;
#pragma unroll
    for (int dk = 0; dk < 64; ++dk) so[dk * 64] = S[dk];
}

constexpr int AT_K = 0  , AT_Q = 36864  , AT_VT = 55296  , VTP = 296;
DEVFN void rope8(float* x1, float* x2, const float* cs) {
#pragma unroll
    for (int e = 0; e < 8; ++e) { const float a = x1[e], bq = x2[e]; x1[e] = a * cs[e] - bq * cs[8 + e]; x2[e] = bq * cs[e] + a * cs[8 + e]; }
}
DEVFN void attn_prompt_unit(const Ctx& C, int l, int unit) {
    const int g = unit >> 8, uu = unit & 255, b = uu >> 5, h2 = (uu >> 4) & 1, rest = uu & 15;
    const int dil = g == 0 ? 1 : g == 1 ? 4 : 16, nb = g == 0 ? 16 : g == 1 ? 4 : 1, win = g == 0 ? 128 : g == 1 ? 512 : 2048;
    const int r = rest / nb, n = rest % nb, hh = 2 * g + h2;
    const int lane = C.lane, quad = lane >> 4, l15 = lane & 15, w = C.wave;
    const bf16_t* U = WSP(bf16_t, WS_U); const float* ROPE = WSP(float, WS_ROPE); bf16_t* OC = WSP(bf16_t, WS_OC); float* LSE = WSP(float, WS_LSE);
    LDSQ bf16_t* Kl = (LDSQ bf16_t*)(C.lds + AT_K); LDSQ bf16_t* Ql = (LDSQ bf16_t*)(C.lds + AT_Q); LDSQ bf16_t* VT = (LDSQ bf16_t*)(C.lds + AT_VT);
    float* kvout = C.outp + (g == 0 ? O_K128P : g == 1 ? O_K512P : O_K2048P) + (size_t)(l * NBP + b) * win * 256;
    for (int p = 0; p < 4; ++p) { const int idx = C.tid + 512 * p, kk = idx >> 3, c = idx & 7;
        const int mpos = 128 * (n - 1) + kk; const bool ok = mpos >= 0; const int t = mpos * dil + r;
        const bf16_t* ur = U + ((size_t)b * 2048 + (ok ? t : 0)) * NU + hh * 64;
        float v8[8];
        if (ok) unpack8(*(const u32x4*)(ur + UC_CV + 8 * c), v8); else {
#pragma unroll
            for (int e = 0; e < 8; ++e) v8[e] = 0.f; }
#pragma unroll
        for (int e = 0; e < 8; ++e) VT[(8 * c + e) * VTP + kk] = (bf16_t)f2bf(v8[e]);
        const bool wout = (n == nb - 1) && kk >= 128; float* orow = kvout + (size_t)(t - (2048 - win)) * 256 + h2 * 64;
        if (wout) {
#pragma unroll
            for (int e = 0; e < 8; ++e) orow[128 + 8 * c + e] = v8[e]; }
        if (c == 0) { float x1[8], x2[8];
            if (ok) { unpack8(*(const u32x4*)(ur + UC_CK), x1); unpack8(*(const u32x4*)(ur + UC_CK + 8), x2); float cs[16];
#pragma unroll
                for (int e = 0; e < 16; ++e) cs[e] = ROPE[t * 16 + e];
                rope8(x1, x2, cs); }
            else {
#pragma unroll
                for (int e = 0; e < 8; ++e) { x1[e] = 0.f; x2[e] = 0.f; } }
            *(LDSQ u32x4*)(Kl + kk * LDP) = pack8(x1); *(LDSQ u32x4*)(Kl + kk * LDP + 8) = pack8(x2);
            if (wout) {
#pragma unroll
                for (int e = 0; e < 8; ++e) { orow[e] = x1[e]; orow[8 + e] = x2[e]; } } }
        else if (c >= 2) { u32x4 kx = {0u, 0u, 0u, 0u}; if (ok) kx = *(const u32x4*)(ur + UC_CK + 8 * c);
            *(LDSQ u32x4*)(Kl + kk * LDP + 8 * c) = kx;
            if (wout) { float k8[8]; unpack8(kx, k8);
#pragma unroll
                for (int e = 0; e < 8; ++e) orow[8 * c + e] = k8[e]; } }
    }
    for (int p = 0; p < 2; ++p) { const int idx = C.tid + 512 * p, qq = idx >> 3, c = idx & 7;
        const int t = (128 * n + qq) * dil + r; const bf16_t* ur = U + ((size_t)b * 2048 + t) * NU + UC_CQ + hh * 64;
        if (c == 0) { float x1[8], x2[8], cs[16]; unpack8(*(const u32x4*)(ur), x1); unpack8(*(const u32x4*)(ur + 8), x2);
#pragma unroll
            for (int e = 0; e < 16; ++e) cs[e] = ROPE[t * 16 + e];
            rope8(x1, x2, cs);
            *(LDSQ u32x4*)(Ql + qq * LDP) = pack8(x1); *(LDSQ u32x4*)(Ql + qq * LDP + 8) = pack8(x2); }
        else if (c >= 2) *(LDSQ u32x4*)(Ql + qq * LDP + 8 * c) = *(const u32x4*)(ur + 8 * c); }
    for (int e = C.tid; e < 64 * 40; e += 512) VT[(e / 40) * VTP + 256 + (e % 40)] = 0;
    SYNC();
    const int q0 = 16 * w, qi = q0 + l15;
    f32x4 st[9]; float mx = NEG_BIG;
#pragma unroll
    for (int kt = 0; kt < 9; ++kt) { f32x4 acc = {0.f, 0.f, 0.f, 0.f};
#pragma unroll
        for (int s = 0; s < 2; ++s) acc = mfma16(lds_frag(Kl, LDP, 16 * (w + kt) + l15, 32 * s + 8 * quad), lds_frag(Ql, LDP, qi, 32 * s + 8 * quad), acc);
#pragma unroll
        for (int rr = 0; rr < 4; ++rr) { const int kj = 16 * (w + kt) + 4 * quad + rr, dist = 128 + qi - kj; const bool valid = dist >= 0 && dist <= 128 && (n > 0 || kj >= 128);
            acc[rr] = valid ? acc[rr] * 0.125f : NEG_BIG; mx = fmaxf(mx, acc[rr]); }
        st[kt] = acc; }
    mx = fmaxf(mx, shfl_xor_f(mx, 16)); mx = fmaxf(mx, shfl_xor_f(mx, 32));
    float den = 0.f;
#pragma unroll
    for (int kt = 0; kt < 9; ++kt)
#pragma unroll
        for (int rr = 0; rr < 4; ++rr) { const float p = st[kt][rr] > -1e29f ? expf(st[kt][rr] - mx) : 0.f; st[kt][rr] = p; den += p; }
    den += shfl_xor_f(den, 16); den += shfl_xor_f(den, 32);
    const float inv = 1.0f / den;
    const int tq = (128 * n + qi) * dil + r; const size_t mrow = (size_t)b * 2048 + tq;
#pragma unroll
    for (int dt = 0; dt < 4; ++dt) { f32x4 acc = {0.f, 0.f, 0.f, 0.f};
#pragma unroll
        for (int pr = 0; pr < 5; ++pr) { const int ta = 2 * pr, tb = 2 * pr + 1;
            const u32x2 plo = pack4(st[ta]); u32x2 phi = {0u, 0u}; if (tb < 9) phi = pack4(st[tb < 9 ? tb : 8]);
            const u32x4 bu = {plo.x, plo.y, phi.x, phi.y};
            const LDSQ bf16_t* vr = VT + (16 * dt + l15) * VTP + 4 * quad;
            const u32x2 alo = *(const LDSQ u32x2*)(vr + 16 * (w + ta)), ahi = *(const LDSQ u32x2*)(vr + 16 * (w + tb));
            const u32x4 au = {alo.x, alo.y, ahi.x, ahi.y};
            acc = mfma16(__builtin_bit_cast(bf16x8, au), __builtin_bit_cast(bf16x8, bu), acc); }
        *(u32x2*)(OC + mrow * 384 + hh * 64 + 16 * dt + 4 * quad) = pack4(acc * inv); }
    if (quad == 0) LSE[mrow * 8 + hh] = mx + logf(den);
    SYNC();
}

constexpr int AS_NEW = 0  , AS_Q = 4096  , AS_CMB = 6144  ;
DEVFN void attn_sample_item(const Ctx& C, int l, int item) {
    const int b = item / 3, g = item % 3;
    const int dil = g == 0 ? 1 : g == 1 ? 4 : 16, lb = g == 0 ? 128 : g == 1 ? 512 : 2048;
    const float* cache = (g == 0 ? C.kv128 : g == 1 ? C.kv512 : C.kv2048) + (size_t)(l * NBS + b) * lb * 256;
    const bf16_t* U = WSP(bf16_t, WS_U); const float* ROPE = WSP(float, WS_ROPE); bf16_t* OC = WSP(bf16_t, WS_OC); float* LSE = WSP(float, WS_LSE);
    LDSQ float* NEW = (LDSQ float*)(C.lds + AS_NEW); LDSQ float* Qs = (LDSQ float*)(C.lds + AS_Q); LDSQ float* CMB = (LDSQ float*)(C.lds + AS_CMB);
    const int lane = C.lane, w = C.wave;
    {
        const int i2 = C.tid >> 7, e0 = (C.tid & 127) * 2; const size_t m = M_P + 4 * b + i2; const int pos = 2048 + i2;
        float* orow = C.outp + (g == 0 ? O_K128S : g == 1 ? O_K512S : O_K2048S) + ((size_t)(l * NBS + b) * 4 + i2) * 256;
#pragma unroll
        for (int k2 = 0; k2 < 2; ++k2) { const int e = e0 + k2, kvs = e >> 7, h2 = (e >> 6) & 1, d = e & 63; const int hh = 2 * g + h2;
            const bf16_t* ur = U + m * NU + (kvs ? UC_CV : UC_CK) + hh * 64; float val = bf2f(ur[d]);
            if (!kvs && d < 16) { const int f = d & 7; const float cs = ROPE[pos * 16 + f], sn = ROPE[pos * 16 + 8 + f];
                val = d < 8 ? val * cs - bf2f(ur[d + 8]) * sn : val * cs + bf2f(ur[d - 8]) * sn; }
            NEW[i2 * 256 + e] = val; orow[e] = val; }
        const int h2 = (C.tid >> 6) & 1, d = C.tid & 63, hh = 2 * g + h2; const bf16_t* ur = U + m * NU + UC_CQ + hh * 64; float val = bf2f(ur[d]);
        if (d < 16) { const int f = d & 7; const float cs = ROPE[pos * 16 + f], sn = ROPE[pos * 16 + 8 + f];
            val = d < 8 ? val * cs - bf2f(ur[d + 8]) * sn : val * cs + bf2f(ur[d - 8]) * sn; }
        Qs[i2 * 128 + h2 * 64 + d] = val * 0.125f;
    }
    SYNC();
    const int i = w & 3, half = w >> 2;
    const f32x4 q4 = *(const LDSQ f32x4*)(Qs + i * 128 + (lane & 31) * 4);
    float mrun = NEG_BIG, den = 0.f; f32x4 o4 = {0.f, 0.f, 0.f, 0.f};
    const int jn = (dil == 1) ? i + 1 : 1;
#define AS_STEP(x4) do { float part = (lane < 32) ? (q4.x * (x4).x + q4.y * (x4).y) + (q4.z * (x4).z + q4.w * (x4).w) : 0.f; \
        part += shfl_xor_f(part, 1); part += shfl_xor_f(part, 2); part += shfl_xor_f(part, 4); part += shfl_xor_f(part, 8); \
        const float s_ = shfl_f(part, lane & 31); const float mn_ = fmaxf(mrun, s_); const float sc_ = expf(mrun - mn_), p_ = expf(s_ - mn_); \
        den = den * sc_ + p_; o4 = o4 * sc_ + (x4) * p_; mrun = mn_; } while (0)
    if (half == 0) { for (int j = 0; j < jn; ++j) { const f32x4 x4 = *(const LDSQ f32x4*)(NEW + (i - j * dil) * 256 + lane * 4); AS_STEP(x4); } }
    const int j0 = half == 0 ? jn : 65, j1 = half == 0 ? 65 : 129;
    for (int j = j0; j < j1; j += 8) { f32x4 xb[8];
#pragma unroll
        for (int u = 0; u < 8; ++u) { const int jj = (j + u < j1) ? j + u : j1 - 1; xb[u] = *(const f32x4*)(cache + (size_t)(lb + i - jj * dil) * 256 + lane * 4); }
#pragma unroll
        for (int u = 0; u < 8; ++u) if (j + u < j1) AS_STEP(xb[u]); }
#undef AS_STEP
    { LDSQ float* cm = CMB + (w * 64 + lane) * 6; cm[0] = mrun; cm[1] = den; cm[2] = o4.x; cm[3] = o4.y; cm[4] = o4.z; cm[5] = o4.w; }
    SYNC();
    if (half == 0) { const LDSQ float* cm = CMB + ((w + 4) * 64 + lane) * 6; const float m2 = cm[0], d2 = cm[1]; const f32x4 o2 = {cm[2], cm[3], cm[4], cm[5]};
        const float mm = fmaxf(mrun, m2), a1 = expf(mrun - mm), a2 = expf(m2 - mm); const float dt = den * a1 + d2 * a2; const f32x4 o = (o4 * a1 + o2 * a2) * (1.0f / dt);
        const size_t m = M_P + 4 * b + i; const int h2 = (lane >> 4) & 1, hh = 2 * g + h2;
        if (lane >= 32) { *(u32x2*)(OC + m * 384 + hh * 64 + (lane & 15) * 4) = pack4(o); if ((lane & 15) == 0) LSE[m * 8 + hh] = mm + logf(dt); } }
    SYNC();
}

DEVFN void merge_item(const Ctx& C, int item) {
    const bf16_t* U = WSP(bf16_t, WS_U); const bf16_t* OC = WSP(bf16_t, WS_OC); const float* LSE = WSP(float, WS_LSE); bf16_t* MIX = WSP(bf16_t, WS_MIX);
    for (int p = 0; p < 3; ++p) { const int idx = C.tid + 512 * p, rl = idx / 48, c = idx % 48; const size_t m = (size_t)item * 32 + rl;
        const int hh = c >> 3, g = hh >> 1, hp = hh & 1;
        const float l0 = LSE[m * 8 + hp], l1 = LSE[m * 8 + 2 + hp], l2 = LSE[m * 8 + 4 + hp]; const float mx = fmaxf(l0, fmaxf(l1, l2));
        const float e0 = expf(l0 - mx), e1 = expf(l1 - mx), e2 = expf(l2 - mx); const float alpha = (g == 0 ? e0 : g == 1 ? e1 : e2) / (e0 + e1 + e2);
        float o[8], z[8]; unpack8(*(const u32x4*)(OC + m * 384 + 8 * c), o); unpack8(*(const u32x4*)(U + m * NU + UC_CZ + 8 * c), z);
#pragma unroll
        for (int e = 0; e < 8; ++e) o[e] = o[e] * alpha * silu_f(z[e]);
        *(u32x4*)(MIX + m * 1024 + 640 + 8 * c) = pack8(o); }
}

constexpr int N_PREP = 1536, N_ATTP = 768, N_ATTS = 384, N_CONVA = 264;
DEVFN void phase_mid(const Ctx& C0, int l) {
    { const Ctx C = relaunder(C0); for (int it = C.cu; it < N_PREP; it += C.ncu) gdn_prep_item(C, l, it); }
    { const Ctx C = relaunder(C0); for (int it = C.cu; it < N_ATTP; it += C.ncu) attn_prompt_unit(C, l, it); }
    { const Ctx C = relaunder(C0); for (int it = C.cu; it < N_ATTS; it += C.ncu) attn_sample_item(C, l, it); }
    { const Ctx C = relaunder(C0); for (int it = (C.cu + C.ncu / 2) % C.ncu; it < N_CONVA; it += C.ncu) conv_a_item(C, l, it); }
}
constexpr int N_SCAN = 48, N_GS = 96, N_MERGE = 528;
DEVFN void phase_scan(const Ctx& C0, int l) {
    const bool split = C0.ncu > N_SCAN;
    if (C0.cu < N_SCAN || !split) { const Ctx C = relaunder(C0); for (int u = C.cu; u < N_SCAN; u += C.ncu) gdn_scan_unit(C, l, u); }
    if (C0.cu >= N_SCAN || !split) { const int first = split ? C0.cu - N_SCAN : C0.cu, stride = split ? C0.ncu - N_SCAN : C0.ncu;
        { const Ctx C = relaunder(C0); for (int it = first; it < N_GS; it += stride) gdn_sample_item(C, l, it * 8 + C.wave, (LDSQ float*)(C.lds + C.wave * 512)); }
        { const Ctx C = relaunder(C0); for (int it = (first + stride - N_GS % stride) % stride; it < N_MERGE; it += stride) merge_item(C, it); } }
}
constexpr int NWAVES = 8;
constexpr int RING_BYTES = 131072, MISC_OFF = RING_BYTES + 320, LDS_BYTES = 147456;
constexpr int CW_BAR = 4096;
#define GRID_BAR() xcd_barrier(bar)

__device__ __forceinline__ Ctx fresh_ctx(const Args* ap, LDSQ unsigned char* lds) {
    Ctx C; int tid = threadIdx.x; asm volatile("" : "+v"(tid));
    C.tid = tid; C.lane = tid & 63; C.wave = __builtin_amdgcn_readfirstlane(tid >> 6);
    C.ncu = gridDim.x; { const int bx = blockIdx.x; C.cu = (C.ncu % 8 == 0) ? (bx % 8) * (C.ncu / 8) + bx / 8 : bx; }
    C.lds = lds; C.a = ap; return C;
}
template <int L> __device__ __forceinline__ void layer_body(const Args* ap, LDSQ unsigned char* lds, const XcdBarrier& bar) {
        { const Ctx C = fresh_ctx(ap, lds); phase_norm(C, L); }
        GRID_BAR();
        { const Ctx C = fresh_ctx(ap, lds);
            pg8::Gemm g{WSP(bf16_t, WS_HN), WSP(bf16_t, WS_WIN) + (size_t)L * 4096 * 1024, M_T, NU, 1024}; pg8::StaticOrder S; S.init(M_T, NU, C.ncu, (int)blockIdx.x);
            pg8::EpiU E{WSP(bf16_t, WS_U), NU};
            pg8::gemm_phase<pg8::EpiU, pg8::StaticOrder, true, true>(C.lds, g, S, E);
        }
        GRID_BAR();
        { const Ctx C = fresh_ctx(ap, lds); phase_mid(C, L); }
        GRID_BAR();
        { const Ctx C = fresh_ctx(ap, lds); phase_scan(C, L); }
        GRID_BAR();
        { const Ctx C = fresh_ctx(ap, lds);
            pg8::Gemm g{WSP(bf16_t, WS_MIX), WSP(bf16_t, WS_WOUT) + (size_t)L * 1024 * 1024, M_T, 1024, 1024}; pg8::StaticOrder S; S.init(M_T, 1024, C.ncu, (int)blockIdx.x);
            const float* X = WSP(float, WS_X);
            pg8::EpiRes E{L == 0 ? C.x_prompt : X, L == 0 ? C.x_sample : X + (size_t)M_P * 1024, WSP(float, WS_X), WSP(float, WS_MOD) + L * 3072 + 2048};
            pg8::gemm_phase<pg8::EpiRes, pg8::StaticOrder, true, true>(C.lds, g, S, E);
        }
        GRID_BAR();
    }

__global__ void __launch_bounds__(NWAVES * 64, 2) mega_fwd(Args args) {
    extern __shared__ __attribute__((aligned(16))) unsigned char lds_raw[];
    Ctx C;
    C.lds = (LDSQ unsigned char*)lds_raw;
    C.tid = threadIdx.x; C.lane = C.tid & 63; C.wave = __builtin_amdgcn_readfirstlane(C.tid >> 6);
    C.ncu = gridDim.x; { const int bx = blockIdx.x; C.cu = (C.ncu % 8 == 0) ? (bx % 8) * (C.ncu / 8) + bx / 8 : bx; }
    C.a = &args;
    volatile LDSQ unsigned* MISC = (volatile LDSQ unsigned*)(C.lds + MISC_OFF);
    for (int u = C.tid; u < (LDS_BYTES - RING_BYTES) / 4; u += NWAVES * 64) ((LDSQ unsigned*)(C.lds + RING_BYTES))[u] = 0u;
    __syncthreads();
    unsigned* ctl = (unsigned*)(C.wsp + WS_CTL);
    XcdBarrier bar = xcd_barrier_post(ctl + CW_BAR, MISC + 8);

    phase_p0a(C);
    GRID_BAR();
    {
        pg8::Gemm g{WSP(bf16_t, WS_CB), WSP(bf16_t, WS_WADA), 256, NMOD, 1024}; pg8::StaticOrder S; S.init(256, NMOD, C.ncu, (int)blockIdx.x);
        pg8::EpiMod E{WSP(float, WS_MOD), C.b_ada, C.b_ada_final};
        pg8::gemm_phase<pg8::EpiMod, pg8::StaticOrder, false, true>(C.lds, g, S, E);
    }
    GRID_BAR();
    layer_body<0>(&args, C.lds, bar); layer_body<1>(&args, C.lds, bar); layer_body<2>(&args, C.lds, bar); layer_body<3>(&args, C.lds, bar);
    { const Ctx C2 = fresh_ctx(&args, C.lds); phase_final(C2); }
}

extern "C" void kernel_launch(void* const* d_in, const int* in_sizes, int n_in, void* d_out, int out_size, void* d_ws, size_t ws_size, hipStream_t stream) {
    static int grid = 0;
    if (grid == 0) {
        if (n_in != 23 || out_size != (int)O_END || ws_size < WS_END) { fprintf(stderr, "kernel_launch: unexpected shapes: n_in %d out %d ws %zu\n", n_in, out_size, ws_size); grid = -1; return; }
        int dev = 0, cus = 0, per_cu = 0;
        if (hipGetDevice(&dev) != hipSuccess || hipDeviceGetAttribute(&cus, hipDeviceAttributeMultiprocessorCount, dev) != hipSuccess) { grid = -1; return; }
        if (hipFuncSetAttribute((const void*)mega_fwd, hipFuncAttributeMaxDynamicSharedMemorySize, LDS_BYTES) != hipSuccess) { fprintf(stderr, "kernel_launch: hipFuncSetAttribute failed\n"); grid = -1; return; }
        if (hipOccupancyMaxActiveBlocksPerMultiprocessor(&per_cu, (const void*)mega_fwd, NWAVES * 64, LDS_BYTES) != hipSuccess || per_cu < 1) { fprintf(stderr, "kernel_launch: occupancy query says %d\n", per_cu); }
        (void)hipGetLastError();
        grid = cus;
    }
    if (grid < 0) return;
    if (hipMemsetAsync((char*)d_ws + WS_CTL, 0, CTL_ZERO_BYTES, stream) != hipSuccess) return;
    Args ha{};
    for (int i = 0; i < 23; ++i) ha.in[i] = (const float*)d_in[i];
    ha.out_ = (float*)d_out; ha.ws_ = (unsigned char*)d_ws;
    hipLaunchKernelGGL(mega_fwd, dim3(grid), dim3(NWAVES * 64), LDS_BYTES, stream, ha);
}
```

```cpp
#include <hip/hip_runtime.h>
#include <cstdio>
#include <cstdint>
namespace pg8 {
#define PG8_LAS __attribute__((address_space(3)))
typedef unsigned short bf16_t;
typedef short bf16x8 __attribute__((ext_vector_type(8)));
typedef float f32x4 __attribute__((ext_vector_type(4)));
typedef unsigned u32x4 __attribute__((ext_vector_type(4)));
constexpr int BM = 256, BK = 64, HALF = 128, HTB = HALF * BK * 2  , STAGE_BYTES = 8 * HTB, NXCD = 8, WGM = 8;

__host__ __device__ __forceinline__ int lds_byte(int r, int c) { const int st = (r >> 4) * 2 + (c >> 5), rr = r & 15, cc = c & 31, ob = rr * 64 + cc * 2; return st * 1024 + (ob ^ (((ob >> 9) & 1) << 5)); }
__host__ __device__ __forceinline__ void stage_rc(int b, int& R, int& C) { const int st = b / 1024, sb = b % 1024, swz = sb ^ (((sb >> 9) & 1) << 5); R = (st >> 1) * 16 + swz / 64; C = (st & 1) * 32 + (swz % 64) / 2; }
__host__ __device__ __forceinline__ int perm32(int rho) { const int n = rho >> 4, i = rho & 15; return 8 * (i >> 2) + 4 * n + (i & 3); }

struct Unit { int pm, pn; };
struct Gemm { const bf16_t* A; const bf16_t* Bt; int M, N, K; };

struct StaticOrder {
    int nM, nN, nwg, G, c;
    __host__ __device__ void init(int M, int N, int G_, int c_) { nM = M / BM; nN = N / BM; nwg = nM * nN; G = G_; c = c_; }
    __host__ __device__ bool next(int i, Unit& u) const {
        const long L = (long)i * G + c; if (L >= nwg) return false;
        int wgid = (int)L; { const int q = nwg / NXCD, r = nwg % NXCD, xcd = wgid % NXCD, off = wgid / NXCD; wgid = (xcd < r ? xcd * (q + 1) : r * (q + 1) + (xcd - r) * q) + off; }
        const int nig = WGM * nN, gid = wgid / nig, fm = gid * WGM, gsz = (nM - fm) < WGM ? (nM - fm) : WGM;
        u.pm = fm + ((wgid % nig) % gsz); u.pn = (wgid % nig) / gsz; return true;
    }
    __device__ __forceinline__ void a_ready(const Unit&) const {}
    __device__ __forceinline__ void done(const Unit&) const {}
};

__device__ __forceinline__ unsigned cvt_pk_bf16(float lo, float hi) { unsigned r; asm volatile("v_cvt_pk_bf16_f32 %0, %1, %2" : "=v"(r) : "v"(lo), "v"(hi)); return r; }
template <class Epi, class Sched, bool ALIGN_EPI = false, bool SP2 = false>
__device__ __forceinline__ void gemm_phase(PG8_LAS unsigned char* lds, const Gemm g, const Sched& S, const Epi& E) {
    int tid_ = threadIdx.x; asm volatile("" : "+v"(tid_));
    const int tid = tid_, wid = __builtin_amdgcn_readfirstlane(tid >> 6), lane = tid & 63, wr = wid >> 2, wc = wid & 3, fr = lane & 15, fq = lane >> 4;
    const int K = g.K, nt = K / BK;
    unsigned voffA[2], voffB[2];
#pragma unroll
    for (int i = 0; i < 2; ++i) { int R, C; stage_rc(tid * 16 + i * 8192, R, C); const int Rb = Epi::PERM ? ((R & ~31) + perm32(R & 31)) : R;
        voffA[i] = (unsigned)(R * K + C) * 2u; voffB[i] = (unsigned)(Rb * K + C) * 2u; }
    const size_t kstep = (size_t)(BK * 2);
    const size_t hstep = (size_t)HALF * K * 2;
    const size_t tstep = 2 * hstep;
    const unsigned ldsw = (unsigned)wid * 1024u;
    const int aoff = lds_byte(wr * 64 + fr, fq * 8), boff = lds_byte(wc * 32 + fr, fq * 8);
#define PG8_SA(b, h) (((b) * 2 + (h)) * HTB)
#define PG8_SB(b, h) ((4 + (b) * 2 + (h)) * HTB)
#define PG8_STAGE(bufoff, gbase, voff) do { _Pragma("unroll") for (int _i = 0; _i < 2; ++_i) \
        __builtin_amdgcn_global_load_lds((const unsigned*)((const char*)(gbase) + (voff)[_i]), (PG8_LAS unsigned*)(lds + (bufoff) + ldsw + _i * 8192), 16, 0, 0); } while (0)
#define PG8_LDA(dst, b, h) do { _Pragma("unroll") for (int m = 0; m < 4; ++m) _Pragma("unroll") for (int k = 0; k < 2; ++k) dst[m][k] = *(const PG8_LAS bf16x8*)(lds + PG8_SA(b, h) + aoff + m * 2048 + k * 1024); } while (0)
#define PG8_LDB(dst, b, h) do { _Pragma("unroll") for (int n = 0; n < 2; ++n) _Pragma("unroll") for (int k = 0; k < 2; ++k) dst[n][k] = *(const PG8_LAS bf16x8*)(lds + PG8_SB(b, h) + boff + n * 2048 + k * 1024); } while (0)
#define PG8_MMA(ai, bj, At, Bt) do { __builtin_amdgcn_s_setprio(1); _Pragma("unroll") for (int m = 0; m < 4; ++m) _Pragma("unroll") for (int n = 0; n < 2; ++n) _Pragma("unroll") for (int k = 0; k < 2; ++k) \
        acc[ai][bj][m][n] = __builtin_amdgcn_mfma_f32_16x16x32_bf16(Bt[n][k], At[m][k], acc[ai][bj][m][n], 0, 0, 0); __builtin_amdgcn_s_setprio(0); } while (0)
#define PG8_WAIT_V(n) asm volatile("s_waitcnt vmcnt(" #n ")" ::: "memory")
#define PG8_WAIT_L(n) asm volatile("s_waitcnt lgkmcnt(" #n ")" ::: "memory")
#define PG8_BAR __builtin_amdgcn_s_barrier()
#define PG8_SCHED __builtin_amdgcn_sched_barrier(0)
    Unit cur, nxt; int ui = 0;
    if (!S.next(0, cur)) return;
    f32x4 acc[2][2][4][2];
#pragma unroll
    for (int a = 0; a < 2; ++a)
#pragma unroll
        for (int b = 0; b < 2; ++b)
#pragma unroll
            for (int m = 0; m < 4; ++m)
#pragma unroll
                for (int n = 0; n < 2; ++n) acc[a][b][m][n] = (f32x4){0.f, 0.f, 0.f, 0.f};
    bf16x8 At[4][2], B0[2][2], B1[2][2];
    const char* cA = (const char*)g.A + (size_t)cur.pm * tstep; const char* cB = (const char*)g.Bt + (size_t)cur.pn * tstep;
    S.a_ready(cur);
    if constexpr (SP2) {
        PG8_STAGE(PG8_SB(0, 0), cB, voffB); PG8_STAGE(PG8_SB(0, 1), cB + hstep, voffB); PG8_STAGE(PG8_SA(0, 0), cA, voffA); PG8_STAGE(PG8_SA(0, 1), cA + hstep, voffA);
        if (wr == 1) PG8_BAR;
        PG8_WAIT_V(2); PG8_BAR;
        PG8_STAGE(PG8_SB(1, 0), cB + kstep, voffB); PG8_STAGE(PG8_SA(1, 0), cA + kstep, voffA); PG8_STAGE(PG8_SB(1, 1), cB + hstep + kstep, voffB);
        PG8_WAIT_V(6); PG8_BAR;
    } else {
        PG8_STAGE(PG8_SB(0, 0), cB, voffB); PG8_STAGE(PG8_SA(0, 0), cA, voffA); PG8_STAGE(PG8_SB(0, 1), cB + hstep, voffB); PG8_STAGE(PG8_SA(0, 1), cA + hstep, voffA);
        if (wr == 1) PG8_BAR;
        PG8_WAIT_V(4); PG8_BAR;
        PG8_STAGE(PG8_SB(1, 0), cB + kstep, voffB); PG8_STAGE(PG8_SA(1, 0), cA + kstep, voffA); PG8_STAGE(PG8_SB(1, 1), cB + hstep + kstep, voffB);
        PG8_WAIT_V(6); PG8_BAR;
    }
    for (;;) {
        const bool has_next = S.next(ui + 1, nxt);
        const char* nA = has_next ? (const char*)g.A + (size_t)nxt.pm * tstep : cA; const char* nB = has_next ? (const char*)g.Bt + (size_t)nxt.pn * tstep : cB;
        for (int t = 0; t < nt; t += 2) {
            const bool last = (t == nt - 2);
            const char* a1 = cA + (size_t)(t + 1) * kstep;
            const char* a2 = last ? nA : cA + (size_t)(t + 2) * kstep; const char* b2 = last ? nB : cB + (size_t)(t + 2) * kstep;
            const char* a3 = a2 + kstep; const char* b3 = b2 + kstep;
            if (last && has_next) S.a_ready(nxt);
            if constexpr (SP2) {
            PG8_LDB(B0, 0, 0); PG8_LDB(B1, 0, 1); PG8_SCHED; PG8_LDA(At, 0, 0); PG8_STAGE(PG8_SA(1, 1), a1 + hstep, voffA);
            PG8_WAIT_V(8); PG8_WAIT_L(0); PG8_BAR; PG8_MMA(0, 0, At, B0); PG8_MMA(0, 1, At, B1); PG8_BAR; PG8_SCHED;
            PG8_LDA(At, 0, 1); PG8_STAGE(PG8_SB(0, 0), b2, voffB); PG8_STAGE(PG8_SB(0, 1), b2 + hstep, voffB); PG8_STAGE(PG8_SA(0, 0), a2, voffA);
            PG8_WAIT_V(8); PG8_WAIT_L(0); PG8_BAR; PG8_MMA(1, 0, At, B0); PG8_MMA(1, 1, At, B1); PG8_BAR; PG8_SCHED;
            PG8_LDB(B0, 1, 0); PG8_LDB(B1, 1, 1); PG8_SCHED; PG8_LDA(At, 1, 0); PG8_STAGE(PG8_SA(0, 1), a2 + hstep, voffA);
            PG8_WAIT_V(8); PG8_WAIT_L(0); PG8_BAR; PG8_MMA(0, 0, At, B0); PG8_MMA(0, 1, At, B1); PG8_BAR; PG8_SCHED;
            PG8_LDA(At, 1, 1); PG8_STAGE(PG8_SB(1, 0), b3, voffB); PG8_STAGE(PG8_SB(1, 1), b3 + hstep, voffB); PG8_STAGE(PG8_SA(1, 0), a3, voffA);
            PG8_WAIT_V(8); PG8_WAIT_L(0); PG8_BAR; PG8_MMA(1, 0, At, B0); PG8_MMA(1, 1, At, B1); PG8_BAR; PG8_SCHED;
            } else {
            PG8_LDB(B0, 0, 0); PG8_SCHED; PG8_LDA(At, 0, 0); PG8_STAGE(PG8_SA(1, 1), a1 + hstep, voffA);
            PG8_WAIT_L(8); PG8_BAR; PG8_WAIT_L(0); PG8_MMA(0, 0, At, B0); PG8_BAR; PG8_SCHED;
            PG8_LDB(B1, 0, 1); PG8_STAGE(PG8_SB(0, 0), b2, voffB);
            PG8_BAR; PG8_WAIT_L(0); PG8_MMA(0, 1, At, B1); PG8_BAR;
            PG8_LDA(At, 0, 1); PG8_STAGE(PG8_SA(0, 0), a2, voffA);
            PG8_BAR; PG8_WAIT_L(0); PG8_MMA(1, 0, At, B0); PG8_BAR; PG8_SCHED;
            PG8_STAGE(PG8_SB(0, 1), b2 + hstep, voffB);
            PG8_WAIT_V(6); PG8_BAR; PG8_MMA(1, 1, At, B1); PG8_BAR;
            PG8_LDB(B0, 1, 0); PG8_SCHED; PG8_LDA(At, 1, 0); PG8_STAGE(PG8_SA(0, 1), a2 + hstep, voffA);
            PG8_WAIT_L(8); PG8_BAR; PG8_WAIT_L(0); PG8_MMA(0, 0, At, B0); PG8_BAR; PG8_SCHED;
            PG8_LDB(B1, 1, 1); PG8_STAGE(PG8_SB(1, 0), b3, voffB);
            PG8_BAR; PG8_WAIT_L(0); PG8_MMA(0, 1, At, B1); PG8_BAR;
            PG8_LDA(At, 1, 1); PG8_STAGE(PG8_SA(1, 0), a3, voffA);
            PG8_BAR; PG8_WAIT_L(0); PG8_MMA(1, 0, At, B0); PG8_BAR; PG8_SCHED;
            PG8_STAGE(PG8_SB(1, 1), b3 + hstep, voffB);
            PG8_WAIT_V(6); PG8_BAR; PG8_MMA(1, 1, At, B1); PG8_BAR;
            }
        }
        if constexpr (ALIGN_EPI) { if (wr == 0) PG8_BAR; }
        if constexpr (!Epi::AFTER_DRAIN) { E(acc, cur, wr, wc, fr, fq); S.done(cur); }
        if (!has_next) break;
#pragma unroll
        for (int a = 0; a < 2; ++a)
#pragma unroll
            for (int b = 0; b < 2; ++b)
#pragma unroll
                for (int m = 0; m < 4; ++m)
#pragma unroll
                    for (int n = 0; n < 2; ++n) acc[a][b][m][n] = (f32x4){0.f, 0.f, 0.f, 0.f};
        cur = nxt; cA = nA; cB = nB; ++ui;
        if constexpr (ALIGN_EPI) { if (wr == 1) PG8_BAR; }
    }
    PG8_WAIT_V(0);
    if constexpr (!ALIGN_EPI) { if (wr == 0) PG8_BAR; }
    PG8_BAR;
    if constexpr (Epi::AFTER_DRAIN) { E.fused(acc, cur, wr, wc, fr, fq, lds, wid, lane); S.done(cur); }
#undef PG8_SA
#undef PG8_SB
#undef PG8_STAGE
#undef PG8_LDA
#undef PG8_LDB
#undef PG8_MMA
#undef PG8_WAIT_V
#undef PG8_WAIT_L
#undef PG8_BAR
#undef PG8_SCHED
}
}
namespace pg8 {
struct EpiU { static constexpr bool PERM = true, AFTER_DRAIN = false; bf16_t* O; int ldc;
    __device__ __forceinline__ void operator()(const f32x4 (&acc)[2][2][4][2], const Unit& u, int wr, int wc, int fr, int fq) const {
        const int row0 = u.pm * BM + wr * 64 + fr, col0 = u.pn * BM + wc * 32 + 8 * fq;
#pragma unroll
        for (int ai = 0; ai < 2; ++ai)
#pragma unroll
            for (int m = 0; m < 4; ++m) { bf16_t* rowp = O + (size_t)(row0 + ai * HALF + m * 16) * ldc + col0;
#pragma unroll
                for (int bj = 0; bj < 2; ++bj) { const f32x4 v0 = acc[ai][bj][m][0], v1 = acc[ai][bj][m][1];
                    u32x4 w; w.x = cvt_pk_bf16(v0[0], v0[1]); w.y = cvt_pk_bf16(v0[2], v0[3]); w.z = cvt_pk_bf16(v1[0], v1[1]); w.w = cvt_pk_bf16(v1[2], v1[3]);
                    *(u32x4*)(rowp + bj * HALF) = w; } }
    }
};
struct EpiMod { static constexpr bool PERM = false, AFTER_DRAIN = false; float* O; const float* b_ada; const float* b_fin;
    __device__ __forceinline__ void operator()(const f32x4 (&acc)[2][2][4][2], const Unit& u, int wr, int wc, int fr, int fq) const {
        const int colt = u.pn * BM; const float* bias = colt < 12288 ? b_ada + colt : b_fin + (colt - 12288);
        const int cl = wc * 32 + 4 * fq;
#pragma unroll
        for (int ai = 0; ai < 2; ++ai)
#pragma unroll
            for (int m = 0; m < 4; ++m) { const int row = ai * HALF + wr * 64 + m * 16 + fr;
                if (row < 136) {
#pragma unroll
                    for (int bj = 0; bj < 2; ++bj)
#pragma unroll
                        for (int n = 0; n < 2; ++n) { const int c = cl + bj * HALF + n * 16; const f32x4 bv = *(const f32x4*)(bias + c);
                            *(f32x4*)(O + (size_t)row * 14336 + colt + c) = acc[ai][bj][m][n] + bv; } } }
    }
};
struct EpiRes { static constexpr bool PERM = false, AFTER_DRAIN = false; const float* base_p; const float* base_s; float* X; const float* gate0;
    __device__ __forceinline__ void operator()(const f32x4 (&acc)[2][2][4][2], const Unit& u, int wr, int wc, int fr, int fq) const {
        const int cl = u.pn * BM + wc * 32 + 4 * fq;
#pragma unroll
        for (int ai = 0; ai < 2; ++ai)
#pragma unroll
            for (int m = 0; m < 4; ++m) { const int row = u.pm * BM + ai * HALF + wr * 64 + m * 16 + fr;
                const float* b = row < 16384 ? base_p + (size_t)row * 1024 : base_s + (size_t)(row - 16384) * 1024;
                const int brow = row < 16384 ? (row >> 11) : 8 + ((row - 16384) >> 2);
                const float* g = gate0 + (size_t)brow * 14336; float* o = X + (size_t)row * 1024;
#pragma unroll
                for (int bj = 0; bj < 2; ++bj)
#pragma unroll
                    for (int n = 0; n < 2; ++n) { const int c = cl + bj * HALF + n * 16; const f32x4 bv = *(const f32x4*)(b + c), gv = *(const f32x4*)(g + c);
                        *(f32x4*)(o + c) = bv + (gv + 1.0f) * acc[ai][bj][m][n]; } }
    }
};
}
using pg8::bf16_t; using pg8::bf16x8; using pg8::f32x4; using pg8::u32x4;
#ifdef HOST_EMU
#define DEVFN static inline
#define LDSQ
#define GASQ
#else
#define DEVFN __device__ __forceinline__
#define LDSQ __attribute__((address_space(3)))
#define GASQ __attribute__((address_space(1)))
#endif
typedef short s16x4 __attribute__((ext_vector_type(4)));
typedef float f32x2 __attribute__((ext_vector_type(2)));
typedef unsigned u32x2 __attribute__((ext_vector_type(2)));

constexpr int D_MODEL = 1024, SEQ = 2048, NBP = 8, NBS = 128, DSEQ = 4, DEPTH = 4;
constexpr int M_P = NBP * SEQ, M_S = NBS * DSEQ, M_T = M_P + M_S;
constexpr int IN_W = 4108, NU = 4096, NBROW = NBP + NBS;
constexpr int NMOD = 4 * 3072 + 2048;
constexpr int UC_AX = 0, UC_ACG = 256, UC_ABG = 512, UC_AZ = 768, UC_BQ = 1024, UC_BK = 1408, UC_BV = 1792, UC_BZ = 2176, UC_CQ = 2560, UC_CK = 2944, UC_CV = 3328, UC_CZ = 3712;
constexpr size_t MiB = 1u << 20;
constexpr size_t WS_CTL = 0, CTL_ZERO_BYTES = 1 * MiB;
constexpr size_t WS_WIN = 2 * MiB;
constexpr size_t WS_WOUT = 34 * MiB;
constexpr size_t WS_WADA = 42 * MiB;
constexpr size_t WS_WAB = 70 * MiB;
constexpr size_t WS_ROPE = 71 * MiB;
constexpr size_t WS_CB = 72 * MiB;
constexpr size_t WS_MOD = 73 * MiB;
constexpr size_t WS_AB = 82 * MiB;
constexpr size_t WS_LSE = 84 * MiB;
constexpr size_t WS_GSC = 86 * MiB;
constexpr size_t WS_X = 96 * MiB;
constexpr size_t WS_HN = 162 * MiB;
constexpr size_t WS_MIX = 196 * MiB;
constexpr size_t WS_OC = 230 * MiB;
constexpr size_t WS_U = 256 * MiB;
constexpr size_t WS_GDN = 400 * MiB;
constexpr size_t GDN_CHUNK_BYTES = 40960;
constexpr size_t WS_END = 480 * MiB;
constexpr size_t O_YP = 0, O_YS = 16777216, O_CAP = 17301504, O_CAS = 17317888, O_CBP = 17580032, O_CBS = 17690624, O_GP = 19460096, O_GS = 20246528,
                 O_K128P = 32829440, O_K128S = 33878016, O_K512P = 34402304, O_K512S = 38596608, O_K2048P = 39120896, O_K2048S = 55898112, O_END = 56422400;

DEVFN float bf_lo(unsigned u) { return __builtin_bit_cast(float, u << 16); }
DEVFN float bf_hi(unsigned u) { return __builtin_bit_cast(float, u & 0xffff0000u); }
DEVFN float bf2f(bf16_t h) { return __builtin_bit_cast(float, (unsigned)h << 16); }
DEVFN unsigned f2bf(float f) { unsigned u = __builtin_bit_cast(unsigned, f); return (u + 0x7fffu + ((u >> 16) & 1u)) >> 16; }
DEVFN unsigned pk2(float lo, float hi) { return f2bf(lo) | (f2bf(hi) << 16); }
DEVFN void unpack8(u32x4 v, float* f) { f[0] = bf_lo(v.x); f[1] = bf_hi(v.x); f[2] = bf_lo(v.y); f[3] = bf_hi(v.y); f[4] = bf_lo(v.z); f[5] = bf_hi(v.z); f[6] = bf_lo(v.w); f[7] = bf_hi(v.w); }
DEVFN u32x4 pack8(const float* f) { u32x4 v; v.x = pk2(f[0], f[1]); v.y = pk2(f[2], f[3]); v.z = pk2(f[4], f[5]); v.w = pk2(f[6], f[7]); return v; }
DEVFN float silu_f(float x) { return x / (1.f + expf(-x)); }
DEVFN float sigmoid_f(float x) { return 1.f / (1.f + expf(-x)); }
DEVFN float softplus_f(float x) { return x > 20.f ? x : log1pf(expf(x)); }

struct Args { const float* in[23]; float* out_; unsigned char* ws_; };
struct Ctx {
    int tid, lane, wave, cu, ncu;
    LDSQ unsigned char* lds;
    const Args* a;
};
#define x_prompt a->in[0]
#define x_sample a->in[1]
#define st_conv_a a->in[2]
#define st_conv_b a->in[3]
#define st_gdn a->in[4]
#define kv128 a->in[5]
#define kv512 a->in[6]
#define kv2048 a->in[7]
#define c_prompt a->in[8]
#define c_sample a->in[9]
#define w_in a->in[10]
#define w_out a->in[11]
#define w_ada a->in[12]
#define b_ada a->in[13]
#define norm_w a->in[14]
#define conv_a_w a->in[15]
#define conv_b_w a->in[16]
#define a_log a->in[17]
#define dt_bias a->in[18]
#define gdn_norm_w a->in[19]
#define final_norm_w a->in[20]
#define w_ada_final a->in[21]
#define b_ada_final a->in[22]
#define outp a->out_
#define wsp a->ws_
#define WSP(T, off) ((T*)(C.wsp + (off)))
#define LAS __attribute__((address_space(3)))
#define XB_TMO      128
#define XB_XCNT(j)  (256  + 64 * (j))
#define XB_XSUB(j)  (1280 + 64 * (j))
#define XB_XGEN(j)  (2304 + 64 * (j))
#define XB_TOP      3328
#define XB_TOPGEN   3392
#define XCD_BAR_WORDS 3456
#define XB_SPIN_CAP (1u << 18)

__device__ __forceinline__ unsigned xb_ld(unsigned* p)              { return __hip_atomic_load(p, __ATOMIC_RELAXED, __HIP_MEMORY_SCOPE_AGENT); }
__device__ __forceinline__ unsigned xb_add(unsigned* p, unsigned v) { return __hip_atomic_fetch_add(p, v, __ATOMIC_RELAXED, __HIP_MEMORY_SCOPE_AGENT); }
__device__ __forceinline__ unsigned xb_xcc_id() { return (unsigned)__builtin_amdgcn_s_getreg((3 << 11) | 20) & 0xFu; }
#define XB_SPIN(cond, bar) do { unsigned _sp = 0; while (cond) { __builtin_amdgcn_s_sleep(1); \
    if ((++_sp & 255u) == 0u) { if (xb_ld(&(bar)[XB_TMO])) break; if (_sp > XB_SPIN_CAP) { atomicAdd(&(bar)[XB_TMO], 1u); break; } } } } while (0)

struct XcdBarrier {
    unsigned* bar; unsigned x;
    volatile LAS unsigned* st;
};

__device__ __forceinline__ XcdBarrier xcd_barrier_post(unsigned* bar, volatile LAS unsigned* st) {
    XcdBarrier b; b.bar = bar; b.x = xb_xcc_id(); b.st = st;
    if (threadIdx.x == 0) (void)xb_add(&bar[XB_XCNT(b.x)], 1u);
    return b;
}
__device__ __forceinline__ void xcd_barrier_complete(unsigned* bar, unsigned x, unsigned& nloc, unsigned& nx) {
    const unsigned G = gridDim.x * gridDim.y * gridDim.z;
    unsigned sum, cnt, mine, sp = 0u;
    for (;;) {
        sum = 0u; cnt = 0u; mine = 0u;
#pragma unroll
        for (unsigned j = 0; j < 16; ++j) { const unsigned c = xb_ld(&bar[XB_XCNT(j)]); sum += c; cnt += (c > 0u) ? 1u : 0u; mine = (j == x) ? c : mine; }
        if (sum == G) break;
        __builtin_amdgcn_s_sleep(1);
        if ((++sp & 255u) == 0u) { if (xb_ld(&bar[XB_TMO])) break; if (sp > XB_SPIN_CAP) { atomicAdd(&bar[XB_TMO], 1u); break; } }
    }
    nloc = mine > 0u ? mine : 1u; nx = cnt > 0u ? cnt : 1u;
}

__device__ __forceinline__ void xcd_barrier(const XcdBarrier& b) {
    asm volatile("s_waitcnt vmcnt(0)" ::: "memory");
    __syncthreads();
    if (threadIdx.x == 0) {
        unsigned* bar = b.bar;
        __builtin_amdgcn_s_waitcnt(0);
        unsigned nloc = b.st[0], nx = b.st[1];
        if (nloc == 0u) { xcd_barrier_complete(bar, b.x, nloc, nx); b.st[0] = nloc; b.st[1] = nx; }
        const unsigned old = xb_add(&bar[XB_XSUB(b.x)], 1u);
        const unsigned gen = old / nloc;
        if (old + 1u == (gen + 1u) * nloc) {
            __builtin_amdgcn_fence(__ATOMIC_RELEASE, "agent");
            asm volatile("s_waitcnt vmcnt(0)" ::: "memory");
            const unsigned og = xb_add(&bar[XB_TOP], 1u);
            const unsigned tg = og / nx;
            if (og + 1u == (tg + 1u) * nx) xb_add(&bar[XB_TOPGEN], 1u);
            else XB_SPIN(xb_ld(&bar[XB_TOPGEN]) == tg, bar);
            __builtin_amdgcn_fence(__ATOMIC_ACQUIRE, "agent");
            xb_add(&bar[XB_XGEN(b.x)], 1u);
            asm volatile("s_waitcnt vmcnt(0)" ::: "memory");
        } else {
            XB_SPIN(xb_ld(&bar[XB_XGEN(b.x)]) == gen, bar);
            __builtin_amdgcn_fence(__ATOMIC_ACQUIRE, "agent");
            asm volatile("s_waitcnt vmcnt(0)" ::: "memory");
        }
    }
    __syncthreads();
}
#define SYNC() __syncthreads()
#define WAVE_LDS_FENCE() do { asm volatile("s_waitcnt lgkmcnt(0)" ::: "memory"); } while (0)
#define COMPILER_MEM_FENCE() asm volatile("" ::: "memory")
#define FAST_SIN(x) __sinf(x)
#define FAST_COS(x) __cosf(x)
DEVFN f32x4 mfma16(bf16x8 a, bf16x8 b, f32x4 c) { return __builtin_amdgcn_mfma_f32_16x16x32_bf16(a, b, c, 0, 0, 0); }
DEVFN float shfl_xor_f(float v, int m) { return __shfl_xor(v, m); }
DEVFN float shfl_f(float v, int src) { return __shfl(v, src); }
DEVFN float shfl_up_f(float v, int d) { return __shfl_up(v, d); }
DEVFN Ctx relaunder(const Ctx& C0) {
    Ctx C = C0; int tid = C0.tid; asm volatile("" : "+v"(tid)); C.tid = tid; C.lane = tid & 63; C.wave = __builtin_amdgcn_readfirstlane(tid >> 6); return C;
}
DEVFN float FMA_OP(float a, float b, float c) { float r; asm("v_fma_f32 %0, %1, %2, %3" : "=v"(r) : "v"(a), "v"(b), "v"(c)); return r; }
DEVFN float wave_sum(float v) {
#pragma unroll
    for (int o = 1; o < 64; o <<= 1) v += shfl_xor_f(v, o);
    return v;
}
DEVFN void p0_transpose_item(const float* W, int N, int nsrc0, bf16_t* WT, int ndst0, int k0, LDSQ float* scr, int lane) {
#pragma unroll 8
    for (int i = 0; i < 32; ++i) { const int kk = 2 * i + (lane >> 5); scr[kk * 33 + (lane & 31)] = W[(size_t)(k0 + kk) * N + nsrc0 + (lane & 31)]; }
    WAVE_LDS_FENCE();
    const int c = lane & 7;
#pragma unroll
    for (int j = 0; j < 4; ++j) { const int n = (lane >> 3) + 8 * j; const LDSQ float* s = scr + (8 * c) * 33 + n;
        u32x4 o; o.x = pk2(s[0 * 33], s[1 * 33]); o.y = pk2(s[2 * 33], s[3 * 33]); o.z = pk2(s[4 * 33], s[5 * 33]); o.w = pk2(s[6 * 33], s[7 * 33]);
        *(u32x4*)(WT + (size_t)(ndst0 + n) * 1024 + k0 + 8 * c) = o; }
    WAVE_LDS_FENCE();
}
DEVFN void phase_p0a(const Ctx& C) {
    LDSQ float* scr = (LDSQ float*)(C.lds + C.wave * 16384);
    const int gw = C.cu * 8 + C.wave, NGW = C.ncu * 8;
    bf16_t* WIN = WSP(bf16_t, WS_WIN); bf16_t* WOUT = WSP(bf16_t, WS_WOUT); bf16_t* WADA = WSP(bf16_t, WS_WADA);
    constexpr int I_IN = 4 * 16 * 128, I_OUT = 4 * 16 * 32, I_ADA = 4 * 16 * 96, I_FIN = 16 * 64;
    for (int it = gw; it < I_IN + I_OUT + I_ADA + I_FIN; it += NGW) {
        int r = it;
        if (r < I_IN) { const int l = r / 2048, rr = r % 2048, kb = rr / 128, nb = rr % 128, nd = 32 * nb, ns = nd < 2560 ? nd : nd + 12;
            p0_transpose_item(C.w_in + (size_t)l * 1024 * IN_W, IN_W, ns, WIN + (size_t)l * 4096 * 1024, nd, 64 * kb, scr, C.lane); continue; }
        r -= I_IN;
        if (r < I_OUT) { const int l = r / 512, rr = r % 512, kb = rr / 32, nb = rr % 32;
            p0_transpose_item(C.w_out + (size_t)l * 1024 * 1024, 1024, 32 * nb, WOUT + (size_t)l * 1024 * 1024, 32 * nb, 64 * kb, scr, C.lane); continue; }
        r -= I_OUT;
        if (r < I_ADA) { const int l = r / 1536, rr = r % 1536, kb = rr / 96, nb = rr % 96;
            p0_transpose_item(C.w_ada + (size_t)l * 1024 * 3072, 3072, 32 * nb, WADA + (size_t)l * 3072 * 1024, 32 * nb, 64 * kb, scr, C.lane); continue; }
        r -= I_ADA;
        { const int kb = r / 64, nb = r % 64;
            p0_transpose_item(C.w_ada_final, 2048, 32 * nb, WADA + (size_t)12288 * 1024, 32 * nb, 64 * kb, scr, C.lane); }
    }
    const int gt = C.cu * 512 + C.tid, NGT = C.ncu * 512;
    float* WAB = WSP(float, WS_WAB);
    for (int i = gt; i < 4 * 12 * 1024; i += NGT) { const int l = i / 12288, j = (i / 1024) % 12, k = i % 1024; WAB[i] = C.w_in[((size_t)l * 1024 + k) * IN_W + 2560 + j]; }
    unsigned* CB = WSP(unsigned, WS_CB);
    for (int i = gt; i < 256 * 512; i += NGT) { const int row = i / 512, c = 2 * (i % 512); float a = 0.f, b = 0.f;
        if (row < NBP) { a = C.c_prompt[row * 1024 + c]; b = C.c_prompt[row * 1024 + c + 1]; }
        else if (row < NBROW) { a = C.c_sample[(row - NBP) * 1024 + c]; b = C.c_sample[(row - NBP) * 1024 + c + 1]; }
        CB[i] = pk2(a, b); }
    float* ROPE = WSP(float, WS_ROPE);
    for (int i = gt; i < 2052 * 8; i += NGT) { const int pos = i >> 3, j = i & 7;
        const float invf[8] = {1.0f, 0.1939227432012558f, 0.03760603070259094f, 0.007292664609849453f, 0.0014142135623842478f, 0.00027424818836152554f, 5.3182957344688475e-05f, 1.0313385246263351e-05f};
        float fr = 1.0f;
#pragma unroll
        for (int q = 0; q < 8; ++q) fr = (j == q) ? invf[q] : fr;
        const float ang = (float)pos * fr;
        const double a = (double)ang, tw = 6.283185307179586476925;
        const double kq = __builtin_floor(a / tw + 0.5); const float red = (float)(a - kq * tw);
        ROPE[pos * 16 + j] = FAST_COS(red); ROPE[pos * 16 + 8 + j] = FAST_SIN(red); }
}
DEVFN int brow_of(int m) { return m < M_P ? (m >> 11) : NBP + ((m - M_P) >> 2); }
DEVFN const float* xrow_l0(const Ctx& C, int m) { return m < M_P ? C.x_prompt + (size_t)m * 1024 : C.x_sample + (size_t)(m - M_P) * 1024; }
DEVFN void phase_norm(const Ctx& C, int l) {
    const int gw = C.cu * 8 + C.wave, NGW = C.ncu * 8;
    const float* X = WSP(float, WS_X); bf16_t* HN = WSP(bf16_t, WS_HN); float* AB = WSP(float, WS_AB);
    const float* MOD = WSP(float, WS_MOD); const float* WAB = WSP(float, WS_WAB) + l * 12 * 1024;
    const f32x4* nw = (const f32x4*)(C.norm_w + l * 1024) + C.lane;
    for (int m = gw; m < M_T; m += NGW) {
        const f32x4* xr = (const f32x4*)(l == 0 ? xrow_l0(C, m) : X + (size_t)m * 1024) + C.lane;
        const float* mod = MOD + (size_t)brow_of(m) * NMOD + l * 3072;
        f32x4 v[4]; float s = 0.f;
#pragma unroll
        for (int j = 0; j < 4; ++j) { v[j] = xr[64 * j]; s += (v[j].x * v[j].x + v[j].y * v[j].y) + (v[j].z * v[j].z + v[j].w * v[j].w); }
        const float rstd = 1.f / sqrtf(wave_sum(s) * (1.f / 1024.f) + 1e-6f);
#pragma unroll
        for (int j = 0; j < 4; ++j) { const f32x4 w = nw[64 * j], sh = ((const f32x4*)mod)[64 * j + C.lane], sc = ((const f32x4*)(mod + 1024))[64 * j + C.lane];
            v[j] = v[j] * rstd * w * (sc + 1.0f) + sh; }
        u32x2* o8 = (u32x2*)(HN + (size_t)m * 1024) + C.lane;
#pragma unroll
        for (int j = 0; j < 4; ++j) { u32x2 o; o.x = pk2(v[j].x, v[j].y); o.y = pk2(v[j].z, v[j].w); o8[64 * j] = o; }
        float myab = 0.f;
#pragma unroll
        for (int q = 0; q < 12; ++q) { float d = 0.f;
#pragma unroll
            for (int j = 0; j < 4; ++j) { const f32x4 w = ((const f32x4*)(WAB + q * 1024))[64 * j + C.lane]; d += (v[j].x * w.x + v[j].y * w.y) + (v[j].z * w.z + v[j].w * w.w); }
            d = wave_sum(d); myab = (C.lane == q) ? d : myab; }
        if (C.lane < 12) AB[(size_t)m * 16 + C.lane] = myab;
    }
}
DEVFN void phase_final(const Ctx& C) {
    const int gw = C.cu * 8 + C.wave, NGW = C.ncu * 8;
    const float* X = WSP(float, WS_X); const float* MOD = WSP(float, WS_MOD);
    const f32x4* nw = (const f32x4*)C.final_norm_w + C.lane;
    for (int m = gw; m < M_T; m += NGW) {
        const f32x4* xr = (const f32x4*)(X + (size_t)m * 1024) + C.lane;
        const float* mod = MOD + (size_t)brow_of(m) * NMOD + 12288;
        f32x4 v[4]; float s = 0.f;
#pragma unroll
        for (int j = 0; j < 4; ++j) { v[j] = xr[64 * j]; s += (v[j].x * v[j].x + v[j].y * v[j].y) + (v[j].z * v[j].z + v[j].w * v[j].w); }
        const float rstd = 1.f / sqrtf(wave_sum(s) * (1.f / 1024.f) + 1e-6f);
        f32x4* o = (f32x4*)(C.outp + (m < M_P ? O_YP + (size_t)m * 1024 : O_YS + (size_t)(m - M_P) * 1024)) + C.lane;
#pragma unroll
        for (int j = 0; j < 4; ++j) { const f32x4 w = nw[64 * j], sh = ((const f32x4*)mod)[64 * j + C.lane], sc = ((const f32x4*)(mod + 1024))[64 * j + C.lane];
            o[64 * j] = v[j] * rstd * w * (sc + 1.0f) + sh; }
    }
}
DEVFN bf16x8 lds_frag(const LDSQ bf16_t* base, int ld, int row, int col) { return *(const LDSQ bf16x8*)(base + row * ld + col); }
DEVFN bf16x8 glb_frag(const bf16_t* base, int ld, int row, int col) { return *(const bf16x8*)(base + (size_t)row * ld + col); }
DEVFN bf16x8 zero_frag() { bf16x8 z = {0, 0, 0, 0, 0, 0, 0, 0}; return z; }
DEVFN u32x2 pack4(f32x4 v) { u32x2 o; o.x = pk2(v.x, v.y); o.y = pk2(v.z, v.w); return o; }
constexpr int LDP = 72;
constexpr float NEG_BIG = -1e30f;
DEVFN int inv_perm(int c) { return (c & 32) | (((c >> 2) & 3) << 3) | (((c >> 4) & 1) << 2) | (c & 3); }
DEVFN bf16x8 acc_pair_frag(f32x4 lo, f32x4 hi) { const u32x4 u = {pk2(lo.x, lo.y), pk2(lo.z, lo.w), pk2(hi.x, hi.y), pk2(hi.z, hi.w)}; return __builtin_bit_cast(bf16x8, u); }

DEVFN void conv_a_item(const Ctx& C, int l, int item) {
    const bf16_t* U = WSP(bf16_t, WS_U); bf16_t* MIX = WSP(bf16_t, WS_MIX);
    const int rl = C.tid >> 5, ch = (C.tid & 31) * 8;
    float w[3][8];
#pragma unroll
    for (int j = 0; j < 3; ++j)
#pragma unroll
        for (int e = 0; e < 8; ++e) w[j][e] = C.conv_a_w[(l * 3 + j) * 256 + ch + e];
    for (int pass = 0; pass < 4; ++pass) {
        const int m = item * 64 + pass * 16 + rl;
        const bool smp = m >= M_P; const int b = smp ? (m - M_P) >> 2 : m >> 11, t = smp ? (m - M_P) & 3 : m & 2047;
        float P[3][8];
#pragma unroll
        for (int j = 0; j < 3; ++j) { const int tt = t - 2 + j;
            if (tt >= 0) { const size_t r = (size_t)(m - 2 + j) * NU; float a[8], c[8];
                unpack8(*(const u32x4*)(U + r + UC_AX + ch), a); unpack8(*(const u32x4*)(U + r + UC_ACG + ch), c);
#pragma unroll
                for (int e = 0; e < 8; ++e) P[j][e] = a[e] * c[e]; }
            else if (smp) { const float* s = C.st_conv_a + ((size_t)(l * NBS + b) * 2 + (tt + 2)) * 256 + ch;
#pragma unroll
                for (int e = 0; e < 8; ++e) P[j][e] = s[e]; }
            else {
#pragma unroll
                for (int e = 0; e < 8; ++e) P[j][e] = 0.f; } }
        float bg[8], z[8], y[8];
        unpack8(*(const u32x4*)(U + (size_t)m * NU + UC_ABG + ch), bg); unpack8(*(const u32x4*)(U + (size_t)m * NU + UC_AZ + ch), z);
#pragma unroll
        for (int e = 0; e < 8; ++e) y[e] = bg[e] * (w[0][e] * P[0][e] + w[1][e] * P[1][e] + w[2][e] * P[2][e]) * silu_f(z[e]);
        *(u32x4*)(MIX + (size_t)m * 1024 + ch) = pack8(y);
        const int last = smp ? 4 : 2048;
        if (t >= last - 2) { float* o = C.outp + (smp ? O_CAS + ((size_t)(l * NBS + b) * 2 + (t - 2)) * 256 : O_CAP + ((size_t)(l * NBP + b) * 2 + (t - 2046)) * 256) + ch;
#pragma unroll
            for (int e = 0; e < 8; ++e) o[e] = P[2][e]; }
    }
}

constexpr int GP_KN = 0, GP_QN = 9216, GP_VBT = 18432, GP_KBGT = 27648, GP_KDT = 36864, GP_LB = 46080, GP_TR = 55296, GP_TT = 64512, GP_AM = 73728, GP_WM = 82944,
              GP_LF = 92160  , GP_PT = 109568  , GP_QT = 112128  , GP_G = 114688  ;
DEVFN void gdn_prep_item(const Ctx& C, int l, int item) {
    const int b = item / 192, h = (item / 32) % 6, n = item % 32;
    const int lane = C.lane, quad = lane >> 4, l15 = lane & 15, wave = C.wave;
    const bf16_t* U = WSP(bf16_t, WS_U); const float* AB = WSP(float, WS_AB);
    unsigned char* cbase = C.wsp + WS_GDN + (size_t)item * GDN_CHUNK_BYTES;
    bf16_t* gWm = (bf16_t*)cbase; bf16_t* gQG = (bf16_t*)(cbase + 8192); bf16_t* gAm = (bf16_t*)(cbase + 16384); bf16_t* gKDt = (bf16_t*)(cbase + 24576); bf16_t* gUt = (bf16_t*)(cbase + 32768);
    LDSQ bf16_t* Kn = (LDSQ bf16_t*)(C.lds + GP_KN); LDSQ bf16_t* Qn = (LDSQ bf16_t*)(C.lds + GP_QN); LDSQ bf16_t* VbT = (LDSQ bf16_t*)(C.lds + GP_VBT);
    LDSQ bf16_t* KbgT = (LDSQ bf16_t*)(C.lds + GP_KBGT); LDSQ bf16_t* KDt = (LDSQ bf16_t*)(C.lds + GP_KDT); LDSQ bf16_t* Lb = (LDSQ bf16_t*)(C.lds + GP_LB);
    LDSQ bf16_t* Tr = (LDSQ bf16_t*)(C.lds + GP_TR); LDSQ bf16_t* Tt = (LDSQ bf16_t*)(C.lds + GP_TT); LDSQ bf16_t* Am = (LDSQ bf16_t*)(C.lds + GP_AM); LDSQ bf16_t* Wm = (LDSQ bf16_t*)(C.lds + GP_WM);
    LDSQ float* Lf = (LDSQ float*)(C.lds + GP_LF); LDSQ bf16_t* PT = (LDSQ bf16_t*)(C.lds + GP_PT); LDSQ bf16_t* QT = (LDSQ bf16_t*)(C.lds + GP_QT);
    LDSQ float* gl = (LDSQ float*)(C.lds + GP_G); LDSQ float* gcl = gl + 64; LDSQ float* betal = gl + 128;
    const int i = C.tid >> 3, cg = C.tid & 7, t = 64 * n + i;
    const size_t row = (size_t)b * 2048 + t;
    float q[8], k[8], v[8], xq[8], xk[8], xv[8];
#pragma unroll
    for (int e = 0; e < 8; ++e) { q[e] = 0.f; k[e] = 0.f; v[e] = 0.f; xq[e] = 0.f; xk[e] = 0.f; xv[e] = 0.f; }
    const int cq = h * 64 + 8 * cg;
#pragma unroll
    for (int j = 0; j < 4; ++j) { const int tt = t - 3 + j;
        if (tt >= 0) { const bf16_t* ur = U + (row - 3 + j) * NU + cq;
            unpack8(*(const u32x4*)(ur + UC_BQ), xq); unpack8(*(const u32x4*)(ur + UC_BK), xk); unpack8(*(const u32x4*)(ur + UC_BV), xv);
            const float* wr_ = C.conv_b_w + (size_t)(l * 4 + j) * 1152 + cq;
#pragma unroll
            for (int e = 0; e < 8; ++e) { q[e] += xq[e] * wr_[e]; k[e] += xk[e] * wr_[384 + e]; v[e] += xv[e] * wr_[768 + e]; } } }
    if (n == 31 && i >= 61) { float* o = C.outp + O_CBP + ((size_t)(l * NBP + b) * 3 + (i - 61)) * 1152 + cq;
#pragma unroll
        for (int e = 0; e < 8; ++e) { o[e] = xq[e]; o[384 + e] = xk[e]; o[768 + e] = xv[e]; } }
    float sq = 0.f, sk = 0.f;
#pragma unroll
    for (int e = 0; e < 8; ++e) { q[e] = silu_f(q[e]); k[e] = silu_f(k[e]); v[e] = silu_f(v[e]); sq += q[e] * q[e]; sk += k[e] * k[e]; }
    sq += shfl_xor_f(sq, 1); sq += shfl_xor_f(sq, 2); sq += shfl_xor_f(sq, 4);
    sk += shfl_xor_f(sk, 1); sk += shfl_xor_f(sk, 2); sk += shfl_xor_f(sk, 4);
    const float rq = 0.125f / sqrtf(sq + 1e-6f), rk = 1.0f / sqrtf(sk + 1e-6f);
#pragma unroll
    for (int e = 0; e < 8; ++e) { q[e] *= rq; k[e] *= rk; }
    if (cg == 0) { const float ga = AB[row * 16 + h], gb = AB[row * 16 + 6 + h];
        gl[i] = -expf(C.a_log[l * 6 + h]) * softplus_f(ga + C.dt_bias[l * 6 + h]); betal[i] = sigmoid_f(gb); }
    for (int e = C.tid; e < 2 * 64 * LDP / 2; e += 512) ((LDSQ unsigned*)Tr)[e] = 0u;
    SYNC();
    if (wave == 0) { float x = gl[lane];
#pragma unroll
        for (int d = 1; d < 64; d <<= 1) { const float y = shfl_up_f(x, d); if (lane >= d) x += y; }
        gcl[lane] = x; }
    SYNC();
    const float gci = gcl[i], glast = gcl[63], bi = betal[i];
    const float egc = expf(gci), ekd = expf(glast - gci);
    {
        float tq[8];
#pragma unroll
        for (int e = 0; e < 8; ++e) tq[e] = q[e] * egc;
        { const int c0 = 32 * (cg >> 2) + 16 * (cg & 1) + 4 * ((cg >> 1) & 1);
            *(u32x2*)(gQG + i * 64 + c0) = (u32x2){pk2(tq[0], tq[1]), pk2(tq[2], tq[3])}; *(u32x2*)(gQG + i * 64 + c0 + 8) = (u32x2){pk2(tq[4], tq[5]), pk2(tq[6], tq[7])}; }
        *(LDSQ u32x4*)(Kn + i * LDP + 8 * cg) = pack8(k); *(LDSQ u32x4*)(Qn + i * LDP + 8 * cg) = pack8(q);
#pragma unroll
        for (int e = 0; e < 8; ++e) { const int d = 8 * cg + e;
            VbT[d * LDP + i] = (bf16_t)f2bf(v[e] * bi); KbgT[d * LDP + i] = (bf16_t)f2bf(k[e] * bi * egc); KDt[d * LDP + inv_perm(i)] = (bf16_t)f2bf(k[e] * ekd); }
    }
    SYNC();
#pragma unroll 1
    for (int jj = 0; jj < 4; ++jj) { const int job = wave * 4 + jj, type = job >> 4, it = (job & 15) >> 2, jt = job & 3;
        if (it < jt) { if (type == 1) {
#pragma unroll
                for (int r = 0; r < 4; ++r) Am[(16 * it + 4 * quad + r) * LDP + inv_perm(16 * jt + l15)] = 0; }
            continue; }
        f32x4 acc = {0.f, 0.f, 0.f, 0.f};
#pragma unroll
        for (int s = 0; s < 2; ++s) { const bf16x8 a = lds_frag(type ? Qn : Kn, LDP, 16 * it + l15, 32 * s + 8 * quad), bb = lds_frag(Kn, LDP, 16 * jt + l15, 32 * s + 8 * quad);
            acc = mfma16(a, bb, acc); }
        const int jc = 16 * jt + l15; const float gj = gcl[jc];
#pragma unroll
        for (int r = 0; r < 4; ++r) { const int ir = 16 * it + 4 * quad + r; const float gi = gcl[ir];
            if (type == 0) { const float val = (ir > jc) ? betal[ir] * acc[r] * expf(gi - gj) : 0.f; Lf[ir * 68 + jc] = val; Lb[ir * LDP + jc] = (bf16_t)f2bf(val); }
            else { const float val = (ir >= jc) ? acc[r] * expf(gi - gj) : 0.f; Am[ir * LDP + inv_perm(jc)] = (bf16_t)f2bf(val); } }
    }
    SYNC();
    if (wave == 0) { const int blk = quad, c = l15; float x[16];
#pragma unroll
        for (int ii = 0; ii < 16; ++ii) { float s = (ii == c) ? 1.f : 0.f;
#pragma unroll
            for (int jx = 0; jx < ii; ++jx) s -= Lf[(16 * blk + ii) * 68 + 16 * blk + jx] * x[jx];
            x[ii] = s; }
#pragma unroll
        for (int ii = 0; ii < 16; ++ii) Tr[(16 * blk + ii) * LDP + 16 * blk + c] = (bf16_t)f2bf(x[ii]);
        *(LDSQ u32x4*)(Tt + (16 * blk + c) * LDP + 16 * blk) = pack8(x); *(LDSQ u32x4*)(Tt + (16 * blk + c) * LDP + 16 * blk + 8) = pack8(x + 8); }
    SYNC();
    if (wave < 2) { const int rb = 2 * wave + 1, cb = 2 * wave; LDSQ bf16_t* pt = PT + wave * 16 * 40;
        bf16x8 a = quad < 2 ? lds_frag(Lb, LDP, 16 * rb + l15, 16 * cb + 8 * quad) : zero_frag();
        bf16x8 bb = quad < 2 ? lds_frag(Tt, LDP, 16 * cb + l15, 16 * cb + 8 * quad) : zero_frag();
        f32x4 z = {0.f, 0.f, 0.f, 0.f}; f32x4 p = mfma16(a, bb, z);
        *(LDSQ u32x2*)(pt + l15 * 40 + 4 * quad) = pack4(p);
        WAVE_LDS_FENCE();
        a = quad < 2 ? lds_frag(Tr, LDP, 16 * rb + l15, 16 * rb + 8 * quad) : zero_frag();
        bb = quad < 2 ? lds_frag(pt, 40, l15, 8 * quad) : zero_frag();
        f32x4 r4 = mfma16(a, bb, z); r4 = -r4;
#pragma unroll
        for (int r = 0; r < 4; ++r) Tr[(16 * rb + 4 * quad + r) * LDP + 16 * cb + l15] = (bf16_t)f2bf(r4[r]);
        *(LDSQ u32x2*)(Tt + (16 * cb + l15) * LDP + 16 * rb + 4 * quad) = pack4(r4); }
    SYNC();
    if (wave < 4) { const int it2 = wave >> 1, jt2 = wave & 1;
        const bf16x8 a = lds_frag(Lb, LDP, 32 + 16 * it2 + l15, 8 * quad), bb = lds_frag(Tt, LDP, 16 * jt2 + l15, 8 * quad);
        f32x4 z = {0.f, 0.f, 0.f, 0.f}; const f32x4 p = mfma16(a, bb, z);
        *(LDSQ u32x2*)(QT + (16 * jt2 + l15) * 40 + 16 * it2 + 4 * quad) = pack4(p); }
    SYNC();
    if (wave < 4) { const int it2 = wave >> 1, jt2 = wave & 1;
        const bf16x8 a = lds_frag(Tr, LDP, 32 + 16 * it2 + l15, 32 + 8 * quad), bb = lds_frag(QT, 40, 16 * jt2 + l15, 8 * quad);
        f32x4 z = {0.f, 0.f, 0.f, 0.f}; f32x4 r4 = mfma16(a, bb, z); r4 = -r4;
#pragma unroll
        for (int r = 0; r < 4; ++r) Tr[(32 + 16 * it2 + 4 * quad + r) * LDP + 16 * jt2 + l15] = (bf16_t)f2bf(r4[r]);
        *(LDSQ u32x2*)(Tt + (16 * jt2 + l15) * LDP + 32 + 16 * it2 + 4 * quad) = pack4(r4); }
    SYNC();
#pragma unroll 1
    for (int jj = 0; jj < 4; ++jj) { const int job = wave * 4 + jj, type = job >> 4, it = (job & 15) >> 2, nt = job & 3;
        f32x4 acc = {0.f, 0.f, 0.f, 0.f};
#pragma unroll
        for (int s = 0; s < 2; ++s) { const bf16x8 a = lds_frag(Tr, LDP, 16 * it + l15, 32 * s + 8 * quad), bb = lds_frag(type ? KbgT : VbT, LDP, 16 * nt + l15, 32 * s + 8 * quad);
            acc = mfma16(a, bb, acc); }
        if (type == 0) *(u32x2*)(gUt + (16 * nt + l15) * 64 + 16 * it + 4 * quad) = pack4(acc);
        else {
#pragma unroll
            for (int r = 0; r < 4; ++r) Wm[(16 * it + 4 * quad + r) * LDP + inv_perm(16 * nt + l15)] = (bf16_t)f2bf(acc[r]); } }
    SYNC();
    { const int r = C.tid >> 3, c8 = (C.tid & 7) * 8;
        *(u32x4*)(gWm + r * 64 + c8) = *(const LDSQ u32x4*)(Wm + r * LDP + c8);
        *(u32x4*)(gAm + r * 64 + c8) = *(const LDSQ u32x4*)(Am + r * LDP + c8);
        *(u32x4*)(gKDt + r * 64 + c8) = *(const LDSQ u32x4*)(KDt + r * LDP + c8);
        if (C.tid == 0) WSP(float, WS_GSC)[item] = expf(glast); }
    SYNC();
}

constexpr int SB_A = 0, SB_ABUF = 46080  , SB_O = 92160  , SB_OBUF = 17408, SB_DEC = 126976  ;
DEVFN void scan_ld(u32x4 (&r)[10], const unsigned char* cbase, int lt) {
#pragma unroll
    for (int k = 0; k < 10; ++k) r[k] = *(const u32x4*)(cbase + (size_t)(lt + 256 * k) * 16);
}
DEVFN void scan_st(const u32x4 (&r)[10], LDSQ unsigned char* abuf, int lt) {
#pragma unroll
    for (int k = 0; k < 10; ++k) { const int p = lt + 256 * k, mat = p >> 9, row = (p & 511) >> 3, c8 = p & 7; *(LDSQ u32x4*)(abuf + mat * 9216 + row * 144 + c8 * 16) = r[k]; }
}
DEVFN void scan_zld(u32x4 (&z)[2], const bf16_t* U, int b, int h, int n, int lw, int lane) {
    const size_t m = (size_t)b * 2048 + 64 * n + 16 * lw + (lane >> 2); const bf16_t* zp = U + m * NU + UC_BZ + h * 64 + 16 * (lane & 3);
    z[0] = *(const u32x4*)zp; z[1] = *(const u32x4*)(zp + 8);
}
DEVFN void scan_epi(const Ctx& C, const u32x4 (&z)[2], const LDSQ float* obuf, const float (&nw)[16], int b, int h, int n, int lw, int lane) {
    const int row = 16 * lw + (lane >> 2), c0 = 16 * (lane & 3); float o[16], zf[16]; float ss = 0.f;
#pragma unroll
    for (int q = 0; q < 4; ++q) { const f32x4 v = *(const LDSQ f32x4*)(obuf + row * 68 + c0 + 4 * q); o[4 * q] = v.x; o[4 * q + 1] = v.y; o[4 * q + 2] = v.z; o[4 * q + 3] = v.w; ss += (v.x * v.x + v.y * v.y) + (v.z * v.z + v.w * v.w); }
    ss += shfl_xor_f(ss, 1); ss += shfl_xor_f(ss, 2);
    const float rstd = 1.0f / sqrtf(ss * (1.f / 64.f) + 1e-6f);
    unpack8(z[0], zf); unpack8(z[1], zf + 8);
#pragma unroll
    for (int e = 0; e < 16; ++e) o[e] = o[e] * rstd * nw[e] * silu_f(zf[e]);
    bf16_t* mp = WSP(bf16_t, WS_MIX) + ((size_t)b * 2048 + 64 * n + row) * 1024 + 256 + h * 64 + c0;
    *(u32x4*)mp = pack8(o); *(u32x4*)(mp + 8) = pack8(o + 8);
}
DEVFN void scan_compute(LDSQ unsigned char* abuf, LDSQ float* obuf, f32x4 (&S)[4], float dec, int w, int quad, int l15) {
    const LDSQ bf16_t* Wm = (const LDSQ bf16_t*)abuf; const LDSQ bf16_t* QG = Wm + 4608; const LDSQ bf16_t* Am = Wm + 2 * 4608; const LDSQ bf16_t* KD = Wm + 3 * 4608; const LDSQ bf16_t* Ut = Wm + 4 * 4608;
    const bf16x8 bS0 = acc_pair_frag(S[0], S[1]), bS1 = acc_pair_frag(S[2], S[3]);
    f32x4 vn[4];
#pragma unroll
    for (int it = 0; it < 4; ++it) { f32x4 acc = {0.f, 0.f, 0.f, 0.f};
        acc = mfma16(lds_frag(Wm, LDP, 16 * it + l15, 8 * quad), bS0, acc); acc = mfma16(lds_frag(Wm, LDP, 16 * it + l15, 32 + 8 * quad), bS1, acc);
        const u32x2 u2 = *(const LDSQ u32x2*)(Ut + (16 * w + l15) * LDP + 16 * it + 4 * quad);
        vn[it] = (f32x4){bf_lo(u2.x), bf_hi(u2.x), bf_lo(u2.y), bf_hi(u2.y)} - acc; }
    const bf16x8 bV0 = acc_pair_frag(vn[0], vn[1]), bV1 = acc_pair_frag(vn[2], vn[3]);
#pragma unroll
    for (int kt = 0; kt < 4; ++kt) { f32x4 acc = S[kt] * dec;
        acc = mfma16(lds_frag(KD, LDP, 16 * kt + l15, 8 * quad), bV0, acc); acc = mfma16(lds_frag(KD, LDP, 16 * kt + l15, 32 + 8 * quad), bV1, acc);
        S[kt] = acc; }
#pragma unroll
    for (int it = 0; it < 4; ++it) { f32x4 acc = {0.f, 0.f, 0.f, 0.f};
        acc = mfma16(lds_frag(QG, LDP, 16 * it + l15, 8 * quad), bS0, acc); acc = mfma16(lds_frag(QG, LDP, 16 * it + l15, 32 + 8 * quad), bS1, acc);
        acc = mfma16(lds_frag(Am, LDP, 16 * it + l15, 8 * quad), bV0, acc); acc = mfma16(lds_frag(Am, LDP, 16 * it + l15, 32 + 8 * quad), bV1, acc);
#pragma unroll
        for (int r = 0; r < 4; ++r) obuf[(16 * it + 4 * quad + r) * 68 + 16 * w + l15] = acc[r]; }
}
DEVFN void gdn_scan_unit(const Ctx& C, int l, int unit) {
    const int b = unit / 6, h = unit % 6;
    const int lane = C.lane, quad = lane >> 4, l15 = lane & 15, w = C.wave;
    const bf16_t* U = WSP(bf16_t, WS_U);
    const unsigned char* g0 = C.wsp + WS_GDN + (size_t)unit * 32 * GDN_CHUNK_BYTES;
    LDSQ unsigned char* A0 = C.lds + SB_A; LDSQ float* O0 = (LDSQ float*)(C.lds + SB_O); LDSQ float* decl = (LDSQ float*)(C.lds + SB_DEC);
    const bool comp = w < 4; const int lw = w & 3, lt = C.tid & 255;
    f32x4 S[4];
#pragma unroll
    for (int kt = 0; kt < 4; ++kt) S[kt] = (f32x4){0.f, 0.f, 0.f, 0.f};
    u32x4 ra[10], ze[2], zo[2]; float nw[16];
    if (!comp) {
#pragma unroll
        for (int e = 0; e < 16; ++e) nw[e] = C.gdn_norm_w[l * 64 + 16 * (lane & 3) + e];
        if (lt < 32) decl[lt] = WSP(float, WS_GSC)[unit * 32 + lt];
        scan_ld(ra, g0, lt); scan_st(ra, A0, lt); scan_ld(ra, g0 + GDN_CHUNK_BYTES, lt);
    }
    SYNC();
#pragma unroll 1
    for (int n = 0; n < 32; n += 2) {
        if (comp) scan_compute(A0, O0, S, decl[n], w, quad, l15);
        else { scan_st(ra, A0 + SB_ABUF, lt);
            if (n + 2 < 32) scan_ld(ra, g0 + (size_t)(n + 2) * GDN_CHUNK_BYTES, lt);
            scan_zld(ze, U, b, h, n, lw, lane);
            if (n > 0) scan_epi(C, zo, O0 + SB_OBUF / 4, nw, b, h, n - 1, lw, lane); }
        SYNC();
        if (comp) scan_compute(A0 + SB_ABUF, O0 + SB_OBUF / 4, S, decl[n + 1], w, quad, l15);
        else { if (n + 2 < 32) scan_st(ra, A0, lt);
            if (n + 3 < 32) scan_ld(ra, g0 + (size_t)(n + 3) * GDN_CHUNK_BYTES, lt);
            scan_zld(zo, U, b, h, n + 1, lw, lane);
            scan_epi(C, ze, O0, nw, b, h, n, lw, lane); }
        SYNC();
    }
    if (!comp) scan_epi(C, zo, O0 + SB_OBUF / 4, nw, b, h, 31, lw, lane);
    else { float* og = C.outp + O_GP + ((size_t)(l * NBP + b) * 6 + h) * 4096;
#pragma unroll
        for (int kt = 0; kt < 4; ++kt)
#pragma unroll
            for (int r = 0; r < 4; ++r) og[(16 * kt + 4 * quad + r) * 64 + 16 * w + l15] = S[kt][r]; }
    SYNC();
}

DEVFN void gdn_sample_item(const Ctx& C, int l, int witem, LDSQ float* kq) {
    const int b = witem / 6, h = witem % 6, d = C.lane, m0 = M_P + 4 * b;
    const bf16_t* U = WSP(bf16_t, WS_U); bf16_t* MIX = WSP(bf16_t, WS_MIX); const float* AB = WSP(float, WS_AB);
    float qv[4], kv[4], vv[4];
    {
        float xp[3][7];
#pragma unroll
        for (int c = 0; c < 3; ++c) { const int ch = c * 384 + h * 64 + d;
#pragma unroll
            for (int j = 0; j < 3; ++j) xp[c][j] = C.st_conv_b[((size_t)(l * NBS + b) * 3 + j) * 1152 + ch];
#pragma unroll
            for (int i = 0; i < 4; ++i) xp[c][3 + i] = bf2f(U[(size_t)(m0 + i) * NU + (c == 0 ? UC_BQ : c == 1 ? UC_BK : UC_BV) + h * 64 + d]);
#pragma unroll
            for (int j = 0; j < 3; ++j) C.outp[O_CBS + ((size_t)(l * NBS + b) * 3 + j) * 1152 + ch] = xp[c][4 + j];
            float wt[4];
#pragma unroll
            for (int j = 0; j < 4; ++j) wt[j] = C.conv_b_w[(size_t)(l * 4 + j) * 1152 + ch];
#pragma unroll
            for (int i = 0; i < 4; ++i) { const float y = silu_f(wt[0] * xp[c][i] + wt[1] * xp[c][i + 1] + wt[2] * xp[c][i + 2] + wt[3] * xp[c][i + 3]);
                if (c == 0) qv[i] = y; else if (c == 1) kv[i] = y; else vv[i] = y; } }
    }
#pragma unroll
    for (int i = 0; i < 4; ++i) { const float sq = wave_sum(qv[i] * qv[i]), sk = wave_sum(kv[i] * kv[i]); qv[i] *= 0.125f / sqrtf(sq + 1e-6f); kv[i] *= 1.0f / sqrtf(sk + 1e-6f); }
    float S[64];
    const float* s0 = C.st_gdn + ((size_t)(l * NBS + b) * 6 + h) * 4096 + d;
#pragma unroll
    for (int dk = 0; dk < 64; ++dk) S[dk] = s0[dk * 64];
    const float alog = -expf(C.a_log[l * 6 + h]), dtb = C.dt_bias[l * 6 + h], nw = C.gdn_norm_w[l * 64 + d];
#pragma unroll 1
    for (int i = 0; i < 4; ++i) {
        const float g = alog * softplus_f(AB[(size_t)(m0 + i) * 16 + h] + dtb), beta = sigmoid_f(AB[(size_t)(m0 + i) * 16 + 6 + h]);
        const float eg = expf(g);
        float qi = qv[0], ki = kv[0], vi = vv[0];
#pragma unroll
        for (int j = 1; j < 4; ++j) { qi = (i == j) ? qv[j] : qi; ki = (i == j) ? kv[j] : ki; vi = (i == j) ? vv[j] : vi; }
        WAVE_LDS_FENCE();
        kq[d] = ki; kq[64 + d] = qi;
        WAVE_LDS_FENCE();
        float ks0 = 0.f, ks1 = 0.f, ks2 = 0.f, ks3 = 0.f;
#pragma unroll
        for (int d0 = 0; d0 < 64; d0 += 4) { const f32x4 ka = *(const LDSQ f32x4*)(kq + d0);
            ks0 = FMA_OP(ka.x, S[d0], ks0); ks1 = FMA_OP(ka.y, S[d0 + 1], ks1); ks2 = FMA_OP(ka.z, S[d0 + 2], ks2); ks3 = FMA_OP(ka.w, S[d0 + 3], ks3); }
        const float vn = beta * (vi - eg * ((ks0 + ks1) + (ks2 + ks3)));
        float o0 = 0.f, o1 = 0.f, o2 = 0.f, o3 = 0.f;
#pragma unroll
        for (int d0 = 0; d0 < 64; d0 += 4) { const f32x4 ka = *(const LDSQ f32x4*)(kq + d0), qa = *(const LDSQ f32x4*)(kq + 64 + d0);
            S[d0] = FMA_OP(eg, S[d0], ka.x * vn); S[d0 + 1] = FMA_OP(eg, S[d0 + 1], ka.y * vn); S[d0 + 2] = FMA_OP(eg, S[d0 + 2], ka.z * vn); S[d0 + 3] = FMA_OP(eg, S[d0 + 3], ka.w * vn);
            o0 = FMA_OP(qa.x, S[d0], o0); o1 = FMA_OP(qa.y, S[d0 + 1], o1); o2 = FMA_OP(qa.z, S[d0 + 2], o2); o3 = FMA_OP(qa.w, S[d0 + 3], o3); }
        const float o = (o0 + o1) + (o2 + o3);
        const float ssq = wave_sum(o * o); const float rstd = 1.0f / sqrtf(ssq * (1.f / 64.f) + 1e-6f);
        const float z = bf2f(U[(size_t)(m0 + i) * NU + UC_BZ + h * 64 + d]);
        MIX[(size_t)(m0 + i) * 1024 + 256 + h * 64 + d] = (bf16_t)f2bf(o * rstd * nw * silu_f(z));
    }
    float* so = C.outp + O_GS + ((size_t)(l * NBS + b) * 6 + h) * 4096 + d;
#pragma unroll
    for (int dk = 0; dk < 64; ++dk) so[dk * 64] = S[dk];
}

constexpr int AT_K = 0  , AT_Q = 36864  , AT_VT = 55296  , VTP = 296;
DEVFN void rope8(float* x1, float* x2, const float* cs) {
#pragma unroll
    for (int e = 0; e < 8; ++e) { const float a = x1[e], bq = x2[e]; x1[e] = a * cs[e] - bq * cs[8 + e]; x2[e] = bq * cs[e] + a * cs[8 + e]; }
}
DEVFN void attn_prompt_unit(const Ctx& C, int l, int unit) {
    const int g = unit >> 8, uu = unit & 255, b = uu >> 5, h2 = (uu >> 4) & 1, rest = uu & 15;
    const int dil = g == 0 ? 1 : g == 1 ? 4 : 16, nb = g == 0 ? 16 : g == 1 ? 4 : 1, win = g == 0 ? 128 : g == 1 ? 512 : 2048;
    const int r = rest / nb, n = rest % nb, hh = 2 * g + h2;
    const int lane = C.lane, quad = lane >> 4, l15 = lane & 15, w = C.wave;
    const bf16_t* U = WSP(bf16_t, WS_U); const float* ROPE = WSP(float, WS_ROPE); bf16_t* OC = WSP(bf16_t, WS_OC); float* LSE = WSP(float, WS_LSE);
    LDSQ bf16_t* Kl = (LDSQ bf16_t*)(C.lds + AT_K); LDSQ bf16_t* Ql = (LDSQ bf16_t*)(C.lds + AT_Q); LDSQ bf16_t* VT = (LDSQ bf16_t*)(C.lds + AT_VT);
    float* kvout = C.outp + (g == 0 ? O_K128P : g == 1 ? O_K512P : O_K2048P) + (size_t)(l * NBP + b) * win * 256;
    for (int p = 0; p < 4; ++p) { const int idx = C.tid + 512 * p, kk = idx >> 3, c = idx & 7;
        const int mpos = 128 * (n - 1) + kk; const bool ok = mpos >= 0; const int t = mpos * dil + r;
        const bf16_t* ur = U + ((size_t)b * 2048 + (ok ? t : 0)) * NU + hh * 64;
        float v8[8];
        if (ok) unpack8(*(const u32x4*)(ur + UC_CV + 8 * c), v8); else {
#pragma unroll
            for (int e = 0; e < 8; ++e) v8[e] = 0.f; }
#pragma unroll
        for (int e = 0; e < 8; ++e) VT[(8 * c + e) * VTP + kk] = (bf16_t)f2bf(v8[e]);
        const bool wout = (n == nb - 1) && kk >= 128; float* orow = kvout + (size_t)(t - (2048 - win)) * 256 + h2 * 64;
        if (wout) {
#pragma unroll
            for (int e = 0; e < 8; ++e) orow[128 + 8 * c + e] = v8[e]; }
        if (c == 0) { float x1[8], x2[8];
            if (ok) { unpack8(*(const u32x4*)(ur + UC_CK), x1); unpack8(*(const u32x4*)(ur + UC_CK + 8), x2); float cs[16];
#pragma unroll
                for (int e = 0; e < 16; ++e) cs[e] = ROPE[t * 16 + e];
                rope8(x1, x2, cs); }
            else {
#pragma unroll
                for (int e = 0; e < 8; ++e) { x1[e] = 0.f; x2[e] = 0.f; } }
            *(LDSQ u32x4*)(Kl + kk * LDP) = pack8(x1); *(LDSQ u32x4*)(Kl + kk * LDP + 8) = pack8(x2);
            if (wout) {
#pragma unroll
                for (int e = 0; e < 8; ++e) { orow[e] = x1[e]; orow[8 + e] = x2[e]; } } }
        else if (c >= 2) { u32x4 kx = {0u, 0u, 0u, 0u}; if (ok) kx = *(const u32x4*)(ur + UC_CK + 8 * c);
            *(LDSQ u32x4*)(Kl + kk * LDP + 8 * c) = kx;
            if (wout) { float k8[8]; unpack8(kx, k8);
#pragma unroll
                for (int e = 0; e < 8; ++e) orow[8 * c + e] = k8[e]; } }
    }
    for (int p = 0; p < 2; ++p) { const int idx = C.tid + 512 * p, qq = idx >> 3, c = idx & 7;
        const int t = (128 * n + qq) * dil + r; const bf16_t* ur = U + ((size_t)b * 2048 + t) * NU + UC_CQ + hh * 64;
        if (c == 0) { float x1[8], x2[8], cs[16]; unpack8(*(const u32x4*)(ur), x1); unpack8(*(const u32x4*)(ur + 8), x2);
#pragma unroll
            for (int e = 0; e < 16; ++e) cs[e] = ROPE[t * 16 + e];
            rope8(x1, x2, cs);
            *(LDSQ u32x4*)(Ql + qq * LDP) = pack8(x1); *(LDSQ u32x4*)(Ql + qq * LDP + 8) = pack8(x2); }
        else if (c >= 2) *(LDSQ u32x4*)(Ql + qq * LDP + 8 * c) = *(const u32x4*)(ur + 8 * c); }
    for (int e = C.tid; e < 64 * 40; e += 512) VT[(e / 40) * VTP + 256 + (e % 40)] = 0;
    SYNC();
    const int q0 = 16 * w, qi = q0 + l15;
    f32x4 st[9]; float mx = NEG_BIG;
#pragma unroll
    for (int kt = 0; kt < 9; ++kt) { f32x4 acc = {0.f, 0.f, 0.f, 0.f};
#pragma unroll
        for (int s = 0; s < 2; ++s) acc = mfma16(lds_frag(Kl, LDP, 16 * (w + kt) + l15, 32 * s + 8 * quad), lds_frag(Ql, LDP, qi, 32 * s + 8 * quad), acc);
#pragma unroll
        for (int rr = 0; rr < 4; ++rr) { const int kj = 16 * (w + kt) + 4 * quad + rr, dist = 128 + qi - kj; const bool valid = dist >= 0 && dist <= 128 && (n > 0 || kj >= 128);
            acc[rr] = valid ? acc[rr] * 0.125f : NEG_BIG; mx = fmaxf(mx, acc[rr]); }
        st[kt] = acc; }
    mx = fmaxf(mx, shfl_xor_f(mx, 16)); mx = fmaxf(mx, shfl_xor_f(mx, 32));
    float den = 0.f;
#pragma unroll
    for (int kt = 0; kt < 9; ++kt)
#pragma unroll
        for (int rr = 0; rr < 4; ++rr) { const float p = st[kt][rr] > -1e29f ? expf(st[kt][rr] - mx) : 0.f; st[kt][rr] = p; den += p; }
    den += shfl_xor_f(den, 16); den += shfl_xor_f(den, 32);
    const float inv = 1.0f / den;
    const int tq = (128 * n + qi) * dil + r; const size_t mrow = (size_t)b * 2048 + tq;
#pragma unroll
    for (int dt = 0; dt < 4; ++dt) { f32x4 acc = {0.f, 0.f, 0.f, 0.f};
#pragma unroll
        for (int pr = 0; pr < 5; ++pr) { const int ta = 2 * pr, tb = 2 * pr + 1;
            const u32x2 plo = pack4(st[ta]); u32x2 phi = {0u, 0u}; if (tb < 9) phi = pack4(st[tb < 9 ? tb : 8]);
            const u32x4 bu = {plo.x, plo.y, phi.x, phi.y};
            const LDSQ bf16_t* vr = VT + (16 * dt + l15) * VTP + 4 * quad;
            const u32x2 alo = *(const LDSQ u32x2*)(vr + 16 * (w + ta)), ahi = *(const LDSQ u32x2*)(vr + 16 * (w + tb));
            const u32x4 au = {alo.x, alo.y, ahi.x, ahi.y};
            acc = mfma16(__builtin_bit_cast(bf16x8, au), __builtin_bit_cast(bf16x8, bu), acc); }
        *(u32x2*)(OC + mrow * 384 + hh * 64 + 16 * dt + 4 * quad) = pack4(acc * inv); }
    if (quad == 0) LSE[mrow * 8 + hh] = mx + logf(den);
    SYNC();
}

constexpr int AS_NEW = 0  , AS_Q = 4096  , AS_CMB = 6144  ;
DEVFN void attn_sample_item(const Ctx& C, int l, int item) {
    const int b = item / 3, g = item % 3;
    const int dil = g == 0 ? 1 : g == 1 ? 4 : 16, lb = g == 0 ? 128 : g == 1 ? 512 : 2048;
    const float* cache = (g == 0 ? C.kv128 : g == 1 ? C.kv512 : C.kv2048) + (size_t)(l * NBS + b) * lb * 256;
    const bf16_t* U = WSP(bf16_t, WS_U); const float* ROPE = WSP(float, WS_ROPE); bf16_t* OC = WSP(bf16_t, WS_OC); float* LSE = WSP(float, WS_LSE);
    LDSQ float* NEW = (LDSQ float*)(C.lds + AS_NEW); LDSQ float* Qs = (LDSQ float*)(C.lds + AS_Q); LDSQ float* CMB = (LDSQ float*)(C.lds + AS_CMB);
    const int lane = C.lane, w = C.wave;
    {
        const int i2 = C.tid >> 7, e0 = (C.tid & 127) * 2; const size_t m = M_P + 4 * b + i2; const int pos = 2048 + i2;
        float* orow = C.outp + (g == 0 ? O_K128S : g == 1 ? O_K512S : O_K2048S) + ((size_t)(l * NBS + b) * 4 + i2) * 256;
#pragma unroll
        for (int k2 = 0; k2 < 2; ++k2) { const int e = e0 + k2, kvs = e >> 7, h2 = (e >> 6) & 1, d = e & 63; const int hh = 2 * g + h2;
            const bf16_t* ur = U + m * NU + (kvs ? UC_CV : UC_CK) + hh * 64; float val = bf2f(ur[d]);
            if (!kvs && d < 16) { const int f = d & 7; const float cs = ROPE[pos * 16 + f], sn = ROPE[pos * 16 + 8 + f];
                val = d < 8 ? val * cs - bf2f(ur[d + 8]) * sn : val * cs + bf2f(ur[d - 8]) * sn; }
            NEW[i2 * 256 + e] = val; orow[e] = val; }
        const int h2 = (C.tid >> 6) & 1, d = C.tid & 63, hh = 2 * g + h2; const bf16_t* ur = U + m * NU + UC_CQ + hh * 64; float val = bf2f(ur[d]);
        if (d < 16) { const int f = d & 7; const float cs = ROPE[pos * 16 + f], sn = ROPE[pos * 16 + 8 + f];
            val = d < 8 ? val * cs - bf2f(ur[d + 8]) * sn : val * cs + bf2f(ur[d - 8]) * sn; }
        Qs[i2 * 128 + h2 * 64 + d] = val * 0.125f;
    }
    SYNC();
    const int i = w & 3, half = w >> 2;
    const f32x4 q4 = *(const LDSQ f32x4*)(Qs + i * 128 + (lane & 31) * 4);
    float mrun = NEG_BIG, den = 0.f; f32x4 o4 = {0.f, 0.f, 0.f, 0.f};
    const int jn = (dil == 1) ? i + 1 : 1;
#define AS_STEP(x4) do { float part = (lane < 32) ? (q4.x * (x4).x + q4.y * (x4).y) + (q4.z * (x4).z + q4.w * (x4).w) : 0.f; \
        part += shfl_xor_f(part, 1); part += shfl_xor_f(part, 2); part += shfl_xor_f(part, 4); part += shfl_xor_f(part, 8); \
        const float s_ = shfl_f(part, lane & 31); const float mn_ = fmaxf(mrun, s_); const float sc_ = expf(mrun - mn_), p_ = expf(s_ - mn_); \
        den = den * sc_ + p_; o4 = o4 * sc_ + (x4) * p_; mrun = mn_; } while (0)
    if (half == 0) { for (int j = 0; j < jn; ++j) { const f32x4 x4 = *(const LDSQ f32x4*)(NEW + (i - j * dil) * 256 + lane * 4); AS_STEP(x4); } }
    const int j0 = half == 0 ? jn : 65, j1 = half == 0 ? 65 : 129;
    for (int j = j0; j < j1; j += 8) { f32x4 xb[8];
#pragma unroll
        for (int u = 0; u < 8; ++u) { const int jj = (j + u < j1) ? j + u : j1 - 1; xb[u] = *(const f32x4*)(cache + (size_t)(lb + i - jj * dil) * 256 + lane * 4); }
#pragma unroll
        for (int u = 0; u < 8; ++u) if (j + u < j1) AS_STEP(xb[u]); }
#undef AS_STEP
    { LDSQ float* cm = CMB + (w * 64 + lane) * 6; cm[0] = mrun; cm[1] = den; cm[2] = o4.x; cm[3] = o4.y; cm[4] = o4.z; cm[5] = o4.w; }
    SYNC();
    if (half == 0) { const LDSQ float* cm = CMB + ((w + 4) * 64 + lane) * 6; const float m2 = cm[0], d2 = cm[1]; const f32x4 o2 = {cm[2], cm[3], cm[4], cm[5]};
        const float mm = fmaxf(mrun, m2), a1 = expf(mrun - mm), a2 = expf(m2 - mm); const float dt = den * a1 + d2 * a2; const f32x4 o = (o4 * a1 + o2 * a2) * (1.0f / dt);
        const size_t m = M_P + 4 * b + i; const int h2 = (lane >> 4) & 1, hh = 2 * g + h2;
        if (lane >= 32) { *(u32x2*)(OC + m * 384 + hh * 64 + (lane & 15) * 4) = pack4(o); if ((lane & 15) == 0) LSE[m * 8 + hh] = mm + logf(dt); } }
    SYNC();
}

DEVFN void merge_item(const Ctx& C, int item) {
    const bf16_t* U = WSP(bf16_t, WS_U); const bf16_t* OC = WSP(bf16_t, WS_OC); const float* LSE = WSP(float, WS_LSE); bf16_t* MIX = WSP(bf16_t, WS_MIX);
    for (int p = 0; p < 3; ++p) { const int idx = C.tid + 512 * p, rl = idx / 48, c = idx % 48; const size_t m = (size_t)item * 32 + rl;
        const int hh = c >> 3, g = hh >> 1, hp = hh & 1;
        const float l0 = LSE[m * 8 + hp], l1 = LSE[m * 8 + 2 + hp], l2 = LSE[m * 8 + 4 + hp]; const float mx = fmaxf(l0, fmaxf(l1, l2));
        const float e0 = expf(l0 - mx), e1 = expf(l1 - mx), e2 = expf(l2 - mx); const float alpha = (g == 0 ? e0 : g == 1 ? e1 : e2) / (e0 + e1 + e2);
        float o[8], z[8]; unpack8(*(const u32x4*)(OC + m * 384 + 8 * c), o); unpack8(*(const u32x4*)(U + m * NU + UC_CZ + 8 * c), z);
#pragma unroll
        for (int e = 0; e < 8; ++e) o[e] = o[e] * alpha * silu_f(z[e]);
        *(u32x4*)(MIX + m * 1024 + 640 + 8 * c) = pack8(o); }
}

constexpr int N_PREP = 1536, N_ATTP = 768, N_ATTS = 384, N_CONVA = 264;
#ifndef DBL
#define DBL 0
#endif
DEVFN void phase_mid(const Ctx& C0, int l, bool second = false) {
    if (!second || DBL == 3 || DBL == 4) { const Ctx C = relaunder(C0); for (int it = C.cu; it < N_PREP; it += C.ncu) gdn_prep_item(C, l, it); }
    if (!second || DBL == 3 || DBL == 5) { const Ctx C = relaunder(C0); for (int it = C.cu; it < N_ATTP; it += C.ncu) attn_prompt_unit(C, l, it); }
    if (!second || DBL == 3 || DBL == 6) { const Ctx C = relaunder(C0); for (int it = C.cu; it < N_ATTS; it += C.ncu) attn_sample_item(C, l, it); }
    if (!second || DBL == 3 || DBL == 7) { const Ctx C = relaunder(C0); for (int it = (C.cu + C.ncu / 2) % C.ncu; it < N_CONVA; it += C.ncu) conv_a_item(C, l, it); }
}
constexpr int N_SCAN = 48, N_GS = 96, N_MERGE = 528;
DEVFN void phase_scan(const Ctx& C0, int l, bool second = false) {
    const bool split = C0.ncu > N_SCAN;
    if ((C0.cu < N_SCAN || !split) && (!second || DBL == 8 || DBL == 9)) { const Ctx C = relaunder(C0); for (int u = C.cu; u < N_SCAN; u += C.ncu) gdn_scan_unit(C, l, u); }
    if (C0.cu >= N_SCAN || !split) { const int first = split ? C0.cu - N_SCAN : C0.cu, stride = split ? C0.ncu - N_SCAN : C0.ncu;
        if (!second || DBL == 8 || DBL == 10) { const Ctx C = relaunder(C0); for (int it = first; it < N_GS; it += stride) gdn_sample_item(C, l, it * 8 + C.wave, (LDSQ float*)(C.lds + C.wave * 512)); }
        if (!second || DBL == 8 || DBL == 10) { const Ctx C = relaunder(C0); for (int it = (first + stride - N_GS % stride) % stride; it < N_MERGE; it += stride) merge_item(C, it); } }
}
constexpr int NWAVES = 8;
constexpr int RING_BYTES = 131072, MISC_OFF = RING_BYTES + 320, LDS_BYTES = 147456;
constexpr int CW_BAR = 4096;
#ifndef DBL
#define DBL 0
#endif
#define GRID_BAR() xcd_barrier(bar)

__device__ __forceinline__ Ctx fresh_ctx(const Args* ap, LDSQ unsigned char* lds) {
    Ctx C; int tid = threadIdx.x; asm volatile("" : "+v"(tid));
    C.tid = tid; C.lane = tid & 63; C.wave = __builtin_amdgcn_readfirstlane(tid >> 6);
    C.ncu = gridDim.x; { const int bx = blockIdx.x; C.cu = (C.ncu % 8 == 0) ? (bx % 8) * (C.ncu / 8) + bx / 8 : bx; }
    C.lds = lds; C.a = ap; return C;
}
template <int L> __device__ __forceinline__ void layer_body(const Args* ap, LDSQ unsigned char* lds, const XcdBarrier& bar) {
        { const Ctx C = fresh_ctx(ap, lds); phase_norm(C, L); }
#if DBL == 1
        GRID_BAR(); { const Ctx C = fresh_ctx(ap, lds); phase_norm(C, L); }
#endif
        GRID_BAR();
        { const Ctx C = fresh_ctx(ap, lds);
            pg8::Gemm g{WSP(bf16_t, WS_HN), WSP(bf16_t, WS_WIN) + (size_t)L * 4096 * 1024, M_T, NU, 1024}; pg8::StaticOrder S; S.init(M_T, NU, C.ncu, (int)blockIdx.x);
            pg8::EpiU E{WSP(bf16_t, WS_U), NU};
            pg8::gemm_phase<pg8::EpiU, pg8::StaticOrder, true, true>(C.lds, g, S, E);
#if DBL == 2
            GRID_BAR(); pg8::gemm_phase<pg8::EpiU, pg8::StaticOrder, true, true>(C.lds, g, S, E);
#endif
        }
        GRID_BAR();
        { const Ctx C = fresh_ctx(ap, lds); phase_mid(C, L); }
#if DBL >= 3 && DBL <= 7
        GRID_BAR(); { const Ctx C = fresh_ctx(ap, lds); phase_mid(C, L, true); }
#endif
        GRID_BAR();
        { const Ctx C = fresh_ctx(ap, lds); phase_scan(C, L); }
#if DBL >= 8 && DBL <= 10
        GRID_BAR(); { const Ctx C = fresh_ctx(ap, lds); phase_scan(C, L, true); }
#endif
        GRID_BAR();
        { const Ctx C = fresh_ctx(ap, lds);
            pg8::Gemm g{WSP(bf16_t, WS_MIX), WSP(bf16_t, WS_WOUT) + (size_t)L * 1024 * 1024, M_T, 1024, 1024}; pg8::StaticOrder S; S.init(M_T, 1024, C.ncu, (int)blockIdx.x);
            const float* X = WSP(float, WS_X);
            pg8::EpiRes E{L == 0 ? C.x_prompt : X, L == 0 ? C.x_sample : X + (size_t)M_P * 1024, WSP(float, WS_X), WSP(float, WS_MOD) + L * 3072 + 2048};
#if DBL == 13
            { pg8::EpiRes E2 = E; E2.X = WSP(float, WS_U); pg8::gemm_phase<pg8::EpiRes, pg8::StaticOrder, true, true>(C.lds, g, S, E2); GRID_BAR(); }
#endif
            pg8::gemm_phase<pg8::EpiRes, pg8::StaticOrder, true, true>(C.lds, g, S, E);
        }
        GRID_BAR();
    }

__global__ void __launch_bounds__(NWAVES * 64, 2) mega_fwd(Args args) {
    extern __shared__ __attribute__((aligned(16))) unsigned char lds_raw[];
    Ctx C;
    C.lds = (LDSQ unsigned char*)lds_raw;
    C.tid = threadIdx.x; C.lane = C.tid & 63; C.wave = __builtin_amdgcn_readfirstlane(C.tid >> 6);
    C.ncu = gridDim.x; { const int bx = blockIdx.x; C.cu = (C.ncu % 8 == 0) ? (bx % 8) * (C.ncu / 8) + bx / 8 : bx; }
    C.a = &args;
    volatile LDSQ unsigned* MISC = (volatile LDSQ unsigned*)(C.lds + MISC_OFF);
    for (int u = C.tid; u < (LDS_BYTES - RING_BYTES) / 4; u += NWAVES * 64) ((LDSQ unsigned*)(C.lds + RING_BYTES))[u] = 0u;
    __syncthreads();
    unsigned* ctl = (unsigned*)(C.wsp + WS_CTL);
    XcdBarrier bar = xcd_barrier_post(ctl + CW_BAR, MISC + 8);

    phase_p0a(C);
#if DBL == 11
    GRID_BAR(); phase_p0a(C);
#endif
    GRID_BAR();
    {
        pg8::Gemm g{WSP(bf16_t, WS_CB), WSP(bf16_t, WS_WADA), 256, NMOD, 1024}; pg8::StaticOrder S; S.init(256, NMOD, C.ncu, (int)blockIdx.x);
        pg8::EpiMod E{WSP(float, WS_MOD), C.b_ada, C.b_ada_final};
        pg8::gemm_phase<pg8::EpiMod, pg8::StaticOrder, false, true>(C.lds, g, S, E);
#if DBL == 12
        GRID_BAR(); pg8::gemm_phase<pg8::EpiMod, pg8::StaticOrder, false, true>(C.lds, g, S, E);
#endif
    }
    GRID_BAR();
    layer_body<0>(&args, C.lds, bar); layer_body<1>(&args, C.lds, bar); layer_body<2>(&args, C.lds, bar); layer_body<3>(&args, C.lds, bar);
    { const Ctx C2 = fresh_ctx(&args, C.lds); phase_final(C2); }
#if DBL == 14
    { const Ctx C2 = fresh_ctx(&args, C.lds); phase_final(C2); }
#endif
}

extern "C" void kernel_launch(void* const* d_in, const int* in_sizes, int n_in, void* d_out, int out_size, void* d_ws, size_t ws_size, hipStream_t stream) {
    static int grid = 0;
    if (grid == 0) {
        if (n_in != 23 || out_size != (int)O_END || ws_size < WS_END) { fprintf(stderr, "kernel_launch: unexpected shapes: n_in %d out %d ws %zu\n", n_in, out_size, ws_size); grid = -1; return; }
        int dev = 0, cus = 0, per_cu = 0;
        if (hipGetDevice(&dev) != hipSuccess || hipDeviceGetAttribute(&cus, hipDeviceAttributeMultiprocessorCount, dev) != hipSuccess) { grid = -1; return; }
        if (hipFuncSetAttribute((const void*)mega_fwd, hipFuncAttributeMaxDynamicSharedMemorySize, LDS_BYTES) != hipSuccess) { fprintf(stderr, "kernel_launch: hipFuncSetAttribute failed\n"); grid = -1; return; }
        if (hipOccupancyMaxActiveBlocksPerMultiprocessor(&per_cu, (const void*)mega_fwd, NWAVES * 64, LDS_BYTES) != hipSuccess || per_cu < 1) { fprintf(stderr, "kernel_launch: occupancy query says %d\n", per_cu); }
        (void)hipGetLastError();
        grid = cus;
    }
    if (grid < 0) return;
    if (hipMemsetAsync((char*)d_ws + WS_CTL, 0, CTL_ZERO_BYTES, stream) != hipSuccess) return;
    Args ha{};
    for (int i = 0; i < 23; ++i) ha.in[i] = (const float*)d_in[i];
    ha.out_ = (float*)d_out; ha.ws_ = (unsigned char*)d_ws;
    hipLaunchKernelGGL(mega_fwd, dim3(grid), dim3(NWAVES * 64), LDS_BYTES, stream, ha);
}
```

```cpp
#include <hip/hip_runtime.h>
#include <cstdio>
#include <cstdint>
namespace pg8 {
#define PG8_LAS __attribute__((address_space(3)))
typedef unsigned short bf16_t;
typedef short bf16x8 __attribute__((ext_vector_type(8)));
typedef float f32x4 __attribute__((ext_vector_type(4)));
typedef unsigned u32x4 __attribute__((ext_vector_type(4)));
constexpr int BM = 256, BK = 64, HALF = 128, HTB = HALF * BK * 2  , STAGE_BYTES = 8 * HTB, NXCD = 8, WGM = 8;

__host__ __device__ __forceinline__ int lds_byte(int r, int c) { const int st = (r >> 4) * 2 + (c >> 5), rr = r & 15, cc = c & 31, ob = rr * 64 + cc * 2; return st * 1024 + (ob ^ (((ob >> 9) & 1) << 5)); }
__host__ __device__ __forceinline__ void stage_rc(int b, int& R, int& C) { const int st = b / 1024, sb = b % 1024, swz = sb ^ (((sb >> 9) & 1) << 5); R = (st >> 1) * 16 + swz / 64; C = (st & 1) * 32 + (swz % 64) / 2; }
__host__ __device__ __forceinline__ int perm32(int rho) { const int n = rho >> 4, i = rho & 15; return 8 * (i >> 2) + 4 * n + (i & 3); }

struct Unit { int pm, pn; };
struct Gemm { const bf16_t* A; const bf16_t* Bt; int M, N, K; };

struct StaticOrder {
    int nM, nN, nwg, G, c;
    __host__ __device__ void init(int M, int N, int G_, int c_) { nM = M / BM; nN = N / BM; nwg = nM * nN; G = G_; c = c_; }
    __host__ __device__ bool next(int i, Unit& u) const {
        const long L = (long)i * G + c; if (L >= nwg) return false;
        int wgid = (int)L; { const int q = nwg / NXCD, r = nwg % NXCD, xcd = wgid % NXCD, off = wgid / NXCD; wgid = (xcd < r ? xcd * (q + 1) : r * (q + 1) + (xcd - r) * q) + off; }
        const int nig = WGM * nN, gid = wgid / nig, fm = gid * WGM, gsz = (nM - fm) < WGM ? (nM - fm) : WGM;
        u.pm = fm + ((wgid % nig) % gsz); u.pn = (wgid % nig) / gsz; return true;
    }
    __device__ __forceinline__ void a_ready(const Unit&) const {}
    __device__ __forceinline__ void done(const Unit&) const {}
};

__device__ __forceinline__ unsigned cvt_pk_bf16(float lo, float hi) { unsigned r; asm volatile("v_cvt_pk_bf16_f32 %0, %1, %2" : "=v"(r) : "v"(lo), "v"(hi)); return r; }
template <class Epi, class Sched, bool ALIGN_EPI = false, bool SP2 = false>
__device__ __forceinline__ void gemm_phase(PG8_LAS unsigned char* lds, const Gemm g, const Sched& S, const Epi& E) {
    int tid_ = threadIdx.x; asm volatile("" : "+v"(tid_));
    const int tid = tid_, wid = __builtin_amdgcn_readfirstlane(tid >> 6), lane = tid & 63, wr = wid >> 2, wc = wid & 3, fr = lane & 15, fq = lane >> 4;
    const int K = g.K, nt = K / BK;
    unsigned voffA[2], voffB[2];
#pragma unroll
    for (int i = 0; i < 2; ++i) { int R, C; stage_rc(tid * 16 + i * 8192, R, C); const int Rb = Epi::PERM ? ((R & ~31) + perm32(R & 31)) : R;
        voffA[i] = (unsigned)(R * K + C) * 2u; voffB[i] = (unsigned)(Rb * K + C) * 2u; }
    const size_t kstep = (size_t)(BK * 2);
    const size_t hstep = (size_t)HALF * K * 2;
    const size_t tstep = 2 * hstep;
    const unsigned ldsw = (unsigned)wid * 1024u;
    const int aoff = lds_byte(wr * 64 + fr, fq * 8), boff = lds_byte(wc * 32 + fr, fq * 8);
#define PG8_SA(b, h) (((b) * 2 + (h)) * HTB)
#define PG8_SB(b, h) ((4 + (b) * 2 + (h)) * HTB)
#define PG8_STAGE(bufoff, gbase, voff) do { _Pragma("unroll") for (int _i = 0; _i < 2; ++_i) \
        __builtin_amdgcn_global_load_lds((const unsigned*)((const char*)(gbase) + (voff)[_i]), (PG8_LAS unsigned*)(lds + (bufoff) + ldsw + _i * 8192), 16, 0, 0); } while (0)
#define PG8_LDA(dst, b, h) do { _Pragma("unroll") for (int m = 0; m < 4; ++m) _Pragma("unroll") for (int k = 0; k < 2; ++k) dst[m][k] = *(const PG8_LAS bf16x8*)(lds + PG8_SA(b, h) + aoff + m * 2048 + k * 1024); } while (0)
#define PG8_LDB(dst, b, h) do { _Pragma("unroll") for (int n = 0; n < 2; ++n) _Pragma("unroll") for (int k = 0; k < 2; ++k) dst[n][k] = *(const PG8_LAS bf16x8*)(lds + PG8_SB(b, h) + boff + n * 2048 + k * 1024); } while (0)
#define PG8_MMA(ai, bj, At, Bt) do { __builtin_amdgcn_s_setprio(1); _Pragma("unroll") for (int m = 0; m < 4; ++m) _Pragma("unroll") for (int n = 0; n < 2; ++n) _Pragma("unroll") for (int k = 0; k < 2; ++k) \
        acc[ai][bj][m][n] = __builtin_amdgcn_mfma_f32_16x16x32_bf16(Bt[n][k], At[m][k], acc[ai][bj][m][n], 0, 0, 0); __builtin_amdgcn_s_setprio(0); } while (0)
#define PG8_WAIT_V(n) asm volatile("s_waitcnt vmcnt(" #n ")" ::: "memory")
#define PG8_WAIT_L(n) asm volatile("s_waitcnt lgkmcnt(" #n ")" ::: "memory")
#define PG8_BAR __builtin_amdgcn_s_barrier()
#define PG8_SCHED __builtin_amdgcn_sched_barrier(0)
    Unit cur, nxt; int ui = 0;
    if (!S.next(0, cur)) return;
    f32x4 acc[2][2][4][2];
#pragma unroll
    for (int a = 0; a < 2; ++a)
#pragma unroll
        for (int b = 0; b < 2; ++b)
#pragma unroll
            for (int m = 0; m < 4; ++m)
#pragma unroll
                for (int n = 0; n < 2; ++n) acc[a][b][m][n] = (f32x4){0.f, 0.f, 0.f, 0.f};
    bf16x8 At[4][2], B0[2][2], B1[2][2];
    const char* cA = (const char*)g.A + (size_t)cur.pm * tstep; const char* cB = (const char*)g.Bt + (size_t)cur.pn * tstep;
    S.a_ready(cur);
    if constexpr (SP2) {
        PG8_STAGE(PG8_SB(0, 0), cB, voffB); PG8_STAGE(PG8_SB(0, 1), cB + hstep, voffB); PG8_STAGE(PG8_SA(0, 0), cA, voffA); PG8_STAGE(PG8_SA(0, 1), cA + hstep, voffA);
        if (wr == 1) PG8_BAR;
        PG8_WAIT_V(2); PG8_BAR;
        PG8_STAGE(PG8_SB(1, 0), cB + kstep, voffB); PG8_STAGE(PG8_SA(1, 0), cA + kstep, voffA); PG8_STAGE(PG8_SB(1, 1), cB + hstep + kstep, voffB);
        PG8_WAIT_V(6); PG8_BAR;
    } else {
        PG8_STAGE(PG8_SB(0, 0), cB, voffB); PG8_STAGE(PG8_SA(0, 0), cA, voffA); PG8_STAGE(PG8_SB(0, 1), cB + hstep, voffB); PG8_STAGE(PG8_SA(0, 1), cA + hstep, voffA);
        if (wr == 1) PG8_BAR;
        PG8_WAIT_V(4); PG8_BAR;
        PG8_STAGE(PG8_SB(1, 0), cB + kstep, voffB); PG8_STAGE(PG8_SA(1, 0), cA + kstep, voffA); PG8_STAGE(PG8_SB(1, 1), cB + hstep + kstep, voffB);
        PG8_WAIT_V(6); PG8_BAR;
    }
    for (;;) {
        const bool has_next = S.next(ui + 1, nxt);
        const char* nA = has_next ? (const char*)g.A + (size_t)nxt.pm * tstep : cA; const char* nB = has_next ? (const char*)g.Bt + (size_t)nxt.pn * tstep : cB;
        for (int t = 0; t < nt; t += 2) {
            const bool last = (t == nt - 2);
            const char* a1 = cA + (size_t)(t + 1) * kstep;
            const char* a2 = last ? nA : cA + (size_t)(t + 2) * kstep; const char* b2 = last ? nB : cB + (size_t)(t + 2) * kstep;
            const char* a3 = a2 + kstep; const char* b3 = b2 + kstep;
            if (last && has_next) S.a_ready(nxt);
            if constexpr (SP2) {
            PG8_LDB(B0, 0, 0); PG8_LDB(B1, 0, 1); PG8_SCHED; PG8_LDA(At, 0, 0); PG8_STAGE(PG8_SA(1, 1), a1 + hstep, voffA);
            PG8_WAIT_V(8); PG8_WAIT_L(0); PG8_BAR; PG8_MMA(0, 0, At, B0); PG8_MMA(0, 1, At, B1); PG8_BAR; PG8_SCHED;
            PG8_LDA(At, 0, 1); PG8_STAGE(PG8_SB(0, 0), b2, voffB); PG8_STAGE(PG8_SB(0, 1), b2 + hstep, voffB); PG8_STAGE(PG8_SA(0, 0), a2, voffA);
            PG8_WAIT_V(8); PG8_WAIT_L(0); PG8_BAR; PG8_MMA(1, 0, At, B0); PG8_MMA(1, 1, At, B1); PG8_BAR; PG8_SCHED;
            PG8_LDB(B0, 1, 0); PG8_LDB(B1, 1, 1); PG8_SCHED; PG8_LDA(At, 1, 0); PG8_STAGE(PG8_SA(0, 1), a2 + hstep, voffA);
            PG8_WAIT_V(8); PG8_WAIT_L(0); PG8_BAR; PG8_MMA(0, 0, At, B0); PG8_MMA(0, 1, At, B1); PG8_BAR; PG8_SCHED;
            PG8_LDA(At, 1, 1); PG8_STAGE(PG8_SB(1, 0), b3, voffB); PG8_STAGE(PG8_SB(1, 1), b3 + hstep, voffB); PG8_STAGE(PG8_SA(1, 0), a3, voffA);
            PG8_WAIT_V(8); PG8_WAIT_L(0); PG8_BAR; PG8_MMA(1, 0, At, B0); PG8_MMA(1, 1, At, B1); PG8_BAR; PG8_SCHED;
            } else {
            PG8_LDB(B0, 0, 0); PG8_SCHED; PG8_LDA(At, 0, 0); PG8_STAGE(PG8_SA(1, 1), a1 + hstep, voffA);
            PG8_WAIT_L(8); PG8_BAR; PG8_WAIT_L(0); PG8_MMA(0, 0, At, B0); PG8_BAR; PG8_SCHED;
            PG8_LDB(B1, 0, 1); PG8_STAGE(PG8_SB(0, 0), b2, voffB);
            PG8_BAR; PG8_WAIT_L(0); PG8_MMA(0, 1, At, B1); PG8_BAR;
            PG8_LDA(At, 0, 1); PG8_STAGE(PG8_SA(0, 0), a2, voffA);
            PG8_BAR; PG8_WAIT_L(0); PG8_MMA(1, 0, At, B0); PG8_BAR; PG8_SCHED;
            PG8_STAGE(PG8_SB(0, 1), b2 + hstep, voffB);
            PG8_WAIT_V(6); PG8_BAR; PG8_MMA(1, 1, At, B1); PG8_BAR;
            PG8_LDB(B0, 1, 0); PG8_SCHED; PG8_LDA(At, 1, 0); PG8_STAGE(PG8_SA(0, 1), a2 + hstep, voffA);
            PG8_WAIT_L(8); PG8_BAR; PG8_WAIT_L(0); PG8_MMA(0, 0, At, B0); PG8_BAR; PG8_SCHED;
            PG8_LDB(B1, 1, 1); PG8_STAGE(PG8_SB(1, 0), b3, voffB);
            PG8_BAR; PG8_WAIT_L(0); PG8_MMA(0, 1, At, B1); PG8_BAR;
            PG8_LDA(At, 1, 1); PG8_STAGE(PG8_SA(1, 0), a3, voffA);
            PG8_BAR; PG8_WAIT_L(0); PG8_MMA(1, 0, At, B0); PG8_BAR; PG8_SCHED;
            PG8_STAGE(PG8_SB(1, 1), b3 + hstep, voffB);
            PG8_WAIT_V(6); PG8_BAR; PG8_MMA(1, 1, At, B1); PG8_BAR;
            }
        }
        if constexpr (ALIGN_EPI) { if (wr == 0) PG8_BAR; }
        if constexpr (!Epi::AFTER_DRAIN) { E(acc, cur, wr, wc, fr, fq); S.done(cur); }
        if (!has_next) break;
#pragma unroll
        for (int a = 0; a < 2; ++a)
#pragma unroll
            for (int b = 0; b < 2; ++b)
#pragma unroll
                for (int m = 0; m < 4; ++m)
#pragma unroll
                    for (int n = 0; n < 2; ++n) acc[a][b][m][n] = (f32x4){0.f, 0.f, 0.f, 0.f};
        cur = nxt; cA = nA; cB = nB; ++ui;
        if constexpr (ALIGN_EPI) { if (wr == 1) PG8_BAR; }
    }
    PG8_WAIT_V(0);
    if constexpr (!ALIGN_EPI) { if (wr == 0) PG8_BAR; }
    PG8_BAR;
    if constexpr (Epi::AFTER_DRAIN) { E.fused(acc, cur, wr, wc, fr, fq, lds, wid, lane); S.done(cur); }
#undef PG8_SA
#undef PG8_SB
#undef PG8_STAGE
#undef PG8_LDA
#undef PG8_LDB
#undef PG8_MMA
#undef PG8_WAIT_V
#undef PG8_WAIT_L
#undef PG8_BAR
#undef PG8_SCHED
}
}
namespace pg8 {
struct EpiU { static constexpr bool PERM = true, AFTER_DRAIN = false; bf16_t* O; int ldc;
    __device__ __forceinline__ void operator()(const f32x4 (&acc)[2][2][4][2], const Unit& u, int wr, int wc, int fr, int fq) const {
        const int row0 = u.pm * BM + wr * 64 + fr, col0 = u.pn * BM + wc * 32 + 8 * fq;
#pragma unroll
        for (int ai = 0; ai < 2; ++ai)
#pragma unroll
            for (int m = 0; m < 4; ++m) { bf16_t* rowp = O + (size_t)(row0 + ai * HALF + m * 16) * ldc + col0;
#pragma unroll
                for (int bj = 0; bj < 2; ++bj) { const f32x4 v0 = acc[ai][bj][m][0], v1 = acc[ai][bj][m][1];
                    u32x4 w; w.x = cvt_pk_bf16(v0[0], v0[1]); w.y = cvt_pk_bf16(v0[2], v0[3]); w.z = cvt_pk_bf16(v1[0], v1[1]); w.w = cvt_pk_bf16(v1[2], v1[3]);
                    *(u32x4*)(rowp + bj * HALF) = w; } }
    }
};
struct EpiMod { static constexpr bool PERM = false, AFTER_DRAIN = false; float* O; const float* b_ada; const float* b_fin;
    __device__ __forceinline__ void operator()(const f32x4 (&acc)[2][2][4][2], const Unit& u, int wr, int wc, int fr, int fq) const {
        const int colt = u.pn * BM; const float* bias = colt < 12288 ? b_ada + colt : b_fin + (colt - 12288);
        const int cl = wc * 32 + 4 * fq;
#pragma unroll
        for (int ai = 0; ai < 2; ++ai)
#pragma unroll
            for (int m = 0; m < 4; ++m) { const int row = ai * HALF + wr * 64 + m * 16 + fr;
                if (row < 136) {
#pragma unroll
                    for (int bj = 0; bj < 2; ++bj)
#pragma unroll
                        for (int n = 0; n < 2; ++n) { const int c = cl + bj * HALF + n * 16; const f32x4 bv = *(const f32x4*)(bias + c);
                            *(f32x4*)(O + (size_t)row * 14336 + colt + c) = acc[ai][bj][m][n] + bv; } } }
    }
};
struct EpiRes { static constexpr bool PERM = false, AFTER_DRAIN = false; const float* base_p; const float* base_s; float* X; const float* gate0;
    __device__ __forceinline__ void operator()(const f32x4 (&acc)[2][2][4][2], const Unit& u, int wr, int wc, int fr, int fq) const {
        const int cl = u.pn * BM + wc * 32 + 4 * fq;
#pragma unroll
        for (int ai = 0; ai < 2; ++ai)
#pragma unroll
            for (int m = 0; m < 4; ++m) { const int row = u.pm * BM + ai * HALF + wr * 64 + m * 16 + fr;
                const float* b = row < 16384 ? base_p + (size_t)row * 1024 : base_s + (size_t)(row - 16384) * 1024;
                const int brow = row < 16384 ? (row >> 11) : 8 + ((row - 16384) >> 2);
                const float* g = gate0 + (size_t)brow * 14336; float* o = X + (size_t)row * 1024;
#pragma unroll
                for (int bj = 0; bj < 2; ++bj)
#pragma unroll
                    for (int n = 0; n < 2; ++n) { const int c = cl + bj * HALF + n * 16; const f32x4 bv = *(const f32x4*)(b + c), gv = *(const f32x4*)(g + c);
                        *(f32x4*)(o + c) = bv + (gv + 1.0f) * acc[ai][bj][m][n]; } }
    }
};
}
using pg8::bf16_t; using pg8::bf16x8; using pg8::f32x4; using pg8::u32x4;
#ifdef HOST_EMU
#define DEVFN static inline
#define DEVMFN inline
#define LDSQ
#define GASQ
#else
#define DEVFN __device__ __forceinline__
#define DEVMFN __device__ __forceinline__
#define LDSQ __attribute__((address_space(3)))
#define GASQ __attribute__((address_space(1)))
#endif
typedef short s16x4 __attribute__((ext_vector_type(4)));
typedef float f32x2 __attribute__((ext_vector_type(2)));
typedef unsigned u32x2 __attribute__((ext_vector_type(2)));

constexpr int D_MODEL = 1024, SEQ = 2048, NBP = 8, NBS = 128, DSEQ = 4, DEPTH = 4;
constexpr int M_P = NBP * SEQ, M_S = NBS * DSEQ, M_T = M_P + M_S;
constexpr int IN_W = 4108, NU = 4096, NBROW = NBP + NBS;
constexpr int NMOD = 4 * 3072 + 2048;
constexpr int UC_AX = 0, UC_ACG = 256, UC_ABG = 512, UC_AZ = 768, UC_BQ = 1024, UC_BK = 1408, UC_BV = 1792, UC_BZ = 2176, UC_CQ = 2560, UC_CK = 2944, UC_CV = 3328, UC_CZ = 3712;
constexpr size_t MiB = 1u << 20;
constexpr size_t WS_CTL = 0, CTL_ZERO_BYTES = 1 * MiB;
constexpr size_t WS_WIN = 2 * MiB;
constexpr size_t WS_WOUT = 34 * MiB;
constexpr size_t WS_WADA = 42 * MiB;
constexpr size_t WS_WAB = 70 * MiB;
constexpr size_t WS_ROPE = 71 * MiB;
constexpr size_t WS_CB = 72 * MiB;
constexpr size_t WS_MOD = 73 * MiB;
constexpr size_t WS_AB = 82 * MiB;
constexpr size_t WS_LSE = 84 * MiB;
constexpr size_t WS_GSC = 86 * MiB;
constexpr size_t WS_X = 96 * MiB;
constexpr size_t WS_HN = 162 * MiB;
constexpr size_t WS_MIX = 196 * MiB;
constexpr size_t WS_OC = 230 * MiB;
constexpr size_t WS_U = 256 * MiB;
constexpr size_t WS_GDN = 400 * MiB;
constexpr size_t GDN_CHUNK_BYTES = 40960;
constexpr size_t WS_END = 480 * MiB;
constexpr size_t O_YP = 0, O_YS = 16777216, O_CAP = 17301504, O_CAS = 17317888, O_CBP = 17580032, O_CBS = 17690624, O_GP = 19460096, O_GS = 20246528,
                 O_K128P = 32829440, O_K128S = 33878016, O_K512P = 34402304, O_K512S = 38596608, O_K2048P = 39120896, O_K2048S = 55898112, O_END = 56422400;

DEVFN float bf_lo(unsigned u) { return __builtin_bit_cast(float, u << 16); }
DEVFN float bf_hi(unsigned u) { return __builtin_bit_cast(float, u & 0xffff0000u); }
DEVFN float bf2f(bf16_t h) { return __builtin_bit_cast(float, (unsigned)h << 16); }
DEVFN unsigned f2bf(float f) { unsigned u = __builtin_bit_cast(unsigned, f); return (u + 0x7fffu + ((u >> 16) & 1u)) >> 16; }
DEVFN unsigned pk2(float lo, float hi) { return f2bf(lo) | (f2bf(hi) << 16); }
DEVFN void unpack8(u32x4 v, float* f) { f[0] = bf_lo(v.x); f[1] = bf_hi(v.x); f[2] = bf_lo(v.y); f[3] = bf_hi(v.y); f[4] = bf_lo(v.z); f[5] = bf_hi(v.z); f[6] = bf_lo(v.w); f[7] = bf_hi(v.w); }
DEVFN u32x4 pack8(const float* f) { u32x4 v; v.x = pk2(f[0], f[1]); v.y = pk2(f[2], f[3]); v.z = pk2(f[4], f[5]); v.w = pk2(f[6], f[7]); return v; }
DEVFN float silu_f(float x) { return x / (1.f + expf(-x)); }
DEVFN float sigmoid_f(float x) { return 1.f / (1.f + expf(-x)); }
DEVFN float softplus_f(float x) { return x > 20.f ? x : log1pf(expf(x)); }

struct Args { const float* in[23]; float* out_; unsigned char* ws_; };
struct Ctx {
    int tid, lane, wave, cu, ncu;
    LDSQ unsigned char* lds;
    const Args* a;
};
#define x_prompt a->in[0]
#define x_sample a->in[1]
#define st_conv_a a->in[2]
#define st_conv_b a->in[3]
#define st_gdn a->in[4]
#define kv128 a->in[5]
#define kv512 a->in[6]
#define kv2048 a->in[7]
#define c_prompt a->in[8]
#define c_sample a->in[9]
#define w_in a->in[10]
#define w_out a->in[11]
#define w_ada a->in[12]
#define b_ada a->in[13]
#define norm_w a->in[14]
#define conv_a_w a->in[15]
#define conv_b_w a->in[16]
#define a_log a->in[17]
#define dt_bias a->in[18]
#define gdn_norm_w a->in[19]
#define final_norm_w a->in[20]
#define w_ada_final a->in[21]
#define b_ada_final a->in[22]
#define outp a->out_
#define wsp a->ws_
constexpr int LDS_QIDX = 131072 + 320 + 64;
constexpr int CW_QUEUE = 32768;
#define WSP(T, off) ((T*)(C.wsp + (off)))
#define LAS __attribute__((address_space(3)))
#define XB_TMO      128
#define XB_XCNT(j)  (256  + 64 * (j))
#define XB_XSUB(j)  (1280 + 64 * (j))
#define XB_XGEN(j)  (2304 + 64 * (j))
#define XB_TOP      3328
#define XB_TOPGEN   3392
#define XCD_BAR_WORDS 3456
#define XB_SPIN_CAP (1u << 18)

__device__ __forceinline__ unsigned xb_ld(unsigned* p)              { return __hip_atomic_load(p, __ATOMIC_RELAXED, __HIP_MEMORY_SCOPE_AGENT); }
__device__ __forceinline__ unsigned xb_add(unsigned* p, unsigned v) { return __hip_atomic_fetch_add(p, v, __ATOMIC_RELAXED, __HIP_MEMORY_SCOPE_AGENT); }
__device__ __forceinline__ unsigned xb_xcc_id() { return (unsigned)__builtin_amdgcn_s_getreg((3 << 11) | 20) & 0xFu; }
#define XB_SPIN(cond, bar) do { unsigned _sp = 0; while (cond) { __builtin_amdgcn_s_sleep(1); \
    if ((++_sp & 255u) == 0u) { if (xb_ld(&(bar)[XB_TMO])) break; if (_sp > XB_SPIN_CAP) { atomicAdd(&(bar)[XB_TMO], 1u); break; } } } } while (0)

struct XcdBarrier {
    unsigned* bar; unsigned x;
    volatile LAS unsigned* st;
};

__device__ __forceinline__ XcdBarrier xcd_barrier_post(unsigned* bar, volatile LAS unsigned* st) {
    XcdBarrier b; b.bar = bar; b.x = xb_xcc_id(); b.st = st;
    if (threadIdx.x == 0) (void)xb_add(&bar[XB_XCNT(b.x)], 1u);
    return b;
}
__device__ __forceinline__ void xcd_barrier_complete(unsigned* bar, unsigned x, unsigned& nloc, unsigned& nx) {
    const unsigned G = gridDim.x * gridDim.y * gridDim.z;
    unsigned sum, cnt, mine, sp = 0u;
    for (;;) {
        sum = 0u; cnt = 0u; mine = 0u;
#pragma unroll
        for (unsigned j = 0; j < 16; ++j) { const unsigned c = xb_ld(&bar[XB_XCNT(j)]); sum += c; cnt += (c > 0u) ? 1u : 0u; mine = (j == x) ? c : mine; }
        if (sum == G) break;
        __builtin_amdgcn_s_sleep(1);
        if ((++sp & 255u) == 0u) { if (xb_ld(&bar[XB_TMO])) break; if (sp > XB_SPIN_CAP) { atomicAdd(&bar[XB_TMO], 1u); break; } }
    }
    nloc = mine > 0u ? mine : 1u; nx = cnt > 0u ? cnt : 1u;
}

__device__ __forceinline__ void xcd_barrier(const XcdBarrier& b) {
    asm volatile("s_waitcnt vmcnt(0)" ::: "memory");
    __syncthreads();
    if (threadIdx.x == 0) {
        unsigned* bar = b.bar;
        __builtin_amdgcn_s_waitcnt(0);
        unsigned nloc = b.st[0], nx = b.st[1];
        if (nloc == 0u) { xcd_barrier_complete(bar, b.x, nloc, nx); b.st[0] = nloc; b.st[1] = nx; }
        const unsigned old = xb_add(&bar[XB_XSUB(b.x)], 1u);
        const unsigned gen = old / nloc;
        if (old + 1u == (gen + 1u) * nloc) {
            __builtin_amdgcn_fence(__ATOMIC_RELEASE, "agent");
            asm volatile("s_waitcnt vmcnt(0)" ::: "memory");
            const unsigned og = xb_add(&bar[XB_TOP], 1u);
            const unsigned tg = og / nx;
            if (og + 1u == (tg + 1u) * nx) xb_add(&bar[XB_TOPGEN], 1u);
            else XB_SPIN(xb_ld(&bar[XB_TOPGEN]) == tg, bar);
            __builtin_amdgcn_fence(__ATOMIC_ACQUIRE, "agent");
            xb_add(&bar[XB_XGEN(b.x)], 1u);
            asm volatile("s_waitcnt vmcnt(0)" ::: "memory");
        } else {
            XB_SPIN(xb_ld(&bar[XB_XGEN(b.x)]) == gen, bar);
            __builtin_amdgcn_fence(__ATOMIC_ACQUIRE, "agent");
            asm volatile("s_waitcnt vmcnt(0)" ::: "memory");
        }
    }
    __syncthreads();
}
#define SYNC() __syncthreads()
#define WAVE_LDS_FENCE() do { asm volatile("s_waitcnt lgkmcnt(0)" ::: "memory"); } while (0)
#define COMPILER_MEM_FENCE() asm volatile("" ::: "memory")
#define FAST_SIN(x) __sinf(x)
#define FAST_COS(x) __cosf(x)
DEVFN f32x4 mfma16(bf16x8 a, bf16x8 b, f32x4 c) { return __builtin_amdgcn_mfma_f32_16x16x32_bf16(a, b, c, 0, 0, 0); }
DEVFN float shfl_xor_f(float v, int m) { return __shfl_xor(v, m); }
DEVFN float shfl_f(float v, int src) { return __shfl(v, src); }
DEVFN float shfl_up_f(float v, int d) { return __shfl_up(v, d); }
DEVFN Ctx relaunder(const Ctx& C0) {
    Ctx C = C0; int tid = C0.tid; asm volatile("" : "+v"(tid)); C.tid = tid; C.lane = tid & 63; C.wave = __builtin_amdgcn_readfirstlane(tid >> 6); return C;
}
DEVFN float FMA_OP(float a, float b, float c) { float r; asm("v_fma_f32 %0, %1, %2, %3" : "=v"(r) : "v"(a), "v"(b), "v"(c)); return r; }
#define QUEUE_PULL(p) __hip_atomic_fetch_add((p), 1u, __ATOMIC_RELAXED, __HIP_MEMORY_SCOPE_AGENT)
DEVFN float wave_sum(float v) {
#pragma unroll
    for (int o = 1; o < 64; o <<= 1) v += shfl_xor_f(v, o);
    return v;
}
DEVFN void p0_transpose_item(const float* W, int N, int nsrc0, bf16_t* WT, int ndst0, int k0, LDSQ float* scr, int lane) {
#pragma unroll 8
    for (int i = 0; i < 32; ++i) { const int kk = 2 * i + (lane >> 5); scr[kk * 33 + (lane & 31)] = W[(size_t)(k0 + kk) * N + nsrc0 + (lane & 31)]; }
    WAVE_LDS_FENCE();
    const int c = lane & 7;
#pragma unroll
    for (int j = 0; j < 4; ++j) { const int n = (lane >> 3) + 8 * j; const LDSQ float* s = scr + (8 * c) * 33 + n;
        u32x4 o; o.x = pk2(s[0 * 33], s[1 * 33]); o.y = pk2(s[2 * 33], s[3 * 33]); o.z = pk2(s[4 * 33], s[5 * 33]); o.w = pk2(s[6 * 33], s[7 * 33]);
        *(u32x4*)(WT + (size_t)(ndst0 + n) * 1024 + k0 + 8 * c) = o; }
    WAVE_LDS_FENCE();
}
DEVFN void phase_p0a(const Ctx& C) {
    LDSQ float* scr = (LDSQ float*)(C.lds + C.wave * 16384);
    const int gw = C.cu * 8 + C.wave, NGW = C.ncu * 8;
    bf16_t* WIN = WSP(bf16_t, WS_WIN); bf16_t* WOUT = WSP(bf16_t, WS_WOUT); bf16_t* WADA = WSP(bf16_t, WS_WADA);
    constexpr int I_IN = 4 * 16 * 128, I_OUT = 4 * 16 * 32, I_ADA = 4 * 16 * 96, I_FIN = 16 * 64;
    for (int it = gw; it < I_IN + I_OUT + I_ADA + I_FIN; it += NGW) {
        int r = it;
        if (r < I_IN) { const int l = r / 2048, rr = r % 2048, kb = rr / 128, nb = rr % 128, nd = 32 * nb, ns = nd < 2560 ? nd : nd + 12;
            p0_transpose_item(C.w_in + (size_t)l * 1024 * IN_W, IN_W, ns, WIN + (size_t)l * 4096 * 1024, nd, 64 * kb, scr, C.lane); continue; }
        r -= I_IN;
        if (r < I_OUT) { const int l = r / 512, rr = r % 512, kb = rr / 32, nb = rr % 32;
            p0_transpose_item(C.w_out + (size_t)l * 1024 * 1024, 1024, 32 * nb, WOUT + (size_t)l * 1024 * 1024, 32 * nb, 64 * kb, scr, C.lane); continue; }
        r -= I_OUT;
        if (r < I_ADA) { const int l = r / 1536, rr = r % 1536, kb = rr / 96, nb = rr % 96;
            p0_transpose_item(C.w_ada + (size_t)l * 1024 * 3072, 3072, 32 * nb, WADA + (size_t)l * 3072 * 1024, 32 * nb, 64 * kb, scr, C.lane); continue; }
        r -= I_ADA;
        { const int kb = r / 64, nb = r % 64;
            p0_transpose_item(C.w_ada_final, 2048, 32 * nb, WADA + (size_t)12288 * 1024, 32 * nb, 64 * kb, scr, C.lane); }
    }
    const int gt = C.cu * 512 + C.tid, NGT = C.ncu * 512;
    float* WAB = WSP(float, WS_WAB);
    for (int i = gt; i < 4 * 12 * 1024; i += NGT) { const int l = i / 12288, j = (i / 1024) % 12, k = i % 1024; WAB[i] = C.w_in[((size_t)l * 1024 + k) * IN_W + 2560 + j]; }
    unsigned* CB = WSP(unsigned, WS_CB);
    for (int i = gt; i < 256 * 512; i += NGT) { const int row = i / 512, c = 2 * (i % 512); float a = 0.f, b = 0.f;
        if (row < NBP) { a = C.c_prompt[row * 1024 + c]; b = C.c_prompt[row * 1024 + c + 1]; }
        else if (row < NBROW) { a = C.c_sample[(row - NBP) * 1024 + c]; b = C.c_sample[(row - NBP) * 1024 + c + 1]; }
        CB[i] = pk2(a, b); }
    float* ROPE = WSP(float, WS_ROPE);
    for (int i = gt; i < 2052 * 8; i += NGT) { const int pos = i >> 3, j = i & 7;
        const float invf[8] = {1.0f, 0.1939227432012558f, 0.03760603070259094f, 0.007292664609849453f, 0.0014142135623842478f, 0.00027424818836152554f, 5.3182957344688475e-05f, 1.0313385246263351e-05f};
        float fr = 1.0f;
#pragma unroll
        for (int q = 0; q < 8; ++q) fr = (j == q) ? invf[q] : fr;
        const float ang = (float)pos * fr;
        const double a = (double)ang, tw = 6.283185307179586476925;
        const double kq = __builtin_floor(a / tw + 0.5); const float red = (float)(a - kq * tw);
        ROPE[pos * 16 + j] = FAST_COS(red); ROPE[pos * 16 + 8 + j] = FAST_SIN(red); }
}
DEVFN int brow_of(int m) { return m < M_P ? (m >> 11) : NBP + ((m - M_P) >> 2); }
DEVFN const float* xrow_l0(const Ctx& C, int m) { return m < M_P ? C.x_prompt + (size_t)m * 1024 : C.x_sample + (size_t)(m - M_P) * 1024; }
DEVFN void phase_norm(const Ctx& C, int l) {
    const int gw = C.cu * 8 + C.wave, NGW = C.ncu * 8;
    const float* X = WSP(float, WS_X); bf16_t* HN = WSP(bf16_t, WS_HN); float* AB = WSP(float, WS_AB);
    const float* MOD = WSP(float, WS_MOD); const float* WAB = WSP(float, WS_WAB) + l * 12 * 1024;
    const f32x4* nw = (const f32x4*)(C.norm_w + l * 1024) + C.lane;
    for (int m = gw; m < M_T; m += NGW) {
        const f32x4* xr = (const f32x4*)(l == 0 ? xrow_l0(C, m) : X + (size_t)m * 1024) + C.lane;
        const float* mod = MOD + (size_t)brow_of(m) * NMOD + l * 3072;
        f32x4 v[4]; float s = 0.f;
#pragma unroll
        for (int j = 0; j < 4; ++j) { v[j] = xr[64 * j]; s += (v[j].x * v[j].x + v[j].y * v[j].y) + (v[j].z * v[j].z + v[j].w * v[j].w); }
        const float rstd = 1.f / sqrtf(wave_sum(s) * (1.f / 1024.f) + 1e-6f);
#pragma unroll
        for (int j = 0; j < 4; ++j) { const f32x4 w = nw[64 * j], sh = ((const f32x4*)mod)[64 * j + C.lane], sc = ((const f32x4*)(mod + 1024))[64 * j + C.lane];
            v[j] = v[j] * rstd * w * (sc + 1.0f) + sh; }
        u32x2* o8 = (u32x2*)(HN + (size_t)m * 1024) + C.lane;
#pragma unroll
        for (int j = 0; j < 4; ++j) { u32x2 o; o.x = pk2(v[j].x, v[j].y); o.y = pk2(v[j].z, v[j].w); o8[64 * j] = o; }
        float myab = 0.f;
#pragma unroll
        for (int q = 0; q < 12; ++q) { float d = 0.f;
#pragma unroll
            for (int j = 0; j < 4; ++j) { const f32x4 w = ((const f32x4*)(WAB + q * 1024))[64 * j + C.lane]; d += (v[j].x * w.x + v[j].y * w.y) + (v[j].z * w.z + v[j].w * w.w); }
            d = wave_sum(d); myab = (C.lane == q) ? d : myab; }
        if (C.lane < 12) AB[(size_t)m * 16 + C.lane] = myab;
    }
}
DEVFN void phase_final(const Ctx& C) {
    const int gw = C.cu * 8 + C.wave, NGW = C.ncu * 8;
    const float* X = WSP(float, WS_X); const float* MOD = WSP(float, WS_MOD);
    const f32x4* nw = (const f32x4*)C.final_norm_w + C.lane;
    for (int m = gw; m < M_T; m += NGW) {
        const f32x4* xr = (const f32x4*)(X + (size_t)m * 1024) + C.lane;
        const float* mod = MOD + (size_t)brow_of(m) * NMOD + 12288;
        f32x4 v[4]; float s = 0.f;
#pragma unroll
        for (int j = 0; j < 4; ++j) { v[j] = xr[64 * j]; s += (v[j].x * v[j].x + v[j].y * v[j].y) + (v[j].z * v[j].z + v[j].w * v[j].w); }
        const float rstd = 1.f / sqrtf(wave_sum(s) * (1.f / 1024.f) + 1e-6f);
        f32x4* o = (f32x4*)(C.outp + (m < M_P ? O_YP + (size_t)m * 1024 : O_YS + (size_t)(m - M_P) * 1024)) + C.lane;
#pragma unroll
        for (int j = 0; j < 4; ++j) { const f32x4 w = nw[64 * j], sh = ((const f32x4*)mod)[64 * j + C.lane], sc = ((const f32x4*)(mod + 1024))[64 * j + C.lane];
            o[64 * j] = v[j] * rstd * w * (sc + 1.0f) + sh; }
    }
}
DEVFN bf16x8 lds_frag(const LDSQ bf16_t* base, int ld, int row, int col) { return *(const LDSQ bf16x8*)(base + row * ld + col); }
DEVFN bf16x8 glb_frag(const bf16_t* base, int ld, int row, int col) { return *(const bf16x8*)(base + (size_t)row * ld + col); }
DEVFN bf16x8 zero_frag() { bf16x8 z = {0, 0, 0, 0, 0, 0, 0, 0}; return z; }
DEVFN u32x2 pack4(f32x4 v) { u32x2 o; o.x = pk2(v.x, v.y); o.y = pk2(v.z, v.w); return o; }
constexpr int LDP = 72;
constexpr float NEG_BIG = -1e30f;
DEVFN int inv_perm(int c) { return (c & 32) | (((c >> 2) & 3) << 3) | (((c >> 4) & 1) << 2) | (c & 3); }
DEVFN bf16x8 acc_pair_frag(f32x4 lo, f32x4 hi) { const u32x4 u = {pk2(lo.x, lo.y), pk2(lo.z, lo.w), pk2(hi.x, hi.y), pk2(hi.z, hi.w)}; return __builtin_bit_cast(bf16x8, u); }

DEVFN void conv_a_item(const Ctx& C, int l, int item) {
    const bf16_t* U = WSP(bf16_t, WS_U); bf16_t* MIX = WSP(bf16_t, WS_MIX);
    const int rl = C.tid >> 5, ch = (C.tid & 31) * 8;
    float w[3][8];
#pragma unroll
    for (int j = 0; j < 3; ++j)
#pragma unroll
        for (int e = 0; e < 8; ++e) w[j][e] = C.conv_a_w[(l * 3 + j) * 256 + ch + e];
    for (int pass = 0; pass < 4; ++pass) {
        const int m = item * 64 + pass * 16 + rl;
        const bool smp = m >= M_P; const int b = smp ? (m - M_P) >> 2 : m >> 11, t = smp ? (m - M_P) & 3 : m & 2047;
        float P[3][8];
#pragma unroll
        for (int j = 0; j < 3; ++j) { const int tt = t - 2 + j;
            if (tt >= 0) { const size_t r = (size_t)(m - 2 + j) * NU; float a[8], c[8];
                unpack8(*(const u32x4*)(U + r + UC_AX + ch), a); unpack8(*(const u32x4*)(U + r + UC_ACG + ch), c);
#pragma unroll
                for (int e = 0; e < 8; ++e) P[j][e] = a[e] * c[e]; }
            else if (smp) { const float* s = C.st_conv_a + ((size_t)(l * NBS + b) * 2 + (tt + 2)) * 256 + ch;
#pragma unroll
                for (int e = 0; e < 8; ++e) P[j][e] = s[e]; }
            else {
#pragma unroll
                for (int e = 0; e < 8; ++e) P[j][e] = 0.f; } }
        float bg[8], z[8], y[8];
        unpack8(*(const u32x4*)(U + (size_t)m * NU + UC_ABG + ch), bg); unpack8(*(const u32x4*)(U + (size_t)m * NU + UC_AZ + ch), z);
#pragma unroll
        for (int e = 0; e < 8; ++e) y[e] = bg[e] * (w[0][e] * P[0][e] + w[1][e] * P[1][e] + w[2][e] * P[2][e]) * silu_f(z[e]);
        *(u32x4*)(MIX + (size_t)m * 1024 + ch) = pack8(y);
        const int last = smp ? 4 : 2048;
        if (t >= last - 2) { float* o = C.outp + (smp ? O_CAS + ((size_t)(l * NBS + b) * 2 + (t - 2)) * 256 : O_CAP + ((size_t)(l * NBP + b) * 2 + (t - 2046)) * 256) + ch;
#pragma unroll
            for (int e = 0; e < 8; ++e) o[e] = P[2][e]; }
    }
}

constexpr int GP_KN = 0, GP_QN = 9216, GP_VBT = 18432, GP_KBGT = 27648, GP_KDT = 36864, GP_LB = 46080, GP_TR = 55296, GP_TT = 64512, GP_AM = 73728, GP_WM = 82944,
              GP_LF = 92160  , GP_PT = 109568  , GP_QT = 112128  , GP_G = 114688  ;
DEVFN void gdn_prep_item(const Ctx& C, int l, int item) {
    const int b = item / 192, h = (item / 32) % 6, n = item % 32;
    const int lane = C.lane, quad = lane >> 4, l15 = lane & 15, wave = C.wave;
    const bf16_t* U = WSP(bf16_t, WS_U); const float* AB = WSP(float, WS_AB);
    unsigned char* cbase = C.wsp + WS_GDN + (size_t)item * GDN_CHUNK_BYTES;
    bf16_t* gWm = (bf16_t*)cbase; bf16_t* gQG = (bf16_t*)(cbase + 8192); bf16_t* gAm = (bf16_t*)(cbase + 16384); bf16_t* gKDt = (bf16_t*)(cbase + 24576); bf16_t* gUt = (bf16_t*)(cbase + 32768);
    LDSQ bf16_t* Kn = (LDSQ bf16_t*)(C.lds + GP_KN); LDSQ bf16_t* Qn = (LDSQ bf16_t*)(C.lds + GP_QN); LDSQ bf16_t* VbT = (LDSQ bf16_t*)(C.lds + GP_VBT);
    LDSQ bf16_t* KbgT = (LDSQ bf16_t*)(C.lds + GP_KBGT); LDSQ bf16_t* KDt = (LDSQ bf16_t*)(C.lds + GP_KDT); LDSQ bf16_t* Lb = (LDSQ bf16_t*)(C.lds + GP_LB);
    LDSQ bf16_t* Tr = (LDSQ bf16_t*)(C.lds + GP_TR); LDSQ bf16_t* Tt = (LDSQ bf16_t*)(C.lds + GP_TT); LDSQ bf16_t* Am = (LDSQ bf16_t*)(C.lds + GP_AM); LDSQ bf16_t* Wm = (LDSQ bf16_t*)(C.lds + GP_WM);
    LDSQ float* Lf = (LDSQ float*)(C.lds + GP_LF); LDSQ bf16_t* PT = (LDSQ bf16_t*)(C.lds + GP_PT); LDSQ bf16_t* QT = (LDSQ bf16_t*)(C.lds + GP_QT);
    LDSQ float* gl = (LDSQ float*)(C.lds + GP_G); LDSQ float* gcl = gl + 64; LDSQ float* betal = gl + 128;
    const int i = C.tid >> 3, cg = C.tid & 7, t = 64 * n + i;
    const size_t row = (size_t)b * 2048 + t;
    float q[8], k[8], v[8], xq[8], xk[8], xv[8];
#pragma unroll
    for (int e = 0; e < 8; ++e) { q[e] = 0.f; k[e] = 0.f; v[e] = 0.f; xq[e] = 0.f; xk[e] = 0.f; xv[e] = 0.f; }
    const int cq = h * 64 + 8 * cg;
#pragma unroll
    for (int j = 0; j < 4; ++j) { const int tt = t - 3 + j;
        if (tt >= 0) { const bf16_t* ur = U + (row - 3 + j) * NU + cq;
            unpack8(*(const u32x4*)(ur + UC_BQ), xq); unpack8(*(const u32x4*)(ur + UC_BK), xk); unpack8(*(const u32x4*)(ur + UC_BV), xv);
            const float* wr_ = C.conv_b_w + (size_t)(l * 4 + j) * 1152 + cq;
#pragma unroll
            for (int e = 0; e < 8; ++e) { q[e] += xq[e] * wr_[e]; k[e] += xk[e] * wr_[384 + e]; v[e] += xv[e] * wr_[768 + e]; } } }
    if (n == 31 && i >= 61) { float* o = C.outp + O_CBP + ((size_t)(l * NBP + b) * 3 + (i - 61)) * 1152 + cq;
#pragma unroll
        for (int e = 0; e < 8; ++e) { o[e] = xq[e]; o[384 + e] = xk[e]; o[768 + e] = xv[e]; } }
    float sq = 0.f, sk = 0.f;
#pragma unroll
    for (int e = 0; e < 8; ++e) { q[e] = silu_f(q[e]); k[e] = silu_f(k[e]); v[e] = silu_f(v[e]); sq += q[e] * q[e]; sk += k[e] * k[e]; }
    sq += shfl_xor_f(sq, 1); sq += shfl_xor_f(sq, 2); sq += shfl_xor_f(sq, 4);
    sk += shfl_xor_f(sk, 1); sk += shfl_xor_f(sk, 2); sk += shfl_xor_f(sk, 4);
    const float rq = 0.125f / sqrtf(sq + 1e-6f), rk = 1.0f / sqrtf(sk + 1e-6f);
#pragma unroll
    for (int e = 0; e < 8; ++e) { q[e] *= rq; k[e] *= rk; }
    if (cg == 0) { const float ga = AB[row * 16 + h], gb = AB[row * 16 + 6 + h];
        gl[i] = -expf(C.a_log[l * 6 + h]) * softplus_f(ga + C.dt_bias[l * 6 + h]); betal[i] = sigmoid_f(gb); }
    for (int e = C.tid; e < 2 * 64 * LDP / 2; e += 512) ((LDSQ unsigned*)Tr)[e] = 0u;
    SYNC();
    if (wave == 0) { float x = gl[lane];
#pragma unroll
        for (int d = 1; d < 64; d <<= 1) { const float y = shfl_up_f(x, d); if (lane >= d) x += y; }
        gcl[lane] = x; }
    SYNC();
    const float gci = gcl[i], glast = gcl[63], bi = betal[i];
    const float egc = expf(gci), ekd = expf(glast - gci);
    {
        float tq[8];
#pragma unroll
        for (int e = 0; e < 8; ++e) tq[e] = q[e] * egc;
        { const int c0 = 32 * (cg >> 2) + 16 * (cg & 1) + 4 * ((cg >> 1) & 1);
            *(u32x2*)(gQG + i * 64 + c0) = (u32x2){pk2(tq[0], tq[1]), pk2(tq[2], tq[3])}; *(u32x2*)(gQG + i * 64 + c0 + 8) = (u32x2){pk2(tq[4], tq[5]), pk2(tq[6], tq[7])}; }
        *(LDSQ u32x4*)(Kn + i * LDP + 8 * cg) = pack8(k); *(LDSQ u32x4*)(Qn + i * LDP + 8 * cg) = pack8(q);
#pragma unroll
        for (int e = 0; e < 8; ++e) { const int d = 8 * cg + e;
            VbT[d * LDP + i] = (bf16_t)f2bf(v[e] * bi); KbgT[d * LDP + i] = (bf16_t)f2bf(k[e] * bi * egc); KDt[d * LDP + inv_perm(i)] = (bf16_t)f2bf(k[e] * ekd); }
    }
    SYNC();
#pragma unroll 1
    for (int jj = 0; jj < 4; ++jj) { const int job = wave * 4 + jj, type = job >> 4, it = (job & 15) >> 2, jt = job & 3;
        if (it < jt) { if (type == 1) {
#pragma unroll
                for (int r = 0; r < 4; ++r) Am[(16 * it + 4 * quad + r) * LDP + inv_perm(16 * jt + l15)] = 0; }
            continue; }
        f32x4 acc = {0.f, 0.f, 0.f, 0.f};
#pragma unroll
        for (int s = 0; s < 2; ++s) { const bf16x8 a = lds_frag(type ? Qn : Kn, LDP, 16 * it + l15, 32 * s + 8 * quad), bb = lds_frag(Kn, LDP, 16 * jt + l15, 32 * s + 8 * quad);
            acc = mfma16(a, bb, acc); }
        const int jc = 16 * jt + l15; const float gj = gcl[jc];
#pragma unroll
        for (int r = 0; r < 4; ++r) { const int ir = 16 * it + 4 * quad + r; const float gi = gcl[ir];
            if (type == 0) { const float val = (ir > jc) ? betal[ir] * acc[r] * expf(gi - gj) : 0.f; Lf[ir * 68 + jc] = val; Lb[ir * LDP + jc] = (bf16_t)f2bf(val); }
            else { const float val = (ir >= jc) ? acc[r] * expf(gi - gj) : 0.f; Am[ir * LDP + inv_perm(jc)] = (bf16_t)f2bf(val); } }
    }
    SYNC();
    if (wave == 0) { const int blk = quad, c = l15; float x[16];
#pragma unroll
        for (int ii = 0; ii < 16; ++ii) { float s = (ii == c) ? 1.f : 0.f;
#pragma unroll
            for (int jx = 0; jx < ii; ++jx) s -= Lf[(16 * blk + ii) * 68 + 16 * blk + jx] * x[jx];
            x[ii] = s; }
#pragma unroll
        for (int ii = 0; ii < 16; ++ii) Tr[(16 * blk + ii) * LDP + 16 * blk + c] = (bf16_t)f2bf(x[ii]);
        *(LDSQ u32x4*)(Tt + (16 * blk + c) * LDP + 16 * blk) = pack8(x); *(LDSQ u32x4*)(Tt + (16 * blk + c) * LDP + 16 * blk + 8) = pack8(x + 8); }
    SYNC();
    if (wave < 2) { const int rb = 2 * wave + 1, cb = 2 * wave; LDSQ bf16_t* pt = PT + wave * 16 * 40;
        bf16x8 a = quad < 2 ? lds_frag(Lb, LDP, 16 * rb + l15, 16 * cb + 8 * quad) : zero_frag();
        bf16x8 bb = quad < 2 ? lds_frag(Tt, LDP, 16 * cb + l15, 16 * cb + 8 * quad) : zero_frag();
        f32x4 z = {0.f, 0.f, 0.f, 0.f}; f32x4 p = mfma16(a, bb, z);
        *(LDSQ u32x2*)(pt + l15 * 40 + 4 * quad) = pack4(p);
        WAVE_LDS_FENCE();
        a = quad < 2 ? lds_frag(Tr, LDP, 16 * rb + l15, 16 * rb + 8 * quad) : zero_frag();
        bb = quad < 2 ? lds_frag(pt, 40, l15, 8 * quad) : zero_frag();
        f32x4 r4 = mfma16(a, bb, z); r4 = -r4;
#pragma unroll
        for (int r = 0; r < 4; ++r) Tr[(16 * rb + 4 * quad + r) * LDP + 16 * cb + l15] = (bf16_t)f2bf(r4[r]);
        *(LDSQ u32x2*)(Tt + (16 * cb + l15) * LDP + 16 * rb + 4 * quad) = pack4(r4); }
    SYNC();
    if (wave < 4) { const int it2 = wave >> 1, jt2 = wave & 1;
        const bf16x8 a = lds_frag(Lb, LDP, 32 + 16 * it2 + l15, 8 * quad), bb = lds_frag(Tt, LDP, 16 * jt2 + l15, 8 * quad);
        f32x4 z = {0.f, 0.f, 0.f, 0.f}; const f32x4 p = mfma16(a, bb, z);
        *(LDSQ u32x2*)(QT + (16 * jt2 + l15) * 40 + 16 * it2 + 4 * quad) = pack4(p); }
    SYNC();
    if (wave < 4) { const int it2 = wave >> 1, jt2 = wave & 1;
        const bf16x8 a = lds_frag(Tr, LDP, 32 + 16 * it2 + l15, 32 + 8 * quad), bb = lds_frag(QT, 40, 16 * jt2 + l15, 8 * quad);
        f32x4 z = {0.f, 0.f, 0.f, 0.f}; f32x4 r4 = mfma16(a, bb, z); r4 = -r4;
#pragma unroll
        for (int r = 0; r < 4; ++r) Tr[(32 + 16 * it2 + 4 * quad + r) * LDP + 16 * jt2 + l15] = (bf16_t)f2bf(r4[r]);
        *(LDSQ u32x2*)(Tt + (16 * jt2 + l15) * LDP + 32 + 16 * it2 + 4 * quad) = pack4(r4); }
    SYNC();
#pragma unroll 1
    for (int jj = 0; jj < 4; ++jj) { const int job = wave * 4 + jj, type = job >> 4, it = (job & 15) >> 2, nt = job & 3;
        f32x4 acc = {0.f, 0.f, 0.f, 0.f};
#pragma unroll
        for (int s = 0; s < 2; ++s) { const bf16x8 a = lds_frag(Tr, LDP, 16 * it + l15, 32 * s + 8 * quad), bb = lds_frag(type ? KbgT : VbT, LDP, 16 * nt + l15, 32 * s + 8 * quad);
            acc = mfma16(a, bb, acc); }
        if (type == 0) *(u32x2*)(gUt + (16 * nt + l15) * 64 + 16 * it + 4 * quad) = pack4(acc);
        else {
#pragma unroll
            for (int r = 0; r < 4; ++r) Wm[(16 * it + 4 * quad + r) * LDP + inv_perm(16 * nt + l15)] = (bf16_t)f2bf(acc[r]); } }
    SYNC();
    { const int r = C.tid >> 3, c8 = (C.tid & 7) * 8;
        *(u32x4*)(gWm + r * 64 + c8) = *(const LDSQ u32x4*)(Wm + r * LDP + c8);
        *(u32x4*)(gAm + r * 64 + c8) = *(const LDSQ u32x4*)(Am + r * LDP + c8);
        *(u32x4*)(gKDt + r * 64 + c8) = *(const LDSQ u32x4*)(KDt + r * LDP + c8);
        if (C.tid == 0) WSP(float, WS_GSC)[item] = expf(glast); }
    SYNC();
}

constexpr int SB_A = 0, SB_ABUF = 46080  , SB_O = 92160  , SB_OBUF = 17408, SB_DEC = 126976  ;
DEVFN void scan_ld(u32x4 (&r)[10], const unsigned char* cbase, int lt) {
#pragma unroll
    for (int k = 0; k < 10; ++k) r[k] = *(const u32x4*)(cbase + (size_t)(lt + 256 * k) * 16);
}
DEVFN void scan_st(const u32x4 (&r)[10], LDSQ unsigned char* abuf, int lt) {
#pragma unroll
    for (int k = 0; k < 10; ++k) { const int p = lt + 256 * k, mat = p >> 9, row = (p & 511) >> 3, c8 = p & 7; *(LDSQ u32x4*)(abuf + mat * 9216 + row * 144 + c8 * 16) = r[k]; }
}
DEVFN void scan_zld(u32x4 (&z)[2], const bf16_t* U, int b, int h, int n, int lw, int lane) {
    const size_t m = (size_t)b * 2048 + 64 * n + 16 * lw + (lane >> 2); const bf16_t* zp = U + m * NU + UC_BZ + h * 64 + 16 * (lane & 3);
    z[0] = *(const u32x4*)zp; z[1] = *(const u32x4*)(zp + 8);
}
DEVFN void scan_epi(const Ctx& C, const u32x4 (&z)[2], const LDSQ float* obuf, const float (&nw)[16], int b, int h, int n, int lw, int lane) {
    const int row = 16 * lw + (lane >> 2), c0 = 16 * (lane & 3); float o[16], zf[16]; float ss = 0.f;
#pragma unroll
    for (int q = 0; q < 4; ++q) { const f32x4 v = *(const LDSQ f32x4*)(obuf + row * 68 + c0 + 4 * q); o[4 * q] = v.x; o[4 * q + 1] = v.y; o[4 * q + 2] = v.z; o[4 * q + 3] = v.w; ss += (v.x * v.x + v.y * v.y) + (v.z * v.z + v.w * v.w); }
    ss += shfl_xor_f(ss, 1); ss += shfl_xor_f(ss, 2);
    const float rstd = 1.0f / sqrtf(ss * (1.f / 64.f) + 1e-6f);
    unpack8(z[0], zf); unpack8(z[1], zf + 8);
#pragma unroll
    for (int e = 0; e < 16; ++e) o[e] = o[e] * rstd * nw[e] * silu_f(zf[e]);
    bf16_t* mp = WSP(bf16_t, WS_MIX) + ((size_t)b * 2048 + 64 * n + row) * 1024 + 256 + h * 64 + c0;
    *(u32x4*)mp = pack8(o); *(u32x4*)(mp + 8) = pack8(o + 8);
}
DEVFN void scan_compute(LDSQ unsigned char* abuf, LDSQ float* obuf, f32x4 (&S)[4], float dec, int w, int quad, int l15) {
    const LDSQ bf16_t* Wm = (const LDSQ bf16_t*)abuf; const LDSQ bf16_t* QG = Wm + 4608; const LDSQ bf16_t* Am = Wm + 2 * 4608; const LDSQ bf16_t* KD = Wm + 3 * 4608; const LDSQ bf16_t* Ut = Wm + 4 * 4608;
    const bf16x8 bS0 = acc_pair_frag(S[0], S[1]), bS1 = acc_pair_frag(S[2], S[3]);
    f32x4 vn[4];
#pragma unroll
    for (int it = 0; it < 4; ++it) { f32x4 acc = {0.f, 0.f, 0.f, 0.f};
        acc = mfma16(lds_frag(Wm, LDP, 16 * it + l15, 8 * quad), bS0, acc); acc = mfma16(lds_frag(Wm, LDP, 16 * it + l15, 32 + 8 * quad), bS1, acc);
        const u32x2 u2 = *(const LDSQ u32x2*)(Ut + (16 * w + l15) * LDP + 16 * it + 4 * quad);
        vn[it] = (f32x4){bf_lo(u2.x), bf_hi(u2.x), bf_lo(u2.y), bf_hi(u2.y)} - acc; }
    const bf16x8 bV0 = acc_pair_frag(vn[0], vn[1]), bV1 = acc_pair_frag(vn[2], vn[3]);
#pragma unroll
    for (int kt = 0; kt < 4; ++kt) { f32x4 acc = S[kt] * dec;
        acc = mfma16(lds_frag(KD, LDP, 16 * kt + l15, 8 * quad), bV0, acc); acc = mfma16(lds_frag(KD, LDP, 16 * kt + l15, 32 + 8 * quad), bV1, acc);
        S[kt] = acc; }
#pragma unroll
    for (int it = 0; it < 4; ++it) { f32x4 acc = {0.f, 0.f, 0.f, 0.f};
        acc = mfma16(lds_frag(QG, LDP, 16 * it + l15, 8 * quad), bS0, acc); acc = mfma16(lds_frag(QG, LDP, 16 * it + l15, 32 + 8 * quad), bS1, acc);
        acc = mfma16(lds_frag(Am, LDP, 16 * it + l15, 8 * quad), bV0, acc); acc = mfma16(lds_frag(Am, LDP, 16 * it + l15, 32 + 8 * quad), bV1, acc);
#pragma unroll
        for (int r = 0; r < 4; ++r) obuf[(16 * it + 4 * quad + r) * 68 + 16 * w + l15] = acc[r]; }
}
DEVFN void gdn_scan_unit(const Ctx& C, int l, int unit) {
    const int b = unit / 6, h = unit % 6;
    const int lane = C.lane, quad = lane >> 4, l15 = lane & 15, w = C.wave;
    const bf16_t* U = WSP(bf16_t, WS_U);
    const unsigned char* g0 = C.wsp + WS_GDN + (size_t)unit * 32 * GDN_CHUNK_BYTES;
    LDSQ unsigned char* A0 = C.lds + SB_A; LDSQ float* O0 = (LDSQ float*)(C.lds + SB_O); LDSQ float* decl = (LDSQ float*)(C.lds + SB_DEC);
    const bool comp = w < 4; const int lw = w & 3, lt = C.tid & 255;
    f32x4 S[4];
#pragma unroll
    for (int kt = 0; kt < 4; ++kt) S[kt] = (f32x4){0.f, 0.f, 0.f, 0.f};
    u32x4 ra[10], ze[2], zo[2]; float nw[16];
    if (!comp) {
#pragma unroll
        for (int e = 0; e < 16; ++e) nw[e] = C.gdn_norm_w[l * 64 + 16 * (lane & 3) + e];
        if (lt < 32) decl[lt] = WSP(float, WS_GSC)[unit * 32 + lt];
        scan_ld(ra, g0, lt); scan_st(ra, A0, lt); scan_ld(ra, g0 + GDN_CHUNK_BYTES, lt);
    }
    SYNC();
#pragma unroll 1
    for (int n = 0; n < 32; n += 2) {
        if (comp) scan_compute(A0, O0, S, decl[n], w, quad, l15);
        else { scan_st(ra, A0 + SB_ABUF, lt);
            if (n + 2 < 32) scan_ld(ra, g0 + (size_t)(n + 2) * GDN_CHUNK_BYTES, lt);
            scan_zld(ze, U, b, h, n, lw, lane);
            if (n > 0) scan_epi(C, zo, O0 + SB_OBUF / 4, nw, b, h, n - 1, lw, lane); }
        SYNC();
        if (comp) scan_compute(A0 + SB_ABUF, O0 + SB_OBUF / 4, S, decl[n + 1], w, quad, l15);
        else { if (n + 2 < 32) scan_st(ra, A0, lt);
            if (n + 3 < 32) scan_ld(ra, g0 + (size_t)(n + 3) * GDN_CHUNK_BYTES, lt);
            scan_zld(zo, U, b, h, n + 1, lw, lane);
            scan_epi(C, ze, O0, nw, b, h, n, lw, lane); }
        SYNC();
    }
    if (!comp) scan_epi(C, zo, O0 + SB_OBUF / 4, nw, b, h, 31, lw, lane);
    else { float* og = C.outp + O_GP + ((size_t)(l * NBP + b) * 6 + h) * 4096;
#pragma unroll
        for (int kt = 0; kt < 4; ++kt)
#pragma unroll
            for (int r = 0; r < 4; ++r) og[(16 * kt + 4 * quad + r) * 64 + 16 * w + l15] = S[kt][r]; }
    SYNC();
}

DEVFN void gdn_sample_item(const Ctx& C, int l, int witem, LDSQ float* kq) {
    const int b = witem / 6, h = witem % 6, d = C.lane, m0 = M_P + 4 * b;
    const bf16_t* U = WSP(bf16_t, WS_U); bf16_t* MIX = WSP(bf16_t, WS_MIX); const float* AB = WSP(float, WS_AB);
    float qv[4], kv[4], vv[4];
    {
        float xp[3][7];
#pragma unroll
        for (int c = 0; c < 3; ++c) { const int ch = c * 384 + h * 64 + d;
#pragma unroll
            for (int j = 0; j < 3; ++j) xp[c][j] = C.st_conv_b[((size_t)(l * NBS + b) * 3 + j) * 1152 + ch];
#pragma unroll
            for (int i = 0; i < 4; ++i) xp[c][3 + i] = bf2f(U[(size_t)(m0 + i) * NU + (c == 0 ? UC_BQ : c == 1 ? UC_BK : UC_BV) + h * 64 + d]);
#pragma unroll
            for (int j = 0; j < 3; ++j) C.outp[O_CBS + ((size_t)(l * NBS + b) * 3 + j) * 1152 + ch] = xp[c][4 + j];
            float wt[4];
#pragma unroll
            for (int j = 0; j < 4; ++j) wt[j] = C.conv_b_w[(size_t)(l * 4 + j) * 1152 + ch];
#pragma unroll
            for (int i = 0; i < 4; ++i) { const float y = silu_f(wt[0] * xp[c][i] + wt[1] * xp[c][i + 1] + wt[2] * xp[c][i + 2] + wt[3] * xp[c][i + 3]);
                if (c == 0) qv[i] = y; else if (c == 1) kv[i] = y; else vv[i] = y; } }
    }
#pragma unroll
    for (int i = 0; i < 4; ++i) { const float sq = wave_sum(qv[i] * qv[i]), sk = wave_sum(kv[i] * kv[i]); qv[i] *= 0.125f / sqrtf(sq + 1e-6f); kv[i] *= 1.0f / sqrtf(sk + 1e-6f); }
    float S[64];
    const float* s0 = C.st_gdn + ((size_t)(l * NBS + b) * 6 + h) * 4096 + d;
#pragma unroll
    for (int dk = 0; dk < 64; ++dk) S[dk] = s0[dk * 64];
    const float alog = -expf(C.a_log[l * 6 + h]), dtb = C.dt_bias[l * 6 + h], nw = C.gdn_norm_w[l * 64 + d];
#pragma unroll 1
    for (int i = 0; i < 4; ++i) {
        const float g = alog * softplus_f(AB[(size_t)(m0 + i) * 16 + h] + dtb), beta = sigmoid_f(AB[(size_t)(m0 + i) * 16 + 6 + h]);
        const float eg = expf(g);
        float qi = qv[0], ki = kv[0], vi = vv[0];
#pragma unroll
        for (int j = 1; j < 4; ++j) { qi = (i == j) ? qv[j] : qi; ki = (i == j) ? kv[j] : ki; vi = (i == j) ? vv[j] : vi; }
        WAVE_LDS_FENCE();
        kq[d] = ki; kq[64 + d] = qi;
        WAVE_LDS_FENCE();
        float ks0 = 0.f, ks1 = 0.f, ks2 = 0.f, ks3 = 0.f;
#pragma unroll
        for (int d0 = 0; d0 < 64; d0 += 4) { const f32x4 ka = *(const LDSQ f32x4*)(kq + d0);
            ks0 = FMA_OP(ka.x, S[d0], ks0); ks1 = FMA_OP(ka.y, S[d0 + 1], ks1); ks2 = FMA_OP(ka.z, S[d0 + 2], ks2); ks3 = FMA_OP(ka.w, S[d0 + 3], ks3); }
        const float vn = beta * (vi - eg * ((ks0 + ks1) + (ks2 + ks3)));
        float o0 = 0.f, o1 = 0.f, o2 = 0.f, o3 = 0.f;
#pragma unroll
        for (int d0 = 0; d0 < 64; d0 += 4) { const f32x4 ka = *(const LDSQ f32x4*)(kq + d0), qa = *(const LDSQ f32x4*)(kq + 64 + d0);
            S[d0] = FMA_OP(eg, S[d0], ka.x * vn); S[d0 + 1] = FMA_OP(eg, S[d0 + 1], ka.y * vn); S[d0 + 2] = FMA_OP(eg, S[d0 + 2], ka.z * vn); S[d0 + 3] = FMA_OP(eg, S[d0 + 3], ka.w * vn);
            o0 = FMA_OP(qa.x, S[d0], o0); o1 = FMA_OP(qa.y, S[d0 + 1], o1); o2 = FMA_OP(qa.z, S[d0 + 2], o2); o3 = FMA_OP(qa.w, S[d0 + 3], o3); }
        const float o = (o0 + o1) + (o2 + o3);
        const float ssq = wave_sum(o * o); const float rstd = 1.0f / sqrtf(ssq * (1.f / 64.f) + 1e-6f);
        const float z = bf2f(U[(size_t)(m0 + i) * NU + UC_BZ + h * 64 + d]);
        MIX[(size_t)(m0 + i) * 1024 + 256 + h * 64 + d] = (bf16_t)f2bf(o * rstd * nw * silu_f(z));
    }
    float* so = C.outp + O_GS + ((size_t)(l * NBS + b) * 6 + h) * 4096 + d;
#pragma unroll
    for (int dk = 0; dk < 64; ++dk) so[dk * 64] = S[dk];
}

constexpr int AT_K = 0  , AT_Q = 36864  , AT_VT = 55296  , VTP = 296;
DEVFN void rope8(float* x1, float* x2, const float* cs) {
#pragma unroll
    for (int e = 0; e < 8; ++e) { const float a = x1[e], bq = x2[e]; x1[e] = a * cs[e] - bq * cs[8 + e]; x2[e] = bq * cs[e] + a * cs[8 + e]; }
}
DEVFN void attn_prompt_unit(const Ctx& C, int l, int unit) {
    const int g = unit >> 8, uu = unit & 255, b = uu >> 5, h2 = (uu >> 4) & 1, rest = uu & 15;
    const int dil = g == 0 ? 1 : g == 1 ? 4 : 16, nb = g == 0 ? 16 : g == 1 ? 4 : 1, win = g == 0 ? 128 : g == 1 ? 512 : 2048;
    const int r = rest / nb, n = rest % nb, hh = 2 * g + h2;
    const int lane = C.lane, quad = lane >> 4, l15 = lane & 15, w = C.wave;
    const bf16_t* U = WSP(bf16_t, WS_U); const float* ROPE = WSP(float, WS_ROPE); bf16_t* OC = WSP(bf16_t, WS_OC); float* LSE = WSP(float, WS_LSE);
    LDSQ bf16_t* Kl = (LDSQ bf16_t*)(C.lds + AT_K); LDSQ bf16_t* Ql = (LDSQ bf16_t*)(C.lds + AT_Q); LDSQ bf16_t* VT = (LDSQ bf16_t*)(C.lds + AT_VT);
    float* kvout = C.outp + (g == 0 ? O_K128P : g == 1 ? O_K512P : O_K2048P) + (size_t)(l * NBP + b) * win * 256;
    for (int p = 0; p < 4; ++p) { const int idx = C.tid + 512 * p, kk = idx >> 3, c = idx & 7;
        const int mpos = 128 * (n - 1) + kk; const bool ok = mpos >= 0; const int t = mpos * dil + r;
        const bf16_t* ur = U + ((size_t)b * 2048 + (ok ? t : 0)) * NU + hh * 64;
        float v8[8];
        if (ok) unpack8(*(const u32x4*)(ur + UC_CV + 8 * c), v8); else {
#pragma unroll
            for (int e = 0; e < 8; ++e) v8[e] = 0.f; }
#pragma unroll
        for (int e = 0; e < 8; ++e) VT[(8 * c + e) * VTP + kk] = (bf16_t)f2bf(v8[e]);
        const bool wout = (n == nb - 1) && kk >= 128; float* orow = kvout + (size_t)(t - (2048 - win)) * 256 + h2 * 64;
        if (wout) {
#pragma unroll
            for (int e = 0; e < 8; ++e) orow[128 + 8 * c + e] = v8[e]; }
        if (c == 0) { float x1[8], x2[8];
            if (ok) { unpack8(*(const u32x4*)(ur + UC_CK), x1); unpack8(*(const u32x4*)(ur + UC_CK + 8), x2); float cs[16];
#pragma unroll
                for (int e = 0; e < 16; ++e) cs[e] = ROPE[t * 16 + e];
                rope8(x1, x2, cs); }
            else {
#pragma unroll
                for (int e = 0; e < 8; ++e) { x1[e] = 0.f; x2[e] = 0.f; } }
            *(LDSQ u32x4*)(Kl + kk * LDP) = pack8(x1); *(LDSQ u32x4*)(Kl + kk * LDP + 8) = pack8(x2);
            if (wout) {
#pragma unroll
                for (int e = 0; e < 8; ++e) { orow[e] = x1[e]; orow[8 + e] = x2[e]; } } }
        else if (c >= 2) { u32x4 kx = {0u, 0u, 0u, 0u}; if (ok) kx = *(const u32x4*)(ur + UC_CK + 8 * c);
            *(LDSQ u32x4*)(Kl + kk * LDP + 8 * c) = kx;
            if (wout) { float k8[8]; unpack8(kx, k8);
#pragma unroll
                for (int e = 0; e < 8; ++e) orow[8 * c + e] = k8[e]; } }
    }
    for (int p = 0; p < 2; ++p) { const int idx = C.tid + 512 * p, qq = idx >> 3, c = idx & 7;
        const int t = (128 * n + qq) * dil + r; const bf16_t* ur = U + ((size_t)b * 2048 + t) * NU + UC_CQ + hh * 64;
        if (c == 0) { float x1[8], x2[8], cs[16]; unpack8(*(const u32x4*)(ur), x1); unpack8(*(const u32x4*)(ur + 8), x2);
#pragma unroll
            for (int e = 0; e < 16; ++e) cs[e] = ROPE[t * 16 + e];
            rope8(x1, x2, cs);
            *(LDSQ u32x4*)(Ql + qq * LDP) = pack8(x1); *(LDSQ u32x4*)(Ql + qq * LDP + 8) = pack8(x2); }
        else if (c >= 2) *(LDSQ u32x4*)(Ql + qq * LDP + 8 * c) = *(const u32x4*)(ur + 8 * c); }
    for (int e = C.tid; e < 64 * 40; e += 512) VT[(e / 40) * VTP + 256 + (e % 40)] = 0;
    SYNC();
    const int q0 = 16 * w, qi = q0 + l15;
    f32x4 st[9]; float mx = NEG_BIG;
#pragma unroll
    for (int kt = 0; kt < 9; ++kt) { f32x4 acc = {0.f, 0.f, 0.f, 0.f};
#pragma unroll
        for (int s = 0; s < 2; ++s) acc = mfma16(lds_frag(Kl, LDP, 16 * (w + kt) + l15, 32 * s + 8 * quad), lds_frag(Ql, LDP, qi, 32 * s + 8 * quad), acc);
#pragma unroll
        for (int rr = 0; rr < 4; ++rr) { const int kj = 16 * (w + kt) + 4 * quad + rr, dist = 128 + qi - kj; const bool valid = dist >= 0 && dist <= 128 && (n > 0 || kj >= 128);
            acc[rr] = valid ? acc[rr] * 0.125f : NEG_BIG; mx = fmaxf(mx, acc[rr]); }
        st[kt] = acc; }
    mx = fmaxf(mx, shfl_xor_f(mx, 16)); mx = fmaxf(mx, shfl_xor_f(mx, 32));
    float den = 0.f;
#pragma unroll
    for (int kt = 0; kt < 9; ++kt)
#pragma unroll
        for (int rr = 0; rr < 4; ++rr) { const float p = st[kt][rr] > -1e29f ? expf(st[kt][rr] - mx) : 0.f; st[kt][rr] = p; den += p; }
    den += shfl_xor_f(den, 16); den += shfl_xor_f(den, 32);
    const float inv = 1.0f / den;
    const int tq = (128 * n + qi) * dil + r; const size_t mrow = (size_t)b * 2048 + tq;
#pragma unroll
    for (int dt = 0; dt < 4; ++dt) { f32x4 acc = {0.f, 0.f, 0.f, 0.f};
#pragma unroll
        for (int pr = 0; pr < 5; ++pr) { const int ta = 2 * pr, tb = 2 * pr + 1;
            const u32x2 plo = pack4(st[ta]); u32x2 phi = {0u, 0u}; if (tb < 9) phi = pack4(st[tb < 9 ? tb : 8]);
            const u32x4 bu = {plo.x, plo.y, phi.x, phi.y};
            const LDSQ bf16_t* vr = VT + (16 * dt + l15) * VTP + 4 * quad;
            const u32x2 alo = *(const LDSQ u32x2*)(vr + 16 * (w + ta)), ahi = *(const LDSQ u32x2*)(vr + 16 * (w + tb));
            const u32x4 au = {alo.x, alo.y, ahi.x, ahi.y};
            acc = mfma16(__builtin_bit_cast(bf16x8, au), __builtin_bit_cast(bf16x8, bu), acc); }
        *(u32x2*)(OC + mrow * 384 + hh * 64 + 16 * dt + 4 * quad) = pack4(acc * inv); }
    if (quad == 0) LSE[mrow * 8 + hh] = mx + logf(den);
    SYNC();
}

constexpr int AS_NEW = 0  , AS_Q = 12288  , AS_CMB = 18432  , AS_O = 55296  , AS_L = 61440  ;
DEVFN void attn_sample_b(const Ctx& C, int l, int b) {
    const bf16_t* U = WSP(bf16_t, WS_U); const float* ROPE = WSP(float, WS_ROPE); bf16_t* MIX = WSP(bf16_t, WS_MIX);
    LDSQ float* NEW = (LDSQ float*)(C.lds + AS_NEW); LDSQ float* Qs = (LDSQ float*)(C.lds + AS_Q); LDSQ float* CMB = (LDSQ float*)(C.lds + AS_CMB);
    LDSQ float* OS = (LDSQ float*)(C.lds + AS_O); LDSQ float* LS = (LDSQ float*)(C.lds + AS_L);
    const int lane = C.lane, w = C.wave;
#pragma unroll 1
    for (int g = 0; g < 3; ++g) {
        const int i2 = C.tid >> 7, e0 = (C.tid & 127) * 2; const size_t m = M_P + 4 * b + i2; const int pos = 2048 + i2;
        float* orow = C.outp + (g == 0 ? O_K128S : g == 1 ? O_K512S : O_K2048S) + ((size_t)(l * NBS + b) * 4 + i2) * 256;
#pragma unroll
        for (int k2 = 0; k2 < 2; ++k2) { const int e = e0 + k2, kvs = e >> 7, h2 = (e >> 6) & 1, d = e & 63; const int hh = 2 * g + h2;
            const bf16_t* ur = U + m * NU + (kvs ? UC_CV : UC_CK) + hh * 64; float val = bf2f(ur[d]);
            if (!kvs && d < 16) { const int f = d & 7; const float cs = ROPE[pos * 16 + f], sn = ROPE[pos * 16 + 8 + f];
                val = d < 8 ? val * cs - bf2f(ur[d + 8]) * sn : val * cs + bf2f(ur[d - 8]) * sn; }
            NEW[(g * 4 + i2) * 256 + e] = val; orow[e] = val; }
        const int h2 = (C.tid >> 6) & 1, d = C.tid & 63, hh = 2 * g + h2; const bf16_t* ur = U + m * NU + UC_CQ + hh * 64; float val = bf2f(ur[d]);
        if (d < 16) { const int f = d & 7; const float cs = ROPE[pos * 16 + f], sn = ROPE[pos * 16 + 8 + f];
            val = d < 8 ? val * cs - bf2f(ur[d + 8]) * sn : val * cs + bf2f(ur[d - 8]) * sn; }
        Qs[(g * 4 + i2) * 128 + h2 * 64 + d] = val * 0.125f;
    }
    SYNC();
    const int i = w & 3, half = w >> 2;
#pragma unroll 1
    for (int g = 0; g < 3; ++g) {
        const int dil = g == 0 ? 1 : g == 1 ? 4 : 16, lb = g == 0 ? 128 : g == 1 ? 512 : 2048;
        const float* cache = (g == 0 ? C.kv128 : g == 1 ? C.kv512 : C.kv2048) + (size_t)(l * NBS + b) * lb * 256;
        const f32x4 q4 = *(const LDSQ f32x4*)(Qs + (g * 4 + i) * 128 + (lane & 31) * 4);
        float mrun = NEG_BIG, den = 0.f; f32x4 o4 = {0.f, 0.f, 0.f, 0.f};
        const int jn = (dil == 1) ? i + 1 : 1;
#define AS_STEP(x4) do { float part = (lane < 32) ? (q4.x * (x4).x + q4.y * (x4).y) + (q4.z * (x4).z + q4.w * (x4).w) : 0.f; \
        part += shfl_xor_f(part, 1); part += shfl_xor_f(part, 2); part += shfl_xor_f(part, 4); part += shfl_xor_f(part, 8); \
        const float s_ = shfl_f(part, lane & 31); const float mn_ = fmaxf(mrun, s_); const float sc_ = expf(mrun - mn_), p_ = expf(s_ - mn_); \
        den = den * sc_ + p_; o4 = o4 * sc_ + (x4) * p_; mrun = mn_; } while (0)
        if (half == 0) { for (int j = 0; j < jn; ++j) { const f32x4 x4 = *(const LDSQ f32x4*)(NEW + (g * 4 + i - j * dil) * 256 + lane * 4); AS_STEP(x4); } }
        const int j0 = half == 0 ? jn : 65, j1 = half == 0 ? 65 : 129;
        for (int j = j0; j < j1; j += 16) { f32x4 xb[16];
#pragma unroll
            for (int u = 0; u < 16; ++u) { const int jj = (j + u < j1) ? j + u : j1 - 1; xb[u] = *(const f32x4*)(cache + (size_t)(lb + i - jj * dil) * 256 + lane * 4); }
#pragma unroll
            for (int u = 0; u < 16; ++u) if (j + u < j1) AS_STEP(xb[u]); }
#undef AS_STEP
        { LDSQ float* cm = CMB + ((g * 8 + w) * 64 + lane) * 6; cm[0] = mrun; cm[1] = den; cm[2] = o4.x; cm[3] = o4.y; cm[4] = o4.z; cm[5] = o4.w; }
    }
    SYNC();
    if (half == 0 && lane >= 32) {
#pragma unroll 1
        for (int g = 0; g < 3; ++g) { const LDSQ float* c1 = CMB + ((g * 8 + w) * 64 + lane) * 6; const LDSQ float* c2 = CMB + ((g * 8 + w + 4) * 64 + lane) * 6;
            const float m1 = c1[0], d1 = c1[1], m2 = c2[0], d2 = c2[1]; const f32x4 o1 = {c1[2], c1[3], c1[4], c1[5]}, o2 = {c2[2], c2[3], c2[4], c2[5]};
            const float mm = fmaxf(m1, m2), a1 = expf(m1 - mm), a2 = expf(m2 - mm); const float dt = d1 * a1 + d2 * a2; const f32x4 o = (o1 * a1 + o2 * a2) * (1.0f / dt);
            const int h2 = (lane >> 4) & 1, hh = 2 * g + h2;
            *(LDSQ f32x4*)(OS + i * 384 + hh * 64 + (lane & 15) * 4) = o; if ((lane & 15) == 0) LS[i * 6 + hh] = mm + logf(dt); } }
    SYNC();
    for (int p = 0; p < 3; ++p) { const int idx = C.tid + 512 * p, i2 = idx / 384, c = idx % 384, hh = c >> 6, g = hh >> 1, hp = hh & 1; const size_t m = M_P + 4 * b + i2;
        const float l0 = LS[i2 * 6 + hp], l1 = LS[i2 * 6 + 2 + hp], l2 = LS[i2 * 6 + 4 + hp]; const float mx = fmaxf(l0, fmaxf(l1, l2));
        const float e0 = expf(l0 - mx), e1 = expf(l1 - mx), e2 = expf(l2 - mx); const float alpha = (g == 0 ? e0 : g == 1 ? e1 : e2) / (e0 + e1 + e2);
        const float z = bf2f(U[m * NU + UC_CZ + c]);
        MIX[m * 1024 + 640 + c] = (bf16_t)f2bf(OS[i2 * 384 + c] * alpha * silu_f(z)); }
    SYNC();
}

DEVFN void merge_item(const Ctx& C, int item) {
    const bf16_t* U = WSP(bf16_t, WS_U); const bf16_t* OC = WSP(bf16_t, WS_OC); const float* LSE = WSP(float, WS_LSE); bf16_t* MIX = WSP(bf16_t, WS_MIX);
    for (int p = 0; p < 3; ++p) { const int idx = C.tid + 512 * p, rl = idx / 48, c = idx % 48; const size_t m = (size_t)item * 32 + rl;
        const int hh = c >> 3, g = hh >> 1, hp = hh & 1;
        const float l0 = LSE[m * 8 + hp], l1 = LSE[m * 8 + 2 + hp], l2 = LSE[m * 8 + 4 + hp]; const float mx = fmaxf(l0, fmaxf(l1, l2));
        const float e0 = expf(l0 - mx), e1 = expf(l1 - mx), e2 = expf(l2 - mx); const float alpha = (g == 0 ? e0 : g == 1 ? e1 : e2) / (e0 + e1 + e2);
        float o[8], z[8]; unpack8(*(const u32x4*)(OC + m * 384 + 8 * c), o); unpack8(*(const u32x4*)(U + m * NU + UC_CZ + 8 * c), z);
#pragma unroll
        for (int e = 0; e < 8; ++e) o[e] = o[e] * alpha * silu_f(z[e]);
        *(u32x4*)(MIX + m * 1024 + 640 + 8 * c) = pack8(o); }
}

constexpr int N_PREP = 1536, N_ATTP = 768, N_ATTS = 128, N_CONVA = 264;
#ifndef DBL
#define DBL 0
#endif
DEVFN void phase_mid(const Ctx& C0, int l, bool second = false) {
    if (!second || DBL == 3 || DBL == 4) { const Ctx C = relaunder(C0); for (int it = C.cu; it < N_PREP; it += C.ncu) gdn_prep_item(C, l, it); }
    if (!second || DBL == 3 || DBL == 5) { const Ctx C = relaunder(C0); for (int it = C.cu; it < N_ATTP; it += C.ncu) attn_prompt_unit(C, l, it); }
}
constexpr int N_SCAN = 48, N_GS = 96, N_MERGE = 512;
#define QUEUE_LOOP(qword, total, body) do { const Ctx C = relaunder(C0); for (;;) { \
        if (C.tid == 0) *(volatile LDSQ int*)(C.lds + LDS_QIDX) = (int)QUEUE_PULL(qword); SYNC(); const int it = *(volatile LDSQ int*)(C.lds + LDS_QIDX); SYNC(); \
        if (it >= (total)) break; body; } } while (0)
DEVFN void phase_scan(const Ctx& C0, int l, bool second = false) {
    const bool split = C0.ncu > N_SCAN;
    if ((C0.cu < N_SCAN || !split) && (!second || DBL == 8 || DBL == 9)) { const Ctx C = relaunder(C0); for (int u = C.cu; u < N_SCAN; u += C.ncu) gdn_scan_unit(C, l, u); }
    if ((C0.cu >= N_SCAN || !split) && (!second || DBL == 8 || DBL == 10)) { unsigned* qw = (unsigned*)(C0.wsp + WS_CTL) + CW_QUEUE + (l * 2 + (second ? 1 : 0)) * 4 * 64;
        QUEUE_LOOP(qw, N_ATTS, attn_sample_b(C, l, it));
        QUEUE_LOOP(qw + 64, N_GS, gdn_sample_item(C, l, it * 8 + C.wave, (LDSQ float*)(C.lds + C.wave * 512)));
        QUEUE_LOOP(qw + 128, N_CONVA, conv_a_item(C, l, it));
        QUEUE_LOOP(qw + 192, N_MERGE, merge_item(C, it)); }
}
constexpr int SG_A = 0  , SG_B = 18432  ;
struct SEpiU { bf16_t* U;
    DEVMFN void operator()(int row, int col, f32x4 v) const { *(u32x2*)(U + (size_t)(M_P + row) * NU + col) = pack4(v); } };
struct SEpiRes { const float* base; float* X; const float* gate0;
    DEVMFN void operator()(int row, int col, f32x4 v) const { const f32x4 bv = *(const f32x4*)(base + (size_t)row * 1024 + col), gv = *(const f32x4*)(gate0 + (size_t)(NBP + (row >> 2)) * NMOD + col);
        *(f32x4*)(X + (size_t)(M_P + row) * 1024 + col) = bv + (gv + 1.0f) * v; } };
template <class Epi> DEVFN void sgemm_unit(const Ctx& C, const bf16_t* A, const bf16_t* Bt, int tm, int tn, const Epi& E) {
    const int lane = C.lane, quad = lane >> 4, l15 = lane & 15, w = C.wave, wm = w & 1, wn = w >> 1;
    const int lr = C.tid >> 3, c8 = (C.tid & 7) * 8;
    const bf16_t* ga = A + (size_t)(64 * tm + lr) * 1024 + c8; const bf16_t* gb0 = Bt + (size_t)(128 * tn + lr) * 1024 + c8; const bf16_t* gb1 = gb0 + (size_t)64 * 1024;
    LDSQ bf16_t* As = (LDSQ bf16_t*)(C.lds + SG_A); LDSQ bf16_t* Bs = (LDSQ bf16_t*)(C.lds + SG_B);
    f32x4 acc[2][2];
#pragma unroll
    for (int mi = 0; mi < 2; ++mi)
#pragma unroll
        for (int ni = 0; ni < 2; ++ni) acc[mi][ni] = (f32x4){0.f, 0.f, 0.f, 0.f};
    u32x4 ra = *(const u32x4*)ga, rb0 = *(const u32x4*)gb0, rb1 = *(const u32x4*)gb1;
    *(LDSQ u32x4*)(As + lr * LDP + c8) = ra; *(LDSQ u32x4*)(Bs + lr * LDP + c8) = rb0; *(LDSQ u32x4*)(Bs + (64 + lr) * LDP + c8) = rb1;
    ra = *(const u32x4*)(ga + 64); rb0 = *(const u32x4*)(gb0 + 64); rb1 = *(const u32x4*)(gb1 + 64);
    SYNC();
#pragma unroll 1
    for (int c = 0; c < 16; ++c) {
        LDSQ bf16_t* Ac = As + (c & 1) * 4608; LDSQ bf16_t* Bc = Bs + (c & 1) * 9216;
        if (c + 1 < 16) { LDSQ bf16_t* An = As + ((c + 1) & 1) * 4608; LDSQ bf16_t* Bn = Bs + ((c + 1) & 1) * 9216;
            *(LDSQ u32x4*)(An + lr * LDP + c8) = ra; *(LDSQ u32x4*)(Bn + lr * LDP + c8) = rb0; *(LDSQ u32x4*)(Bn + (64 + lr) * LDP + c8) = rb1; }
        if (c + 2 < 16) { ra = *(const u32x4*)(ga + 64 * (c + 2)); rb0 = *(const u32x4*)(gb0 + 64 * (c + 2)); rb1 = *(const u32x4*)(gb1 + 64 * (c + 2)); }
#pragma unroll
        for (int s = 0; s < 2; ++s) { bf16x8 af[2], bfr[2];
#pragma unroll
            for (int mi = 0; mi < 2; ++mi) af[mi] = lds_frag(Ac, LDP, 32 * wm + 16 * mi + l15, 32 * s + 8 * quad);
#pragma unroll
            for (int ni = 0; ni < 2; ++ni) bfr[ni] = lds_frag(Bc, LDP, 32 * wn + 16 * ni + l15, 32 * s + 8 * quad);
#pragma unroll
            for (int mi = 0; mi < 2; ++mi)
#pragma unroll
                for (int ni = 0; ni < 2; ++ni) acc[mi][ni] = mfma16(bfr[ni], af[mi], acc[mi][ni]); }
        SYNC();
    }
#pragma unroll
    for (int mi = 0; mi < 2; ++mi)
#pragma unroll
        for (int ni = 0; ni < 2; ++ni) E(64 * tm + 32 * wm + 16 * mi + l15, 128 * tn + 32 * wn + 16 * ni + 4 * quad, acc[mi][ni]);
}
constexpr int NWAVES = 8;
constexpr int RING_BYTES = 131072, MISC_OFF = RING_BYTES + 320, LDS_BYTES = 147456;
constexpr int CW_BAR = 4096;
#ifndef DBL
#define DBL 0
#endif
#define GRID_BAR() xcd_barrier(bar)

__device__ __forceinline__ Ctx fresh_ctx(const Args* ap, LDSQ unsigned char* lds) {
    Ctx C; int tid = threadIdx.x; asm volatile("" : "+v"(tid));
    C.tid = tid; C.lane = tid & 63; C.wave = __builtin_amdgcn_readfirstlane(tid >> 6);
    C.ncu = gridDim.x; { const int bx = blockIdx.x; C.cu = (C.ncu % 8 == 0) ? (bx % 8) * (C.ncu / 8) + bx / 8 : bx; }
    C.lds = lds; C.a = ap; return C;
}
template <int L> __device__ __forceinline__ void layer_body(const Args* ap, LDSQ unsigned char* lds, const XcdBarrier& bar) {
        { const Ctx C = fresh_ctx(ap, lds); phase_norm(C, L); }
#if DBL == 1
        GRID_BAR(); { const Ctx C = fresh_ctx(ap, lds); phase_norm(C, L); }
#endif
        GRID_BAR();
        { const Ctx C = fresh_ctx(ap, lds);
            { const SEpiU SE{WSP(bf16_t, WS_U)};
                for (int u = C.cu; u < 256; u += C.ncu) sgemm_unit(C, WSP(bf16_t, WS_HN) + (size_t)M_P * 1024, WSP(bf16_t, WS_WIN) + (size_t)L * 4096 * 1024, u & 7, u >> 3, SE); }
            pg8::Gemm g{WSP(bf16_t, WS_HN), WSP(bf16_t, WS_WIN) + (size_t)L * 4096 * 1024, M_P, NU, 1024}; pg8::StaticOrder S; S.init(M_P, NU, C.ncu, (int)blockIdx.x);
            pg8::EpiU E{WSP(bf16_t, WS_U), NU};
            pg8::gemm_phase<pg8::EpiU, pg8::StaticOrder, true, true>(C.lds, g, S, E);
#if DBL == 2
            GRID_BAR(); pg8::gemm_phase<pg8::EpiU, pg8::StaticOrder, true, true>(C.lds, g, S, E);
#endif
        }
        GRID_BAR();
        { const Ctx C = fresh_ctx(ap, lds); phase_mid(C, L); }
#if DBL >= 3 && DBL <= 7
        GRID_BAR(); { const Ctx C = fresh_ctx(ap, lds); phase_mid(C, L, true); }
#endif
        GRID_BAR();
        { const Ctx C = fresh_ctx(ap, lds); phase_scan(C, L); }
#if DBL >= 8 && DBL <= 10
        GRID_BAR(); { const Ctx C = fresh_ctx(ap, lds); phase_scan(C, L, true); }
#endif
        GRID_BAR();
        { const Ctx C = fresh_ctx(ap, lds);
            const float* X = WSP(float, WS_X);
            { const SEpiRes SE{L == 0 ? C.x_sample : X + (size_t)M_P * 1024, WSP(float, WS_X), WSP(float, WS_MOD) + L * 3072 + 2048};
                for (int u = C.ncu - 1 - C.cu; u < 64; u += C.ncu) sgemm_unit(C, WSP(bf16_t, WS_MIX) + (size_t)M_P * 1024, WSP(bf16_t, WS_WOUT) + (size_t)L * 1024 * 1024, u & 7, u >> 3, SE); }
            pg8::Gemm g{WSP(bf16_t, WS_MIX), WSP(bf16_t, WS_WOUT) + (size_t)L * 1024 * 1024, M_P, 1024, 1024}; pg8::StaticOrder S; S.init(M_P, 1024, C.ncu, (int)blockIdx.x);
            pg8::EpiRes E{L == 0 ? C.x_prompt : X, L == 0 ? C.x_sample : X + (size_t)M_P * 1024, WSP(float, WS_X), WSP(float, WS_MOD) + L * 3072 + 2048};
#if DBL == 13
            { pg8::EpiRes E2 = E; E2.X = WSP(float, WS_U); pg8::gemm_phase<pg8::EpiRes, pg8::StaticOrder, true, true>(C.lds, g, S, E2); GRID_BAR(); }
#endif
            pg8::gemm_phase<pg8::EpiRes, pg8::StaticOrder, true, true>(C.lds, g, S, E);
        }
        GRID_BAR();
    }

__global__ void __launch_bounds__(NWAVES * 64, 2) mega_fwd(Args args) {
    extern __shared__ __attribute__((aligned(16))) unsigned char lds_raw[];
    Ctx C;
    C.lds = (LDSQ unsigned char*)lds_raw;
    C.tid = threadIdx.x; C.lane = C.tid & 63; C.wave = __builtin_amdgcn_readfirstlane(C.tid >> 6);
    C.ncu = gridDim.x; { const int bx = blockIdx.x; C.cu = (C.ncu % 8 == 0) ? (bx % 8) * (C.ncu / 8) + bx / 8 : bx; }
    C.a = &args;
    volatile LDSQ unsigned* MISC = (volatile LDSQ unsigned*)(C.lds + MISC_OFF);
    for (int u = C.tid; u < (LDS_BYTES - RING_BYTES) / 4; u += NWAVES * 64) ((LDSQ unsigned*)(C.lds + RING_BYTES))[u] = 0u;
    __syncthreads();
    unsigned* ctl = (unsigned*)(C.wsp + WS_CTL);
    XcdBarrier bar = xcd_barrier_post(ctl + CW_BAR, MISC + 8);

    phase_p0a(C);
#if DBL == 11
    GRID_BAR(); phase_p0a(C);
#endif
    GRID_BAR();
    {
        pg8::Gemm g{WSP(bf16_t, WS_CB), WSP(bf16_t, WS_WADA), 256, NMOD, 1024}; pg8::StaticOrder S; S.init(256, NMOD, C.ncu, (int)blockIdx.x);
        pg8::EpiMod E{WSP(float, WS_MOD), C.b_ada, C.b_ada_final};
        pg8::gemm_phase<pg8::EpiMod, pg8::StaticOrder, false, true>(C.lds, g, S, E);
#if DBL == 12
        GRID_BAR(); pg8::gemm_phase<pg8::EpiMod, pg8::StaticOrder, false, true>(C.lds, g, S, E);
#endif
    }
    GRID_BAR();
    layer_body<0>(&args, C.lds, bar); layer_body<1>(&args, C.lds, bar); layer_body<2>(&args, C.lds, bar); layer_body<3>(&args, C.lds, bar);
    { const Ctx C2 = fresh_ctx(&args, C.lds); phase_final(C2); }
#if DBL == 14
    { const Ctx C2 = fresh_ctx(&args, C.lds); phase_final(C2); }
#endif
}

extern "C" void kernel_launch(void* const* d_in, const int* in_sizes, int n_in, void* d_out, int out_size, void* d_ws, size_t ws_size, hipStream_t stream) {
    static int grid = 0;
    if (grid == 0) {
        if (n_in != 23 || out_size != (int)O_END || ws_size < WS_END) { fprintf(stderr, "kernel_launch: unexpected shapes: n_in %d out %d ws %zu\n", n_in, out_size, ws_size); grid = -1; return; }
        int dev = 0, cus = 0, per_cu = 0;
        if (hipGetDevice(&dev) != hipSuccess || hipDeviceGetAttribute(&cus, hipDeviceAttributeMultiprocessorCount, dev) != hipSuccess) { grid = -1; return; }
        if (hipFuncSetAttribute((const void*)mega_fwd, hipFuncAttributeMaxDynamicSharedMemorySize, LDS_BYTES) != hipSuccess) { fprintf(stderr, "kernel_launch: hipFuncSetAttribute failed\n"); grid = -1; return; }
        if (hipOccupancyMaxActiveBlocksPerMultiprocessor(&per_cu, (const void*)mega_fwd, NWAVES * 64, LDS_BYTES) != hipSuccess || per_cu < 1) { fprintf(stderr, "kernel_launch: occupancy query says %d\n", per_cu); }
        (void)hipGetLastError();
        grid = cus;
    }
    if (grid < 0) return;
    if (hipMemsetAsync((char*)d_ws + WS_CTL, 0, CTL_ZERO_BYTES, stream) != hipSuccess) return;
    Args ha{};
    for (int i = 0; i < 23; ++i) ha.in[i] = (const float*)d_in[i];
    ha.out_ = (float*)d_out; ha.ws_ = (unsigned char*)d_ws;
    hipLaunchKernelGGL(mega_fwd, dim3(grid), dim3(NWAVES * 64), LDS_BYTES, stream, ha);
}
```

```cpp
#include <hip/hip_runtime.h>
#include <cstdio>
#include <cstdint>
namespace pg8 {
#define PG8_LAS __attribute__((address_space(3)))
typedef unsigned short bf16_t;
typedef short bf16x8 __attribute__((ext_vector_type(8)));
typedef float f32x4 __attribute__((ext_vector_type(4)));
typedef unsigned u32x4 __attribute__((ext_vector_type(4)));
constexpr int BM = 256, BK = 64, HALF = 128, HTB = HALF * BK * 2  , STAGE_BYTES = 8 * HTB, NXCD = 8, WGM = 8;

__host__ __device__ __forceinline__ int lds_byte(int r, int c) { const int st = (r >> 4) * 2 + (c >> 5), rr = r & 15, cc = c & 31, ob = rr * 64 + cc * 2; return st * 1024 + (ob ^ (((ob >> 9) & 1) << 5)); }
__host__ __device__ __forceinline__ void stage_rc(int b, int& R, int& C) { const int st = b / 1024, sb = b % 1024, swz = sb ^ (((sb >> 9) & 1) << 5); R = (st >> 1) * 16 + swz / 64; C = (st & 1) * 32 + (swz % 64) / 2; }
__host__ __device__ __forceinline__ int perm32(int rho) { const int n = rho >> 4, i = rho & 15; return 8 * (i >> 2) + 4 * n + (i & 3); }

struct Unit { int pm, pn; };
struct Gemm { const bf16_t* A; const bf16_t* Bt; int M, N, K; };

struct StaticOrder {
    int nM, nN, nwg, G, c;
    __host__ __device__ void init(int M, int N, int G_, int c_) { nM = M / BM; nN = N / BM; nwg = nM * nN; G = G_; c = c_; }
    __host__ __device__ bool next(int i, Unit& u) const {
        const long L = (long)i * G + c; if (L >= nwg) return false;
        int wgid = (int)L; { const int q = nwg / NXCD, r = nwg % NXCD, xcd = wgid % NXCD, off = wgid / NXCD; wgid = (xcd < r ? xcd * (q + 1) : r * (q + 1) + (xcd - r) * q) + off; }
        const int nig = WGM * nN, gid = wgid / nig, fm = gid * WGM, gsz = (nM - fm) < WGM ? (nM - fm) : WGM;
        u.pm = fm + ((wgid % nig) % gsz); u.pn = (wgid % nig) / gsz; return true;
    }
    __device__ __forceinline__ void a_ready(const Unit&) const {}
    __device__ __forceinline__ void done(const Unit&) const {}
};

__device__ __forceinline__ unsigned cvt_pk_bf16(float lo, float hi) { unsigned r; asm volatile("v_cvt_pk_bf16_f32 %0, %1, %2" : "=v"(r) : "v"(lo), "v"(hi)); return r; }
template <class Epi, class Sched, bool ALIGN_EPI = false, bool SP2 = false>
__device__ __forceinline__ void gemm_phase(PG8_LAS unsigned char* lds, const Gemm g, const Sched& S, const Epi& E) {
    int tid_ = threadIdx.x; asm volatile("" : "+v"(tid_));
    const int tid = tid_, wid = __builtin_amdgcn_readfirstlane(tid >> 6), lane = tid & 63, wr = wid >> 2, wc = wid & 3, fr = lane & 15, fq = lane >> 4;
    const int K = g.K, nt = K / BK;
    unsigned voffA[2], voffB[2];
#pragma unroll
    for (int i = 0; i < 2; ++i) { int R, C; stage_rc(tid * 16 + i * 8192, R, C); const int Rb = Epi::PERM ? ((R & ~31) + perm32(R & 31)) : R;
        voffA[i] = (unsigned)(R * K + C) * 2u; voffB[i] = (unsigned)(Rb * K + C) * 2u; }
    const size_t kstep = (size_t)(BK * 2);
    const size_t hstep = (size_t)HALF * K * 2;
    const size_t tstep = 2 * hstep;
    const unsigned ldsw = (unsigned)wid * 1024u;
    const int aoff = lds_byte(wr * 64 + fr, fq * 8), boff = lds_byte(wc * 32 + fr, fq * 8);
#define PG8_SA(b, h) (((b) * 2 + (h)) * HTB)
#define PG8_SB(b, h) ((4 + (b) * 2 + (h)) * HTB)
#define PG8_STAGE(bufoff, gbase, voff) do { _Pragma("unroll") for (int _i = 0; _i < 2; ++_i) \
        __builtin_amdgcn_global_load_lds((const unsigned*)((const char*)(gbase) + (voff)[_i]), (PG8_LAS unsigned*)(lds + (bufoff) + ldsw + _i * 8192), 16, 0, 0); } while (0)
#define PG8_LDA(dst, b, h) do { _Pragma("unroll") for (int m = 0; m < 4; ++m) _Pragma("unroll") for (int k = 0; k < 2; ++k) dst[m][k] = *(const PG8_LAS bf16x8*)(lds + PG8_SA(b, h) + aoff + m * 2048 + k * 1024); } while (0)
#define PG8_LDB(dst, b, h) do { _Pragma("unroll") for (int n = 0; n < 2; ++n) _Pragma("unroll") for (int k = 0; k < 2; ++k) dst[n][k] = *(const PG8_LAS bf16x8*)(lds + PG8_SB(b, h) + boff + n * 2048 + k * 1024); } while (0)
#define PG8_MMA(ai, bj, At, Bt) do { __builtin_amdgcn_s_setprio(1); _Pragma("unroll") for (int m = 0; m < 4; ++m) _Pragma("unroll") for (int n = 0; n < 2; ++n) _Pragma("unroll") for (int k = 0; k < 2; ++k) \
        acc[ai][bj][m][n] = __builtin_amdgcn_mfma_f32_16x16x32_bf16(Bt[n][k], At[m][k], acc[ai][bj][m][n], 0, 0, 0); __builtin_amdgcn_s_setprio(0); } while (0)
#define PG8_WAIT_V(n) asm volatile("s_waitcnt vmcnt(" #n ")" ::: "memory")
#define PG8_WAIT_L(n) asm volatile("s_waitcnt lgkmcnt(" #n ")" ::: "memory")
#define PG8_BAR __builtin_amdgcn_s_barrier()
#define PG8_SCHED __builtin_amdgcn_sched_barrier(0)
    Unit cur, nxt; int ui = 0;
    if (!S.next(0, cur)) return;
    f32x4 acc[2][2][4][2];
#pragma unroll
    for (int a = 0; a < 2; ++a)
#pragma unroll
        for (int b = 0; b < 2; ++b)
#pragma unroll
            for (int m = 0; m < 4; ++m)
#pragma unroll
                for (int n = 0; n < 2; ++n) acc[a][b][m][n] = (f32x4){0.f, 0.f, 0.f, 0.f};
    bf16x8 At[4][2], B0[2][2], B1[2][2];
    const char* cA = (const char*)g.A + (size_t)cur.pm * tstep; const char* cB = (const char*)g.Bt + (size_t)cur.pn * tstep;
    S.a_ready(cur);
    if constexpr (SP2) {
        PG8_STAGE(PG8_SB(0, 0), cB, voffB); PG8_STAGE(PG8_SB(0, 1), cB + hstep, voffB); PG8_STAGE(PG8_SA(0, 0), cA, voffA); PG8_STAGE(PG8_SA(0, 1), cA + hstep, voffA);
        if (wr == 1) PG8_BAR;
        PG8_WAIT_V(2); PG8_BAR;
        PG8_STAGE(PG8_SB(1, 0), cB + kstep, voffB); PG8_STAGE(PG8_SA(1, 0), cA + kstep, voffA); PG8_STAGE(PG8_SB(1, 1), cB + hstep + kstep, voffB);
        PG8_WAIT_V(6); PG8_BAR;
    } else {
        PG8_STAGE(PG8_SB(0, 0), cB, voffB); PG8_STAGE(PG8_SA(0, 0), cA, voffA); PG8_STAGE(PG8_SB(0, 1), cB + hstep, voffB); PG8_STAGE(PG8_SA(0, 1), cA + hstep, voffA);
        if (wr == 1) PG8_BAR;
        PG8_WAIT_V(4); PG8_BAR;
        PG8_STAGE(PG8_SB(1, 0), cB + kstep, voffB); PG8_STAGE(PG8_SA(1, 0), cA + kstep, voffA); PG8_STAGE(PG8_SB(1, 1), cB + hstep + kstep, voffB);
        PG8_WAIT_V(6); PG8_BAR;
    }
    for (;;) {
        const bool has_next = S.next(ui + 1, nxt);
        const char* nA = has_next ? (const char*)g.A + (size_t)nxt.pm * tstep : cA; const char* nB = has_next ? (const char*)g.Bt + (size_t)nxt.pn * tstep : cB;
        for (int t = 0; t < nt; t += 2) {
            const bool last = (t == nt - 2);
            const char* a1 = cA + (size_t)(t + 1) * kstep;
            const char* a2 = last ? nA : cA + (size_t)(t + 2) * kstep; const char* b2 = last ? nB : cB + (size_t)(t + 2) * kstep;
            const char* a3 = a2 + kstep; const char* b3 = b2 + kstep;
            if (last && has_next) S.a_ready(nxt);
            if constexpr (SP2) {
            PG8_LDB(B0, 0, 0); PG8_LDB(B1, 0, 1); PG8_SCHED; PG8_LDA(At, 0, 0); PG8_STAGE(PG8_SA(1, 1), a1 + hstep, voffA);
            PG8_WAIT_V(8); PG8_WAIT_L(0); PG8_BAR; PG8_MMA(0, 0, At, B0); PG8_MMA(0, 1, At, B1); PG8_BAR; PG8_SCHED;
            PG8_LDA(At, 0, 1); PG8_STAGE(PG8_SB(0, 0), b2, voffB); PG8_STAGE(PG8_SB(0, 1), b2 + hstep, voffB); PG8_STAGE(PG8_SA(0, 0), a2, voffA);
            PG8_WAIT_V(8); PG8_WAIT_L(0); PG8_BAR; PG8_MMA(1, 0, At, B0); PG8_MMA(1, 1, At, B1); PG8_BAR; PG8_SCHED;
            PG8_LDB(B0, 1, 0); PG8_LDB(B1, 1, 1); PG8_SCHED; PG8_LDA(At, 1, 0); PG8_STAGE(PG8_SA(0, 1), a2 + hstep, voffA);
            PG8_WAIT_V(8); PG8_WAIT_L(0); PG8_BAR; PG8_MMA(0, 0, At, B0); PG8_MMA(0, 1, At, B1); PG8_BAR; PG8_SCHED;
            PG8_LDA(At, 1, 1); PG8_STAGE(PG8_SB(1, 0), b3, voffB); PG8_STAGE(PG8_SB(1, 1), b3 + hstep, voffB); PG8_STAGE(PG8_SA(1, 0), a3, voffA);
            PG8_WAIT_V(8); PG8_WAIT_L(0); PG8_BAR; PG8_MMA(1, 0, At, B0); PG8_MMA(1, 1, At, B1); PG8_BAR; PG8_SCHED;
            } else {
            PG8_LDB(B0, 0, 0); PG8_SCHED; PG8_LDA(At, 0, 0); PG8_STAGE(PG8_SA(1, 1), a1 + hstep, voffA);
            PG8_WAIT_L(8); PG8_BAR; PG8_WAIT_L(0); PG8_MMA(0, 0, At, B0); PG8_BAR; PG8_SCHED;
            PG8_LDB(B1, 0, 1); PG8_STAGE(PG8_SB(0, 0), b2, voffB);
            PG8_BAR; PG8_WAIT_L(0); PG8_MMA(0, 1, At, B1); PG8_BAR;
            PG8_LDA(At, 0, 1); PG8_STAGE(PG8_SA(0, 0), a2, voffA);
            PG8_BAR; PG8_WAIT_L(0); PG8_MMA(1, 0, At, B0); PG8_BAR; PG8_SCHED;
            PG8_STAGE(PG8_SB(0, 1), b2 + hstep, voffB);
            PG8_WAIT_V(6); PG8_BAR; PG8_MMA(1, 1, At, B1); PG8_BAR;
            PG8_LDB(B0, 1, 0); PG8_SCHED; PG8_LDA(At, 1, 0); PG8_STAGE(PG8_SA(0, 1), a2 + hstep, voffA);
            PG8_WAIT_L(8); PG8_BAR; PG8_WAIT_L(0); PG8_MMA(0, 0, At, B0); PG8_BAR; PG8_SCHED;
            PG8_LDB(B1, 1, 1); PG8_STAGE(PG8_SB(1, 0), b3, voffB);
            PG8_BAR; PG8_WAIT_L(0); PG8_MMA(0, 1, At, B1); PG8_BAR;
            PG8_LDA(At, 1, 1); PG8_STAGE(PG8_SA(1, 0), a3, voffA);
            PG8_BAR; PG8_WAIT_L(0); PG8_MMA(1, 0, At, B0); PG8_BAR; PG8_SCHED;
            PG8_STAGE(PG8_SB(1, 1), b3 + hstep, voffB);
            PG8_WAIT_V(6); PG8_BAR; PG8_MMA(1, 1, At, B1); PG8_BAR;
            }
        }
        if constexpr (ALIGN_EPI) { if (wr == 0) PG8_BAR; }
        if constexpr (!Epi::AFTER_DRAIN) { E(acc, cur, wr, wc, fr, fq); S.done(cur); }
        if (!has_next) break;
#pragma unroll
        for (int a = 0; a < 2; ++a)
#pragma unroll
            for (int b = 0; b < 2; ++b)
#pragma unroll
                for (int m = 0; m < 4; ++m)
#pragma unroll
                    for (int n = 0; n < 2; ++n) acc[a][b][m][n] = (f32x4){0.f, 0.f, 0.f, 0.f};
        cur = nxt; cA = nA; cB = nB; ++ui;
        if constexpr (ALIGN_EPI) { if (wr == 1) PG8_BAR; }
    }
    PG8_WAIT_V(0);
    if constexpr (!ALIGN_EPI) { if (wr == 0) PG8_BAR; }
    PG8_BAR;
    if constexpr (Epi::AFTER_DRAIN) { E.fused(acc, cur, wr, wc, fr, fq, lds, wid, lane); S.done(cur); }
#undef PG8_SA
#undef PG8_SB
#undef PG8_STAGE
#undef PG8_LDA
#undef PG8_LDB
#undef PG8_MMA
#undef PG8_WAIT_V
#undef PG8_WAIT_L
#undef PG8_BAR
#undef PG8_SCHED
}
}
namespace pg8 {
struct EpiU { static constexpr bool PERM = true, AFTER_DRAIN = false; bf16_t* O; int ldc;
    __device__ __forceinline__ void operator()(const f32x4 (&acc)[2][2][4][2], const Unit& u, int wr, int wc, int fr, int fq) const {
        const int row0 = u.pm * BM + wr * 64 + fr, col0 = u.pn * BM + wc * 32 + 8 * fq;
#pragma unroll
        for (int ai = 0; ai < 2; ++ai)
#pragma unroll
            for (int m = 0; m < 4; ++m) { bf16_t* rowp = O + (size_t)(row0 + ai * HALF + m * 16) * ldc + col0;
#pragma unroll
                for (int bj = 0; bj < 2; ++bj) { const f32x4 v0 = acc[ai][bj][m][0], v1 = acc[ai][bj][m][1];
                    u32x4 w; w.x = cvt_pk_bf16(v0[0], v0[1]); w.y = cvt_pk_bf16(v0[2], v0[3]); w.z = cvt_pk_bf16(v1[0], v1[1]); w.w = cvt_pk_bf16(v1[2], v1[3]);
                    *(u32x4*)(rowp + bj * HALF) = w; } }
    }
};
struct EpiMod { static constexpr bool PERM = false, AFTER_DRAIN = false; float* O; const float* b_ada; const float* b_fin;
    __device__ __forceinline__ void operator()(const f32x4 (&acc)[2][2][4][2], const Unit& u, int wr, int wc, int fr, int fq) const {
        const int colt = u.pn * BM; const float* bias = colt < 12288 ? b_ada + colt : b_fin + (colt - 12288);
        const int cl = wc * 32 + 4 * fq;
#pragma unroll
        for (int ai = 0; ai < 2; ++ai)
#pragma unroll
            for (int m = 0; m < 4; ++m) { const int row = ai * HALF + wr * 64 + m * 16 + fr;
                if (row < 136) {
#pragma unroll
                    for (int bj = 0; bj < 2; ++bj)
#pragma unroll
                        for (int n = 0; n < 2; ++n) { const int c = cl + bj * HALF + n * 16; const f32x4 bv = *(const f32x4*)(bias + c);
                            *(f32x4*)(O + (size_t)row * 14336 + colt + c) = acc[ai][bj][m][n] + bv; } } }
    }
};
struct EpiRes { static constexpr bool PERM = false, AFTER_DRAIN = false; const float* base_p; const float* base_s; float* X; const float* gate0;
    __device__ __forceinline__ void operator()(const f32x4 (&acc)[2][2][4][2], const Unit& u, int wr, int wc, int fr, int fq) const {
        const int cl = u.pn * BM + wc * 32 + 4 * fq;
#pragma unroll
        for (int ai = 0; ai < 2; ++ai)
#pragma unroll
            for (int m = 0; m < 4; ++m) { const int row = u.pm * BM + ai * HALF + wr * 64 + m * 16 + fr;
                const float* b = row < 16384 ? base_p + (size_t)row * 1024 : base_s + (size_t)(row - 16384) * 1024;
                const int brow = row < 16384 ? (row >> 11) : 8 + ((row - 16384) >> 2);
                const float* g = gate0 + (size_t)brow * 14336; float* o = X + (size_t)row * 1024;
#pragma unroll
                for (int bj = 0; bj < 2; ++bj)
#pragma unroll
                    for (int n = 0; n < 2; ++n) { const int c = cl + bj * HALF + n * 16; const f32x4 bv = *(const f32x4*)(b + c), gv = *(const f32x4*)(g + c);
                        *(f32x4*)(o + c) = bv + (gv + 1.0f) * acc[ai][bj][m][n]; } }
    }
};
}
using pg8::bf16_t; using pg8::bf16x8; using pg8::f32x4; using pg8::u32x4;
#ifdef HOST_EMU
#define DEVFN static inline
#define DEVMFN inline
#define LDSQ
#define GASQ
#else
#define DEVFN __device__ __forceinline__
#define DEVMFN __device__ __forceinline__
#define LDSQ __attribute__((address_space(3)))
#define GASQ __attribute__((address_space(1)))
#endif
typedef short s16x4 __attribute__((ext_vector_type(4)));
typedef float f32x2 __attribute__((ext_vector_type(2)));
typedef unsigned u32x2 __attribute__((ext_vector_type(2)));

constexpr int D_MODEL = 1024, SEQ = 2048, NBP = 8, NBS = 128, DSEQ = 4, DEPTH = 4;
constexpr int M_P = NBP * SEQ, M_S = NBS * DSEQ, M_T = M_P + M_S;
constexpr int IN_W = 4108, NU = 4096, NBROW = NBP + NBS;
constexpr int NMOD = 4 * 3072 + 2048;
constexpr int UC_AX = 0, UC_ACG = 256, UC_ABG = 512, UC_AZ = 768, UC_BQ = 1024, UC_BK = 1408, UC_BV = 1792, UC_BZ = 2176, UC_CQ = 2560, UC_CK = 2944, UC_CV = 3328, UC_CZ = 3712;
constexpr size_t MiB = 1u << 20;
constexpr size_t WS_CTL = 0, CTL_ZERO_BYTES = 1 * MiB;
constexpr size_t WS_WIN = 2 * MiB;
constexpr size_t WS_WOUT = 34 * MiB;
constexpr size_t WS_WADA = 42 * MiB;
constexpr size_t WS_WAB = 70 * MiB;
constexpr size_t WS_ROPE = 71 * MiB;
constexpr size_t WS_CB = 72 * MiB;
constexpr size_t WS_MOD = 73 * MiB;
constexpr size_t WS_AB = 82 * MiB;
constexpr size_t WS_LSE = 84 * MiB;
constexpr size_t WS_GSC = 86 * MiB;
constexpr size_t WS_X = 96 * MiB;
constexpr size_t WS_HN = 162 * MiB;
constexpr size_t WS_MIX = 196 * MiB;
constexpr size_t WS_OC = 230 * MiB;
constexpr size_t WS_U = 256 * MiB;
constexpr size_t WS_GDN = 400 * MiB;
constexpr size_t GDN_CHUNK_BYTES = 40960;
constexpr size_t WS_END = 480 * MiB;
constexpr size_t O_YP = 0, O_YS = 16777216, O_CAP = 17301504, O_CAS = 17317888, O_CBP = 17580032, O_CBS = 17690624, O_GP = 19460096, O_GS = 20246528,
                 O_K128P = 32829440, O_K128S = 33878016, O_K512P = 34402304, O_K512S = 38596608, O_K2048P = 39120896, O_K2048S = 55898112, O_END = 56422400;

DEVFN float bf_lo(unsigned u) { return __builtin_bit_cast(float, u << 16); }
DEVFN float bf_hi(unsigned u) { return __builtin_bit_cast(float, u & 0xffff0000u); }
DEVFN float bf2f(bf16_t h) { return __builtin_bit_cast(float, (unsigned)h << 16); }
#ifdef HOST_EMU
DEVFN unsigned f2bf(float f) { unsigned u = __builtin_bit_cast(unsigned, f); return (u + 0x7fffu + ((u >> 16) & 1u)) >> 16; }
DEVFN unsigned pk2(float lo, float hi) { return f2bf(lo) | (f2bf(hi) << 16); }
DEVFN float EXPF(float x) { return expf(x); }
DEVFN float LOGF(float x) { return logf(x); }
DEVFN float RCPF(float x) { return 1.0f / x; }
DEVFN float RSQF(float x) { return 1.0f / sqrtf(x); }
#else
typedef __bf16 hwbf16x2 __attribute__((ext_vector_type(2)));
DEVFN unsigned pk2(float lo, float hi) { const f32x2 v = {lo, hi}; const hwbf16x2 b = __builtin_convertvector(v, hwbf16x2); return __builtin_bit_cast(unsigned, b); }
DEVFN unsigned f2bf(float f) { return pk2(f, 0.f) & 0xffffu; }
DEVFN float EXPF(float x) { return __builtin_amdgcn_exp2f(x * 1.4426950408889634f); }
DEVFN float LOGF(float x) { return __builtin_amdgcn_logf(x) * 0.6931471805599453f; }
DEVFN float RCPF(float x) { return __builtin_amdgcn_rcpf(x); }
DEVFN float RSQF(float x) { return __builtin_amdgcn_rsqf(x); }
#endif
DEVFN void unpack8(u32x4 v, float* f) { f[0] = bf_lo(v.x); f[1] = bf_hi(v.x); f[2] = bf_lo(v.y); f[3] = bf_hi(v.y); f[4] = bf_lo(v.z); f[5] = bf_hi(v.z); f[6] = bf_lo(v.w); f[7] = bf_hi(v.w); }
DEVFN u32x4 pack8(const float* f) { u32x4 v; v.x = pk2(f[0], f[1]); v.y = pk2(f[2], f[3]); v.z = pk2(f[4], f[5]); v.w = pk2(f[6], f[7]); return v; }
DEVFN float silu_f(float x) { return x * RCPF(1.f + EXPF(-x)); }
DEVFN float sigmoid_f(float x) { return RCPF(1.f + EXPF(-x)); }
DEVFN float softplus_f(float x) { return x > 20.f ? x : log1pf(expf(x)); }

struct Args { const float* in[23]; float* out_; unsigned char* ws_; };
struct Ctx {
    int tid, lane, wave, cu, ncu;
    LDSQ unsigned char* lds;
    const Args* a;
};
#define x_prompt a->in[0]
#define x_sample a->in[1]
#define st_conv_a a->in[2]
#define st_conv_b a->in[3]
#define st_gdn a->in[4]
#define kv128 a->in[5]
#define kv512 a->in[6]
#define kv2048 a->in[7]
#define c_prompt a->in[8]
#define c_sample a->in[9]
#define w_in a->in[10]
#define w_out a->in[11]
#define w_ada a->in[12]
#define b_ada a->in[13]
#define norm_w a->in[14]
#define conv_a_w a->in[15]
#define conv_b_w a->in[16]
#define a_log a->in[17]
#define dt_bias a->in[18]
#define gdn_norm_w a->in[19]
#define final_norm_w a->in[20]
#define w_ada_final a->in[21]
#define b_ada_final a->in[22]
#define outp a->out_
#define wsp a->ws_
constexpr int LDS_MISC = 158208;
constexpr int LDS_QIDX = LDS_MISC + 320 + 64;
constexpr int CW_QUEUE = 32768;
#define WSP(T, off) ((T*)(C.wsp + (off)))
#define LAS __attribute__((address_space(3)))
#define XB_TMO      128
#define XB_XCNT(j)  (256  + 64 * (j))
#define XB_XSUB(j)  (1280 + 64 * (j))
#define XB_XGEN(j)  (2304 + 64 * (j))
#define XB_TOP      3328
#define XB_TOPGEN   3392
#define XCD_BAR_WORDS 3456
#define XB_SPIN_CAP (1u << 18)

__device__ __forceinline__ unsigned xb_ld(unsigned* p)              { return __hip_atomic_load(p, __ATOMIC_RELAXED, __HIP_MEMORY_SCOPE_AGENT); }
__device__ __forceinline__ unsigned xb_add(unsigned* p, unsigned v) { return __hip_atomic_fetch_add(p, v, __ATOMIC_RELAXED, __HIP_MEMORY_SCOPE_AGENT); }
__device__ __forceinline__ unsigned xb_xcc_id() { return (unsigned)__builtin_amdgcn_s_getreg((3 << 11) | 20) & 0xFu; }
#define XB_SPIN(cond, bar) do { unsigned _sp = 0; while (cond) { __builtin_amdgcn_s_sleep(1); \
    if ((++_sp & 255u) == 0u) { if (xb_ld(&(bar)[XB_TMO])) break; if (_sp > XB_SPIN_CAP) { atomicAdd(&(bar)[XB_TMO], 1u); break; } } } } while (0)

struct XcdBarrier {
    unsigned* bar; unsigned x;
    volatile LAS unsigned* st;
};

__device__ __forceinline__ XcdBarrier xcd_barrier_post(unsigned* bar, volatile LAS unsigned* st) {
    XcdBarrier b; b.bar = bar; b.x = xb_xcc_id(); b.st = st;
    if (threadIdx.x == 0) (void)xb_add(&bar[XB_XCNT(b.x)], 1u);
    return b;
}
__device__ __forceinline__ void xcd_barrier_complete(unsigned* bar, unsigned x, unsigned& nloc, unsigned& nx) {
    const unsigned G = gridDim.x * gridDim.y * gridDim.z;
    unsigned sum, cnt, mine, sp = 0u;
    for (;;) {
        sum = 0u; cnt = 0u; mine = 0u;
#pragma unroll
        for (unsigned j = 0; j < 16; ++j) { const unsigned c = xb_ld(&bar[XB_XCNT(j)]); sum += c; cnt += (c > 0u) ? 1u : 0u; mine = (j == x) ? c : mine; }
        if (sum == G) break;
        __builtin_amdgcn_s_sleep(1);
        if ((++sp & 255u) == 0u) { if (xb_ld(&bar[XB_TMO])) break; if (sp > XB_SPIN_CAP) { atomicAdd(&bar[XB_TMO], 1u); break; } }
    }
    nloc = mine > 0u ? mine : 1u; nx = cnt > 0u ? cnt : 1u;
}

__device__ __forceinline__ void xcd_barrier(const XcdBarrier& b) {
    asm volatile("s_waitcnt vmcnt(0)" ::: "memory");
    __syncthreads();
    if (threadIdx.x == 0) {
        unsigned* bar = b.bar;
        __builtin_amdgcn_s_waitcnt(0);
        unsigned nloc = b.st[0], nx = b.st[1];
        if (nloc == 0u) { xcd_barrier_complete(bar, b.x, nloc, nx); b.st[0] = nloc; b.st[1] = nx; }
        const unsigned old = xb_add(&bar[XB_XSUB(b.x)], 1u);
        const unsigned gen = old / nloc;
        if (old + 1u == (gen + 1u) * nloc) {
            __builtin_amdgcn_fence(__ATOMIC_RELEASE, "agent");
            asm volatile("s_waitcnt vmcnt(0)" ::: "memory");
            const unsigned og = xb_add(&bar[XB_TOP], 1u);
            const unsigned tg = og / nx;
            if (og + 1u == (tg + 1u) * nx) xb_add(&bar[XB_TOPGEN], 1u);
            else XB_SPIN(xb_ld(&bar[XB_TOPGEN]) == tg, bar);
            __builtin_amdgcn_fence(__ATOMIC_ACQUIRE, "agent");
            xb_add(&bar[XB_XGEN(b.x)], 1u);
            asm volatile("s_waitcnt vmcnt(0)" ::: "memory");
        } else {
            XB_SPIN(xb_ld(&bar[XB_XGEN(b.x)]) == gen, bar);
            __builtin_amdgcn_fence(__ATOMIC_ACQUIRE, "agent");
            asm volatile("s_waitcnt vmcnt(0)" ::: "memory");
        }
    }
    __syncthreads();
}
#define SYNC() __syncthreads()
#define WAVE_LDS_FENCE() do { asm volatile("s_waitcnt lgkmcnt(0)" ::: "memory"); } while (0)
#define COMPILER_MEM_FENCE() asm volatile("" ::: "memory")
#define FAST_SIN(x) __sinf(x)
#define FAST_COS(x) __cosf(x)
DEVFN f32x4 mfma16(bf16x8 a, bf16x8 b, f32x4 c) { return __builtin_amdgcn_mfma_f32_16x16x32_bf16(a, b, c, 0, 0, 0); }
DEVFN float shfl_xor_f(float v, int m) { return __shfl_xor(v, m); }
DEVFN float shfl_f(float v, int src) { return __shfl(v, src); }
DEVFN float shfl_up_f(float v, int d) { return __shfl_up(v, d); }
DEVFN Ctx relaunder(const Ctx& C0) {
    Ctx C = C0; int tid = C0.tid; asm volatile("" : "+v"(tid)); C.tid = tid; C.lane = tid & 63; C.wave = __builtin_amdgcn_readfirstlane(tid >> 6); return C;
}
DEVFN float FMA_OP(float a, float b, float c) { float r; asm("v_fma_f32 %0, %1, %2, %3" : "=v"(r) : "v"(a), "v"(b), "v"(c)); return r; }
#define QUEUE_PULL(p) __hip_atomic_fetch_add((p), 1u, __ATOMIC_RELAXED, __HIP_MEMORY_SCOPE_AGENT)
#define VM_DRAIN() asm volatile("s_waitcnt vmcnt(0)" ::: "memory")
#define VM_WAIT_N(n) asm volatile("s_waitcnt vmcnt(" #n ")" ::: "memory")
#define RAW_SYNC() do { asm volatile("s_waitcnt lgkmcnt(0)" ::: "memory"); __builtin_amdgcn_s_barrier(); asm volatile("" ::: "memory"); } while (0)
#define DMA16(gptr, ldsbase, lane) __builtin_amdgcn_global_load_lds((const unsigned*)(gptr), (LDSQ unsigned*)(ldsbase), 16, 0, 0)
DEVFN float wave_sum(float v) {
#pragma unroll
    for (int o = 1; o < 64; o <<= 1) v += shfl_xor_f(v, o);
    return v;
}
DEVFN void p0_transpose_item(const float* W, int N, int nsrc0, bf16_t* WT, int ndst0, int k0, LDSQ float* scr, int lane) {
#pragma unroll 8
    for (int i = 0; i < 32; ++i) { const int kk = 2 * i + (lane >> 5); scr[kk * 33 + (lane & 31)] = W[(size_t)(k0 + kk) * N + nsrc0 + (lane & 31)]; }
    WAVE_LDS_FENCE();
    const int c = lane & 7;
#pragma unroll
    for (int j = 0; j < 4; ++j) { const int n = (lane >> 3) + 8 * j; const LDSQ float* s = scr + (8 * c) * 33 + n;
        u32x4 o; o.x = pk2(s[0 * 33], s[1 * 33]); o.y = pk2(s[2 * 33], s[3 * 33]); o.z = pk2(s[4 * 33], s[5 * 33]); o.w = pk2(s[6 * 33], s[7 * 33]);
        *(u32x4*)(WT + (size_t)(ndst0 + n) * 1024 + k0 + 8 * c) = o; }
    WAVE_LDS_FENCE();
}
DEVFN void phase_p0a(const Ctx& C) {
    LDSQ float* scr = (LDSQ float*)(C.lds + C.wave * 16384);
    const int gw = C.cu * 8 + C.wave, NGW = C.ncu * 8;
    bf16_t* WIN = WSP(bf16_t, WS_WIN); bf16_t* WOUT = WSP(bf16_t, WS_WOUT); bf16_t* WADA = WSP(bf16_t, WS_WADA);
    constexpr int I_IN = 4 * 16 * 128, I_OUT = 4 * 16 * 32, I_ADA = 4 * 16 * 96, I_FIN = 16 * 64;
    for (int it = gw; it < I_IN + I_OUT + I_ADA + I_FIN; it += NGW) {
        int r = it;
        if (r < I_IN) { const int l = r / 2048, rr = r % 2048, kb = rr / 128, nb = rr % 128, nd = 32 * nb, ns = nd < 2560 ? nd : nd + 12;
            p0_transpose_item(C.w_in + (size_t)l * 1024 * IN_W, IN_W, ns, WIN + (size_t)l * 4096 * 1024, nd, 64 * kb, scr, C.lane); continue; }
        r -= I_IN;
        if (r < I_OUT) { const int l = r / 512, rr = r % 512, kb = rr / 32, nb = rr % 32;
            p0_transpose_item(C.w_out + (size_t)l * 1024 * 1024, 1024, 32 * nb, WOUT + (size_t)l * 1024 * 1024, 32 * nb, 64 * kb, scr, C.lane); continue; }
        r -= I_OUT;
        if (r < I_ADA) { const int l = r / 1536, rr = r % 1536, kb = rr / 96, nb = rr % 96;
            p0_transpose_item(C.w_ada + (size_t)l * 1024 * 3072, 3072, 32 * nb, WADA + (size_t)l * 3072 * 1024, 32 * nb, 64 * kb, scr, C.lane); continue; }
        r -= I_ADA;
        { const int kb = r / 64, nb = r % 64;
            p0_transpose_item(C.w_ada_final, 2048, 32 * nb, WADA + (size_t)12288 * 1024, 32 * nb, 64 * kb, scr, C.lane); }
    }
    const int gt = C.cu * 512 + C.tid, NGT = C.ncu * 512;
    float* WAB = WSP(float, WS_WAB);
    for (int i = gt; i < 4 * 12 * 1024; i += NGT) { const int l = i / 12288, j = (i / 1024) % 12, k = i % 1024; WAB[i] = C.w_in[((size_t)l * 1024 + k) * IN_W + 2560 + j]; }
    unsigned* CB = WSP(unsigned, WS_CB);
    for (int i = gt; i < 256 * 512; i += NGT) { const int row = i / 512, c = 2 * (i % 512); float a = 0.f, b = 0.f;
        if (row < NBP) { a = C.c_prompt[row * 1024 + c]; b = C.c_prompt[row * 1024 + c + 1]; }
        else if (row < NBROW) { a = C.c_sample[(row - NBP) * 1024 + c]; b = C.c_sample[(row - NBP) * 1024 + c + 1]; }
        CB[i] = pk2(a, b); }
    float* ROPE = WSP(float, WS_ROPE);
    for (int i = gt; i < 2052 * 8; i += NGT) { const int pos = i >> 3, j = i & 7;
        const float invf[8] = {1.0f, 0.1939227432012558f, 0.03760603070259094f, 0.007292664609849453f, 0.0014142135623842478f, 0.00027424818836152554f, 5.3182957344688475e-05f, 1.0313385246263351e-05f};
        float fr = 1.0f;
#pragma unroll
        for (int q = 0; q < 8; ++q) fr = (j == q) ? invf[q] : fr;
        const float ang = (float)pos * fr;
        const double a = (double)ang, tw = 6.283185307179586476925;
        const double kq = __builtin_floor(a / tw + 0.5); const float red = (float)(a - kq * tw);
        ROPE[pos * 16 + j] = FAST_COS(red); ROPE[pos * 16 + 8 + j] = FAST_SIN(red); }
}
DEVFN int brow_of(int m) { return m < M_P ? (m >> 11) : NBP + ((m - M_P) >> 2); }
DEVFN const float* xrow_l0(const Ctx& C, int m) { return m < M_P ? C.x_prompt + (size_t)m * 1024 : C.x_sample + (size_t)(m - M_P) * 1024; }
DEVFN void phase_norm(const Ctx& C, int l) {
    const int gw = C.cu * 8 + C.wave, NGW = C.ncu * 8;
    const float* X = WSP(float, WS_X); bf16_t* HN = WSP(bf16_t, WS_HN); float* AB = WSP(float, WS_AB);
    const float* MOD = WSP(float, WS_MOD); const float* WAB = WSP(float, WS_WAB) + l * 12 * 1024;
    const f32x4* nw = (const f32x4*)(C.norm_w + l * 1024) + C.lane;
    for (int m = gw; m < M_T; m += NGW) {
        const f32x4* xr = (const f32x4*)(l == 0 ? xrow_l0(C, m) : X + (size_t)m * 1024) + C.lane;
        const float* mod = MOD + (size_t)brow_of(m) * NMOD + l * 3072;
        f32x4 v[4]; float s = 0.f;
#pragma unroll
        for (int j = 0; j < 4; ++j) { v[j] = xr[64 * j]; s += (v[j].x * v[j].x + v[j].y * v[j].y) + (v[j].z * v[j].z + v[j].w * v[j].w); }
        const float rstd = RSQF(wave_sum(s) * (1.f / 1024.f) + 1e-6f);
#pragma unroll
        for (int j = 0; j < 4; ++j) { const f32x4 w = nw[64 * j], sh = ((const f32x4*)mod)[64 * j + C.lane], sc = ((const f32x4*)(mod + 1024))[64 * j + C.lane];
            v[j] = v[j] * rstd * w * (sc + 1.0f) + sh; }
        u32x2* o8 = (u32x2*)(HN + (size_t)m * 1024) + C.lane;
#pragma unroll
        for (int j = 0; j < 4; ++j) { u32x2 o; o.x = pk2(v[j].x, v[j].y); o.y = pk2(v[j].z, v[j].w); o8[64 * j] = o; }
        float myab = 0.f;
#pragma unroll
        for (int q = 0; q < 12; ++q) { float d = 0.f;
#pragma unroll
            for (int j = 0; j < 4; ++j) { const f32x4 w = ((const f32x4*)(WAB + q * 1024))[64 * j + C.lane]; d += (v[j].x * w.x + v[j].y * w.y) + (v[j].z * w.z + v[j].w * w.w); }
            d = wave_sum(d); myab = (C.lane == q) ? d : myab; }
        if (C.lane < 12) AB[(size_t)m * 16 + C.lane] = myab;
    }
}
DEVFN void phase_final(const Ctx& C) {
    const int gw = C.cu * 8 + C.wave, NGW = C.ncu * 8;
    const float* X = WSP(float, WS_X); const float* MOD = WSP(float, WS_MOD);
    const f32x4* nw = (const f32x4*)C.final_norm_w + C.lane;
    for (int m = gw; m < M_T; m += NGW) {
        const f32x4* xr = (const f32x4*)(X + (size_t)m * 1024) + C.lane;
        const float* mod = MOD + (size_t)brow_of(m) * NMOD + 12288;
        f32x4 v[4]; float s = 0.f;
#pragma unroll
        for (int j = 0; j < 4; ++j) { v[j] = xr[64 * j]; s += (v[j].x * v[j].x + v[j].y * v[j].y) + (v[j].z * v[j].z + v[j].w * v[j].w); }
        const float rstd = RSQF(wave_sum(s) * (1.f / 1024.f) + 1e-6f);
        f32x4* o = (f32x4*)(C.outp + (m < M_P ? O_YP + (size_t)m * 1024 : O_YS + (size_t)(m - M_P) * 1024)) + C.lane;
#pragma unroll
        for (int j = 0; j < 4; ++j) { const f32x4 w = nw[64 * j], sh = ((const f32x4*)mod)[64 * j + C.lane], sc = ((const f32x4*)(mod + 1024))[64 * j + C.lane];
            o[64 * j] = v[j] * rstd * w * (sc + 1.0f) + sh; }
    }
}
DEVFN bf16x8 lds_frag(const LDSQ bf16_t* base, int ld, int row, int col) { return *(const LDSQ bf16x8*)(base + row * ld + col); }
DEVFN bf16x8 glb_frag(const bf16_t* base, int ld, int row, int col) { return *(const bf16x8*)(base + (size_t)row * ld + col); }
DEVFN bf16x8 zero_frag() { bf16x8 z = {0, 0, 0, 0, 0, 0, 0, 0}; return z; }
DEVFN u32x2 pack4(f32x4 v) { u32x2 o; o.x = pk2(v.x, v.y); o.y = pk2(v.z, v.w); return o; }
constexpr int LDP = 72;
constexpr float NEG_BIG = -1e30f;
DEVFN int inv_perm(int c) { return (c & 32) | (((c >> 2) & 3) << 3) | (((c >> 4) & 1) << 2) | (c & 3); }
DEVFN bf16x8 acc_pair_frag(f32x4 lo, f32x4 hi) { const u32x4 u = {pk2(lo.x, lo.y), pk2(lo.z, lo.w), pk2(hi.x, hi.y), pk2(hi.z, hi.w)}; return __builtin_bit_cast(bf16x8, u); }

DEVFN void conv_a_item(const Ctx& C, int l, int item) {
    const bf16_t* U = WSP(bf16_t, WS_U); bf16_t* MIX = WSP(bf16_t, WS_MIX);
    const int rl = C.tid >> 5, ch = (C.tid & 31) * 8;
    float w[3][8];
#pragma unroll
    for (int j = 0; j < 3; ++j)
#pragma unroll
        for (int e = 0; e < 8; ++e) w[j][e] = C.conv_a_w[(l * 3 + j) * 256 + ch + e];
    for (int pass = 0; pass < 4; ++pass) {
        const int m = item * 64 + pass * 16 + rl;
        const bool smp = m >= M_P; const int b = smp ? (m - M_P) >> 2 : m >> 11, t = smp ? (m - M_P) & 3 : m & 2047;
        float P[3][8];
#pragma unroll
        for (int j = 0; j < 3; ++j) { const int tt = t - 2 + j;
            if (tt >= 0) { const size_t r = (size_t)(m - 2 + j) * NU; float a[8], c[8];
                unpack8(*(const u32x4*)(U + r + UC_AX + ch), a); unpack8(*(const u32x4*)(U + r + UC_ACG + ch), c);
#pragma unroll
                for (int e = 0; e < 8; ++e) P[j][e] = a[e] * c[e]; }
            else if (smp) { const float* s = C.st_conv_a + ((size_t)(l * NBS + b) * 2 + (tt + 2)) * 256 + ch;
#pragma unroll
                for (int e = 0; e < 8; ++e) P[j][e] = s[e]; }
            else {
#pragma unroll
                for (int e = 0; e < 8; ++e) P[j][e] = 0.f; } }
        float bg[8], z[8], y[8];
        unpack8(*(const u32x4*)(U + (size_t)m * NU + UC_ABG + ch), bg); unpack8(*(const u32x4*)(U + (size_t)m * NU + UC_AZ + ch), z);
#pragma unroll
        for (int e = 0; e < 8; ++e) y[e] = bg[e] * (w[0][e] * P[0][e] + w[1][e] * P[1][e] + w[2][e] * P[2][e]) * silu_f(z[e]);
        *(u32x4*)(MIX + (size_t)m * 1024 + ch) = pack8(y);
        const int last = smp ? 4 : 2048;
        if (t >= last - 2) { float* o = C.outp + (smp ? O_CAS + ((size_t)(l * NBS + b) * 2 + (t - 2)) * 256 : O_CAP + ((size_t)(l * NBP + b) * 2 + (t - 2046)) * 256) + ch;
#pragma unroll
            for (int e = 0; e < 8; ++e) o[e] = P[2][e]; }
    }
}

constexpr int GP_KN = 0, GP_QN = 9216, GP_VBT = 18432, GP_KBGT = 27648, GP_KDT = 36864, GP_LB = 46080, GP_TR = 55296, GP_TT = 64512, GP_AM = 73728, GP_WM = 82944,
              GP_LF = 92160  , GP_PT = 109568  , GP_QT = 112128  , GP_G = 114688  ;
DEVFN void gdn_prep_item(const Ctx& C, int l, int item) {
    const int b = item / 192, h = (item / 32) % 6, n = item % 32;
    const int lane = C.lane, quad = lane >> 4, l15 = lane & 15, wave = C.wave;
    const bf16_t* U = WSP(bf16_t, WS_U); const float* AB = WSP(float, WS_AB);
    unsigned char* cbase = C.wsp + WS_GDN + (size_t)item * GDN_CHUNK_BYTES;
    bf16_t* gWm = (bf16_t*)cbase; bf16_t* gQG = (bf16_t*)(cbase + 8192); bf16_t* gAm = (bf16_t*)(cbase + 16384); bf16_t* gKDt = (bf16_t*)(cbase + 24576); bf16_t* gUt = (bf16_t*)(cbase + 32768);
    LDSQ bf16_t* Kn = (LDSQ bf16_t*)(C.lds + GP_KN); LDSQ bf16_t* Qn = (LDSQ bf16_t*)(C.lds + GP_QN); LDSQ bf16_t* VbT = (LDSQ bf16_t*)(C.lds + GP_VBT);
    LDSQ bf16_t* KbgT = (LDSQ bf16_t*)(C.lds + GP_KBGT); LDSQ bf16_t* KDt = (LDSQ bf16_t*)(C.lds + GP_KDT); LDSQ bf16_t* Lb = (LDSQ bf16_t*)(C.lds + GP_LB);
    LDSQ bf16_t* Tr = (LDSQ bf16_t*)(C.lds + GP_TR); LDSQ bf16_t* Tt = (LDSQ bf16_t*)(C.lds + GP_TT); LDSQ bf16_t* Am = (LDSQ bf16_t*)(C.lds + GP_AM); LDSQ bf16_t* Wm = (LDSQ bf16_t*)(C.lds + GP_WM);
    LDSQ float* Lf = (LDSQ float*)(C.lds + GP_LF); LDSQ bf16_t* PT = (LDSQ bf16_t*)(C.lds + GP_PT); LDSQ bf16_t* QT = (LDSQ bf16_t*)(C.lds + GP_QT);
    LDSQ float* gl = (LDSQ float*)(C.lds + GP_G); LDSQ float* gcl = gl + 64; LDSQ float* betal = gl + 128;
    const int i = C.tid >> 3, cg = C.tid & 7, t = 64 * n + i;
    const size_t row = (size_t)b * 2048 + t;
    float q[8], k[8], v[8], xq[8], xk[8], xv[8];
#pragma unroll
    for (int e = 0; e < 8; ++e) { q[e] = 0.f; k[e] = 0.f; v[e] = 0.f; xq[e] = 0.f; xk[e] = 0.f; xv[e] = 0.f; }
    const int cq = h * 64 + 8 * cg;
#pragma unroll
    for (int j = 0; j < 4; ++j) { const int tt = t - 3 + j;
        if (tt >= 0) { const bf16_t* ur = U + (row - 3 + j) * NU + cq;
            unpack8(*(const u32x4*)(ur + UC_BQ), xq); unpack8(*(const u32x4*)(ur + UC_BK), xk); unpack8(*(const u32x4*)(ur + UC_BV), xv);
            const float* wr_ = C.conv_b_w + (size_t)(l * 4 + j) * 1152 + cq;
#pragma unroll
            for (int e = 0; e < 8; ++e) { q[e] += xq[e] * wr_[e]; k[e] += xk[e] * wr_[384 + e]; v[e] += xv[e] * wr_[768 + e]; } } }
    if (n == 31 && i >= 61) { float* o = C.outp + O_CBP + ((size_t)(l * NBP + b) * 3 + (i - 61)) * 1152 + cq;
#pragma unroll
        for (int e = 0; e < 8; ++e) { o[e] = xq[e]; o[384 + e] = xk[e]; o[768 + e] = xv[e]; } }
    float sq = 0.f, sk = 0.f;
#pragma unroll
    for (int e = 0; e < 8; ++e) { q[e] = silu_f(q[e]); k[e] = silu_f(k[e]); v[e] = silu_f(v[e]); sq += q[e] * q[e]; sk += k[e] * k[e]; }
    sq += shfl_xor_f(sq, 1); sq += shfl_xor_f(sq, 2); sq += shfl_xor_f(sq, 4);
    sk += shfl_xor_f(sk, 1); sk += shfl_xor_f(sk, 2); sk += shfl_xor_f(sk, 4);
    const float rq = 0.125f * RSQF(sq + 1e-6f), rk = RSQF(sk + 1e-6f);
#pragma unroll
    for (int e = 0; e < 8; ++e) { q[e] *= rq; k[e] *= rk; }
    if (cg == 0) { const float ga = AB[row * 16 + h], gb = AB[row * 16 + 6 + h];
        gl[i] = -EXPF(C.a_log[l * 6 + h]) * softplus_f(ga + C.dt_bias[l * 6 + h]); betal[i] = sigmoid_f(gb); }
    for (int e = C.tid; e < 2 * 64 * LDP / 2; e += 512) ((LDSQ unsigned*)Tr)[e] = 0u;
    SYNC();
    if (wave == 0) { float x = gl[lane];
#pragma unroll
        for (int d = 1; d < 64; d <<= 1) { const float y = shfl_up_f(x, d); if (lane >= d) x += y; }
        gcl[lane] = x; }
    SYNC();
    const float gci = gcl[i], glast = gcl[63], bi = betal[i];
    const float egc = EXPF(gci), ekd = EXPF(glast - gci);
    {
        float tq[8];
#pragma unroll
        for (int e = 0; e < 8; ++e) tq[e] = q[e] * egc;
        { const int c0 = 32 * (cg >> 2) + 16 * (cg & 1) + 4 * ((cg >> 1) & 1);
            *(u32x2*)(gQG + i * 64 + c0) = (u32x2){pk2(tq[0], tq[1]), pk2(tq[2], tq[3])}; *(u32x2*)(gQG + i * 64 + c0 + 8) = (u32x2){pk2(tq[4], tq[5]), pk2(tq[6], tq[7])}; }
        *(LDSQ u32x4*)(Kn + i * LDP + 8 * cg) = pack8(k); *(LDSQ u32x4*)(Qn + i * LDP + 8 * cg) = pack8(q);
#pragma unroll
        for (int e = 0; e < 8; ++e) { const int d = 8 * cg + e;
            VbT[d * LDP + i] = (bf16_t)f2bf(v[e] * bi); KbgT[d * LDP + i] = (bf16_t)f2bf(k[e] * bi * egc); KDt[d * LDP + inv_perm(i)] = (bf16_t)f2bf(k[e] * ekd); }
    }
    SYNC();
#pragma unroll 1
    for (int jj = 0; jj < 4; ++jj) { const int job = wave * 4 + jj, type = job >> 4, it = (job & 15) >> 2, jt = job & 3;
        if (it < jt) { if (type == 1) {
#pragma unroll
                for (int r = 0; r < 4; ++r) Am[(16 * it + 4 * quad + r) * LDP + inv_perm(16 * jt + l15)] = 0; }
            continue; }
        f32x4 acc = {0.f, 0.f, 0.f, 0.f};
#pragma unroll
        for (int s = 0; s < 2; ++s) { const bf16x8 a = lds_frag(type ? Qn : Kn, LDP, 16 * it + l15, 32 * s + 8 * quad), bb = lds_frag(Kn, LDP, 16 * jt + l15, 32 * s + 8 * quad);
            acc = mfma16(a, bb, acc); }
        const int jc = 16 * jt + l15; const float gj = gcl[jc];
#pragma unroll
        for (int r = 0; r < 4; ++r) { const int ir = 16 * it + 4 * quad + r; const float gi = gcl[ir];
            if (type == 0) { const float val = (ir > jc) ? betal[ir] * acc[r] * EXPF(gi - gj) : 0.f; Lf[ir * 68 + jc] = val; Lb[ir * LDP + jc] = (bf16_t)f2bf(val); }
            else { const float val = (ir >= jc) ? acc[r] * EXPF(gi - gj) : 0.f; Am[ir * LDP + inv_perm(jc)] = (bf16_t)f2bf(val); } }
    }
    SYNC();
    if (wave == 0) { const int blk = quad, c = l15; float x[16];
#pragma unroll
        for (int ii = 0; ii < 16; ++ii) { float s = (ii == c) ? 1.f : 0.f;
#pragma unroll
            for (int jx = 0; jx < ii; ++jx) s -= Lf[(16 * blk + ii) * 68 + 16 * blk + jx] * x[jx];
            x[ii] = s; }
#pragma unroll
        for (int ii = 0; ii < 16; ++ii) Tr[(16 * blk + ii) * LDP + 16 * blk + c] = (bf16_t)f2bf(x[ii]);
        *(LDSQ u32x4*)(Tt + (16 * blk + c) * LDP + 16 * blk) = pack8(x); *(LDSQ u32x4*)(Tt + (16 * blk + c) * LDP + 16 * blk + 8) = pack8(x + 8); }
    SYNC();
    if (wave < 2) { const int rb = 2 * wave + 1, cb = 2 * wave; LDSQ bf16_t* pt = PT + wave * 16 * 40;
        bf16x8 a = quad < 2 ? lds_frag(Lb, LDP, 16 * rb + l15, 16 * cb + 8 * quad) : zero_frag();
        bf16x8 bb = quad < 2 ? lds_frag(Tt, LDP, 16 * cb + l15, 16 * cb + 8 * quad) : zero_frag();
        f32x4 z = {0.f, 0.f, 0.f, 0.f}; f32x4 p = mfma16(a, bb, z);
        *(LDSQ u32x2*)(pt + l15 * 40 + 4 * quad) = pack4(p);
        WAVE_LDS_FENCE();
        a = quad < 2 ? lds_frag(Tr, LDP, 16 * rb + l15, 16 * rb + 8 * quad) : zero_frag();
        bb = quad < 2 ? lds_frag(pt, 40, l15, 8 * quad) : zero_frag();
        f32x4 r4 = mfma16(a, bb, z); r4 = -r4;
#pragma unroll
        for (int r = 0; r < 4; ++r) Tr[(16 * rb + 4 * quad + r) * LDP + 16 * cb + l15] = (bf16_t)f2bf(r4[r]);
        *(LDSQ u32x2*)(Tt + (16 * cb + l15) * LDP + 16 * rb + 4 * quad) = pack4(r4); }
    SYNC();
    if (wave < 4) { const int it2 = wave >> 1, jt2 = wave & 1;
        const bf16x8 a = lds_frag(Lb, LDP, 32 + 16 * it2 + l15, 8 * quad), bb = lds_frag(Tt, LDP, 16 * jt2 + l15, 8 * quad);
        f32x4 z = {0.f, 0.f, 0.f, 0.f}; const f32x4 p = mfma16(a, bb, z);
        *(LDSQ u32x2*)(QT + (16 * jt2 + l15) * 40 + 16 * it2 + 4 * quad) = pack4(p); }
    SYNC();
    if (wave < 4) { const int it2 = wave >> 1, jt2 = wave & 1;
        const bf16x8 a = lds_frag(Tr, LDP, 32 + 16 * it2 + l15, 32 + 8 * quad), bb = lds_frag(QT, 40, 16 * jt2 + l15, 8 * quad);
        f32x4 z = {0.f, 0.f, 0.f, 0.f}; f32x4 r4 = mfma16(a, bb, z); r4 = -r4;
#pragma unroll
        for (int r = 0; r < 4; ++r) Tr[(32 + 16 * it2 + 4 * quad + r) * LDP + 16 * jt2 + l15] = (bf16_t)f2bf(r4[r]);
        *(LDSQ u32x2*)(Tt + (16 * jt2 + l15) * LDP + 32 + 16 * it2 + 4 * quad) = pack4(r4); }
    SYNC();
#pragma unroll 1
    for (int jj = 0; jj < 4; ++jj) { const int job = wave * 4 + jj, type = job >> 4, it = (job & 15) >> 2, nt = job & 3;
        f32x4 acc = {0.f, 0.f, 0.f, 0.f};
#pragma unroll
        for (int s = 0; s < 2; ++s) { const bf16x8 a = lds_frag(Tr, LDP, 16 * it + l15, 32 * s + 8 * quad), bb = lds_frag(type ? KbgT : VbT, LDP, 16 * nt + l15, 32 * s + 8 * quad);
            acc = mfma16(a, bb, acc); }
        if (type == 0) *(u32x2*)(gUt + (16 * nt + l15) * 64 + 16 * it + 4 * quad) = pack4(acc);
        else {
#pragma unroll
            for (int r = 0; r < 4; ++r) Wm[(16 * it + 4 * quad + r) * LDP + inv_perm(16 * nt + l15)] = (bf16_t)f2bf(acc[r]); } }
    SYNC();
    { const int r = C.tid >> 3, c8 = (C.tid & 7) * 8;
        *(u32x4*)(gWm + r * 64 + c8) = *(const LDSQ u32x4*)(Wm + r * LDP + c8);
        *(u32x4*)(gAm + r * 64 + c8) = *(const LDSQ u32x4*)(Am + r * LDP + c8);
        *(u32x4*)(gKDt + r * 64 + c8) = *(const LDSQ u32x4*)(KDt + r * LDP + c8);
        if (C.tid == 0) WSP(float, WS_GSC)[item] = EXPF(glast); }
    SYNC();
}

constexpr int SB_RING = 0, SB_RBUF = 40960, SB_Z = 122880, SB_ZBUF = 8192, SB_O = 139264, SB_OBUF = 9216, SB_DEC = 157696, SB_END = 158080;
DEVFN int sw_off(int row, int col) { return row * 64 + ((((col >> 3) ^ row) & 7) << 3) + (col & 7); }
DEVFN bf16x8 sw_frag(const LDSQ bf16_t* base, int row, int col) { return *(const LDSQ bf16x8*)(base + sw_off(row, col)); }
DEVFN void scan_dma_chunk(const unsigned char* cbase, LDSQ unsigned char* rbuf, int w, int lane) {
    const int row = 8 * w + (lane >> 3), c = (lane & 7) ^ (lane >> 3);
#pragma unroll
    for (int j = 0; j < 5; ++j) DMA16(cbase + j * 8192 + row * 128 + c * 16, rbuf + j * 8192 + w * 1024, lane);
}
DEVFN void scan_dma_z(const bf16_t* Uz, int n, LDSQ unsigned char* zbuf, int rg, int lane) {
    const int row = 8 * rg + (lane >> 3), c = (lane & 7) ^ (lane >> 3);
    DMA16((const unsigned char*)(Uz + (size_t)(64 * n + row) * NU) + c * 16, zbuf + rg * 1024, lane);
}
DEVFN void scan_epi(const Ctx& C, const bf16_t* Uz, LDSQ unsigned char* zbuf, const LDSQ bf16_t* obuf, const LDSQ float* nw, int b, int h, int n, bool next_z, int lw, int lane) {
    const int row = 16 * lw + (lane >> 2), c0 = 16 * (lane & 3); float o[16], zf[16]; float ss = 0.f;
    unpack8(*(const LDSQ u32x4*)(obuf + row * LDP + c0), o); unpack8(*(const LDSQ u32x4*)(obuf + row * LDP + c0 + 8), o + 8);
    unpack8(*(const LDSQ u32x4*)((const LDSQ bf16_t*)zbuf + sw_off(row, c0)), zf); unpack8(*(const LDSQ u32x4*)((const LDSQ bf16_t*)zbuf + sw_off(row, c0 + 8)), zf + 8);
    WAVE_LDS_FENCE();
    if (next_z) { scan_dma_z(Uz, n + 2, zbuf, 2 * lw, lane); scan_dma_z(Uz, n + 2, zbuf, 2 * lw + 1, lane); }
#pragma unroll
    for (int e = 0; e < 16; ++e) ss += o[e] * o[e];
    ss += shfl_xor_f(ss, 1); ss += shfl_xor_f(ss, 2);
    const float rstd = RSQF(ss * (1.f / 64.f) + 1e-6f);
#pragma unroll
    for (int e = 0; e < 16; ++e) o[e] = o[e] * rstd * nw[e] * silu_f(zf[e]);
    bf16_t* mp = WSP(bf16_t, WS_MIX) + ((size_t)b * 2048 + 64 * n + row) * 1024 + 256 + h * 64 + c0;
    *(u32x4*)mp = pack8(o); *(u32x4*)(mp + 8) = pack8(o + 8);
}
DEVFN void scan_compute(const LDSQ unsigned char* rbuf, LDSQ bf16_t* obuf, f32x4 (&S)[4], float dec, int w, int quad, int l15) {
    const LDSQ bf16_t* Wm = (const LDSQ bf16_t*)rbuf; const LDSQ bf16_t* QG = Wm + 4096; const LDSQ bf16_t* Am = Wm + 2 * 4096; const LDSQ bf16_t* KD = Wm + 3 * 4096; const LDSQ bf16_t* Ut = Wm + 4 * 4096;
    const bf16x8 bS0 = acc_pair_frag(S[0], S[1]), bS1 = acc_pair_frag(S[2], S[3]);
    f32x4 vn[4];
#pragma unroll
    for (int it = 0; it < 4; ++it) { f32x4 acc = {0.f, 0.f, 0.f, 0.f};
        acc = mfma16(sw_frag(Wm, 16 * it + l15, 8 * quad), bS0, acc); acc = mfma16(sw_frag(Wm, 16 * it + l15, 32 + 8 * quad), bS1, acc);
        const u32x2 u2 = *(const LDSQ u32x2*)(Ut + sw_off(16 * w + l15, 16 * it + 4 * quad));
        vn[it] = (f32x4){bf_lo(u2.x), bf_hi(u2.x), bf_lo(u2.y), bf_hi(u2.y)} - acc; }
    const bf16x8 bV0 = acc_pair_frag(vn[0], vn[1]), bV1 = acc_pair_frag(vn[2], vn[3]);
#pragma unroll
    for (int kt = 0; kt < 4; ++kt) { f32x4 acc = S[kt] * dec;
        acc = mfma16(sw_frag(KD, 16 * kt + l15, 8 * quad), bV0, acc); acc = mfma16(sw_frag(KD, 16 * kt + l15, 32 + 8 * quad), bV1, acc);
        S[kt] = acc; }
#pragma unroll
    for (int it = 0; it < 4; ++it) { f32x4 acc = {0.f, 0.f, 0.f, 0.f};
        acc = mfma16(sw_frag(QG, 16 * it + l15, 8 * quad), bS0, acc); acc = mfma16(sw_frag(QG, 16 * it + l15, 32 + 8 * quad), bS1, acc);
        acc = mfma16(sw_frag(Am, 16 * it + l15, 8 * quad), bV0, acc); acc = mfma16(sw_frag(Am, 16 * it + l15, 32 + 8 * quad), bV1, acc);
#pragma unroll
        for (int r = 0; r < 4; ++r) obuf[(16 * it + 4 * quad + r) * LDP + 16 * w + l15] = (bf16_t)f2bf(acc[r]); }
}
DEVFN void gdn_scan_unit(const Ctx& C, int l, int unit) {
    const int b = unit / 6, h = unit % 6;
    const int lane = C.lane, quad = lane >> 4, l15 = lane & 15, w = C.wave;
    const bf16_t* Uz = WSP(bf16_t, WS_U) + (size_t)b * 2048 * NU + UC_BZ + h * 64;
    const unsigned char* g0 = C.wsp + WS_GDN + (size_t)unit * 32 * GDN_CHUNK_BYTES;
    LDSQ unsigned char* R0 = C.lds + SB_RING; LDSQ unsigned char* Z0 = C.lds + SB_Z; LDSQ bf16_t* O0 = (LDSQ bf16_t*)(C.lds + SB_O); LDSQ float* decl = (LDSQ float*)(C.lds + SB_DEC);
    const bool comp = w < 4; const int lw = w & 3, lt = C.tid & 255;
    f32x4 S[4];
#pragma unroll
    for (int kt = 0; kt < 4; ++kt) S[kt] = (f32x4){0.f, 0.f, 0.f, 0.f};
    LDSQ float* nwl = decl + 32; const LDSQ float* nw = nwl + 16 * (lane & 3);
    if (!comp) { if (lt < 32) decl[lt] = WSP(float, WS_GSC)[unit * 32 + lt]; else if (lt < 96) nwl[lt - 32] = C.gdn_norm_w[l * 64 + lt - 32]; }
    VM_DRAIN();
    scan_dma_chunk(g0, R0, w, lane); scan_dma_chunk(g0 + GDN_CHUNK_BYTES, R0 + SB_RBUF, w, lane);
    if (!comp) { scan_dma_z(Uz, 0, Z0, 2 * lw, lane); scan_dma_z(Uz, 0, Z0, 2 * lw + 1, lane); }
    VM_DRAIN(); RAW_SYNC();
#pragma unroll 1
    for (int n = 0; n < 32; ++n) {
        const bool more = n + 2 < 32;
        if (more) scan_dma_chunk(g0 + (size_t)(n + 2) * GDN_CHUNK_BYTES, R0 + ((n + 2) % 3) * SB_RBUF, w, lane);
        if (comp) { scan_compute(R0 + (n % 3) * SB_RBUF, O0 + (n & 1) * (SB_OBUF / 2), S, decl[n], w, quad, l15);
            if (more) VM_WAIT_N(5); else VM_DRAIN(); }
        else { if (n > 0) scan_epi(C, Uz, Z0 + ((n - 1) & 1) * SB_ZBUF, O0 + ((n - 1) & 1) * (SB_OBUF / 2), nw, b, h, n - 1, n + 1 < 32, lw, lane);
            else { scan_dma_z(Uz, 1, Z0 + SB_ZBUF, 2 * lw, lane); scan_dma_z(Uz, 1, Z0 + SB_ZBUF, 2 * lw + 1, lane); }
            if (more) VM_WAIT_N(9); else VM_DRAIN(); }
        RAW_SYNC();
    }
    if (!comp) scan_epi(C, Uz, Z0 + SB_ZBUF, O0 + SB_OBUF / 2, nw, b, h, 31, false, lw, lane);
    else { float* og = C.outp + O_GP + ((size_t)(l * NBP + b) * 6 + h) * 4096;
#pragma unroll
        for (int kt = 0; kt < 4; ++kt)
#pragma unroll
            for (int r = 0; r < 4; ++r) og[(16 * kt + 4 * quad + r) * 64 + 16 * w + l15] = S[kt][r]; }
    SYNC();
}

DEVFN void gdn_sample_item(const Ctx& C, int l, int witem, LDSQ float* kq) {
    const int b = witem / 6, h = witem % 6, d = C.lane, m0 = M_P + 4 * b;
    const bf16_t* U = WSP(bf16_t, WS_U); bf16_t* MIX = WSP(bf16_t, WS_MIX); const float* AB = WSP(float, WS_AB);
    float qv[4], kv[4], vv[4];
    {
        float xp[3][7];
#pragma unroll
        for (int c = 0; c < 3; ++c) { const int ch = c * 384 + h * 64 + d;
#pragma unroll
            for (int j = 0; j < 3; ++j) xp[c][j] = C.st_conv_b[((size_t)(l * NBS + b) * 3 + j) * 1152 + ch];
#pragma unroll
            for (int i = 0; i < 4; ++i) xp[c][3 + i] = bf2f(U[(size_t)(m0 + i) * NU + (c == 0 ? UC_BQ : c == 1 ? UC_BK : UC_BV) + h * 64 + d]);
#pragma unroll
            for (int j = 0; j < 3; ++j) C.outp[O_CBS + ((size_t)(l * NBS + b) * 3 + j) * 1152 + ch] = xp[c][4 + j];
            float wt[4];
#pragma unroll
            for (int j = 0; j < 4; ++j) wt[j] = C.conv_b_w[(size_t)(l * 4 + j) * 1152 + ch];
#pragma unroll
            for (int i = 0; i < 4; ++i) { const float y = silu_f(wt[0] * xp[c][i] + wt[1] * xp[c][i + 1] + wt[2] * xp[c][i + 2] + wt[3] * xp[c][i + 3]);
                if (c == 0) qv[i] = y; else if (c == 1) kv[i] = y; else vv[i] = y; } }
    }
#pragma unroll
    for (int i = 0; i < 4; ++i) { const float sq = wave_sum(qv[i] * qv[i]), sk = wave_sum(kv[i] * kv[i]); qv[i] *= 0.125f * RSQF(sq + 1e-6f); kv[i] *= RSQF(sk + 1e-6f); }
    float S[64];
    const float* s0 = C.st_gdn + ((size_t)(l * NBS + b) * 6 + h) * 4096 + d;
#pragma unroll
    for (int dk = 0; dk < 64; ++dk) S[dk] = s0[dk * 64];
    const float alog = -EXPF(C.a_log[l * 6 + h]), dtb = C.dt_bias[l * 6 + h], nw = C.gdn_norm_w[l * 64 + d];
#pragma unroll 1
    for (int i = 0; i < 4; ++i) {
        const float g = alog * softplus_f(AB[(size_t)(m0 + i) * 16 + h] + dtb), beta = sigmoid_f(AB[(size_t)(m0 + i) * 16 + 6 + h]);
        const float eg = EXPF(g);
        float qi = qv[0], ki = kv[0], vi = vv[0];
#pragma unroll
        for (int j = 1; j < 4; ++j) { qi = (i == j) ? qv[j] : qi; ki = (i == j) ? kv[j] : ki; vi = (i == j) ? vv[j] : vi; }
        WAVE_LDS_FENCE();
        kq[d] = ki; kq[64 + d] = qi;
        WAVE_LDS_FENCE();
        float ks0 = 0.f, ks1 = 0.f, ks2 = 0.f, ks3 = 0.f;
#pragma unroll
        for (int d0 = 0; d0 < 64; d0 += 4) { const f32x4 ka = *(const LDSQ f32x4*)(kq + d0);
            ks0 = FMA_OP(ka.x, S[d0], ks0); ks1 = FMA_OP(ka.y, S[d0 + 1], ks1); ks2 = FMA_OP(ka.z, S[d0 + 2], ks2); ks3 = FMA_OP(ka.w, S[d0 + 3], ks3); }
        const float vn = beta * (vi - eg * ((ks0 + ks1) + (ks2 + ks3)));
        float o0 = 0.f, o1 = 0.f, o2 = 0.f, o3 = 0.f;
#pragma unroll
        for (int d0 = 0; d0 < 64; d0 += 4) { const f32x4 ka = *(const LDSQ f32x4*)(kq + d0), qa = *(const LDSQ f32x4*)(kq + 64 + d0);
            S[d0] = FMA_OP(eg, S[d0], ka.x * vn); S[d0 + 1] = FMA_OP(eg, S[d0 + 1], ka.y * vn); S[d0 + 2] = FMA_OP(eg, S[d0 + 2], ka.z * vn); S[d0 + 3] = FMA_OP(eg, S[d0 + 3], ka.w * vn);
            o0 = FMA_OP(qa.x, S[d0], o0); o1 = FMA_OP(qa.y, S[d0 + 1], o1); o2 = FMA_OP(qa.z, S[d0 + 2], o2); o3 = FMA_OP(qa.w, S[d0 + 3], o3); }
        const float o = (o0 + o1) + (o2 + o3);
        const float ssq = wave_sum(o * o); const float rstd = RSQF(ssq * (1.f / 64.f) + 1e-6f);
        const float z = bf2f(U[(size_t)(m0 + i) * NU + UC_BZ + h * 64 + d]);
        MIX[(size_t)(m0 + i) * 1024 + 256 + h * 64 + d] = (bf16_t)f2bf(o * rstd * nw * silu_f(z));
    }
    float* so = C.outp + O_GS + ((size_t)(l * NBS + b) * 6 + h) * 4096 + d;
#pragma unroll
    for (int dk = 0; dk < 64; ++dk) so[dk * 64] = S[dk];
}

constexpr int AT_K = 0  , AT_Q = 36864  , AT_VT = 55296  , VTP = 296;
DEVFN void rope8(float* x1, float* x2, const float* cs) {
#pragma unroll
    for (int e = 0; e < 8; ++e) { const float a = x1[e], bq = x2[e]; x1[e] = a * cs[e] - bq * cs[8 + e]; x2[e] = bq * cs[e] + a * cs[8 + e]; }
}
DEVFN void attn_prompt_unit(const Ctx& C, int l, int unit) {
    const int g = unit >> 8, uu = unit & 255, b = uu >> 5, h2 = (uu >> 4) & 1, rest = uu & 15;
    const int dil = g == 0 ? 1 : g == 1 ? 4 : 16, nb = g == 0 ? 16 : g == 1 ? 4 : 1, win = g == 0 ? 128 : g == 1 ? 512 : 2048;
    const int r = rest / nb, n = rest % nb, hh = 2 * g + h2;
    const int lane = C.lane, quad = lane >> 4, l15 = lane & 15, w = C.wave;
    const bf16_t* U = WSP(bf16_t, WS_U); const float* ROPE = WSP(float, WS_ROPE); bf16_t* OC = WSP(bf16_t, WS_OC); float* LSE = WSP(float, WS_LSE);
    LDSQ bf16_t* Kl = (LDSQ bf16_t*)(C.lds + AT_K); LDSQ bf16_t* Ql = (LDSQ bf16_t*)(C.lds + AT_Q); LDSQ bf16_t* VT = (LDSQ bf16_t*)(C.lds + AT_VT);
    float* kvout = C.outp + (g == 0 ? O_K128P : g == 1 ? O_K512P : O_K2048P) + (size_t)(l * NBP + b) * win * 256;
    for (int p = 0; p < 4; ++p) { const int idx = C.tid + 512 * p, kk = idx >> 3, c = idx & 7;
        const int mpos = 128 * (n - 1) + kk; const bool ok = mpos >= 0; const int t = mpos * dil + r;
        const bf16_t* ur = U + ((size_t)b * 2048 + (ok ? t : 0)) * NU + hh * 64;
        float v8[8];
        if (ok) unpack8(*(const u32x4*)(ur + UC_CV + 8 * c), v8); else {
#pragma unroll
            for (int e = 0; e < 8; ++e) v8[e] = 0.f; }
#pragma unroll
        for (int e = 0; e < 8; ++e) VT[(8 * c + e) * VTP + kk] = (bf16_t)f2bf(v8[e]);
        const bool wout = (n == nb - 1) && kk >= 128; float* orow = kvout + (size_t)(t - (2048 - win)) * 256 + h2 * 64;
        if (wout) {
#pragma unroll
            for (int e = 0; e < 8; ++e) orow[128 + 8 * c + e] = v8[e]; }
        if (c == 0) { float x1[8], x2[8];
            if (ok) { unpack8(*(const u32x4*)(ur + UC_CK), x1); unpack8(*(const u32x4*)(ur + UC_CK + 8), x2); float cs[16];
#pragma unroll
                for (int e = 0; e < 16; ++e) cs[e] = ROPE[t * 16 + e];
                rope8(x1, x2, cs); }
            else {
#pragma unroll
                for (int e = 0; e < 8; ++e) { x1[e] = 0.f; x2[e] = 0.f; } }
            *(LDSQ u32x4*)(Kl + kk * LDP) = pack8(x1); *(LDSQ u32x4*)(Kl + kk * LDP + 8) = pack8(x2);
            if (wout) {
#pragma unroll
                for (int e = 0; e < 8; ++e) { orow[e] = x1[e]; orow[8 + e] = x2[e]; } } }
        else if (c >= 2) { u32x4 kx = {0u, 0u, 0u, 0u}; if (ok) kx = *(const u32x4*)(ur + UC_CK + 8 * c);
            *(LDSQ u32x4*)(Kl + kk * LDP + 8 * c) = kx;
            if (wout) { float k8[8]; unpack8(kx, k8);
#pragma unroll
                for (int e = 0; e < 8; ++e) orow[8 * c + e] = k8[e]; } }
    }
    for (int p = 0; p < 2; ++p) { const int idx = C.tid + 512 * p, qq = idx >> 3, c = idx & 7;
        const int t = (128 * n + qq) * dil + r; const bf16_t* ur = U + ((size_t)b * 2048 + t) * NU + UC_CQ + hh * 64;
        if (c == 0) { float x1[8], x2[8], cs[16]; unpack8(*(const u32x4*)(ur), x1); unpack8(*(const u32x4*)(ur + 8), x2);
#pragma unroll
            for (int e = 0; e < 16; ++e) cs[e] = ROPE[t * 16 + e];
            rope8(x1, x2, cs);
            *(LDSQ u32x4*)(Ql + qq * LDP) = pack8(x1); *(LDSQ u32x4*)(Ql + qq * LDP + 8) = pack8(x2); }
        else if (c >= 2) *(LDSQ u32x4*)(Ql + qq * LDP + 8 * c) = *(const u32x4*)(ur + 8 * c); }
    for (int e = C.tid; e < 64 * 40; e += 512) VT[(e / 40) * VTP + 256 + (e % 40)] = 0;
    SYNC();
    const int q0 = 16 * w, qi = q0 + l15;
    f32x4 st[9]; float mx = NEG_BIG;
#pragma unroll
    for (int kt = 0; kt < 9; ++kt) { f32x4 acc = {0.f, 0.f, 0.f, 0.f};
#pragma unroll
        for (int s = 0; s < 2; ++s) acc = mfma16(lds_frag(Kl, LDP, 16 * (w + kt) + l15, 32 * s + 8 * quad), lds_frag(Ql, LDP, qi, 32 * s + 8 * quad), acc);
#pragma unroll
        for (int rr = 0; rr < 4; ++rr) { const int kj = 16 * (w + kt) + 4 * quad + rr, dist = 128 + qi - kj; const bool valid = dist >= 0 && dist <= 128 && (n > 0 || kj >= 128);
            acc[rr] = valid ? acc[rr] * 0.125f : NEG_BIG; mx = fmaxf(mx, acc[rr]); }
        st[kt] = acc; }
    mx = fmaxf(mx, shfl_xor_f(mx, 16)); mx = fmaxf(mx, shfl_xor_f(mx, 32));
    float den = 0.f;
#pragma unroll
    for (int kt = 0; kt < 9; ++kt)
#pragma unroll
        for (int rr = 0; rr < 4; ++rr) { const float p = st[kt][rr] > -1e29f ? EXPF(st[kt][rr] - mx) : 0.f; st[kt][rr] = p; den += p; }
    den += shfl_xor_f(den, 16); den += shfl_xor_f(den, 32);
    const float inv = 1.0f / den;
    const int tq = (128 * n + qi) * dil + r; const size_t mrow = (size_t)b * 2048 + tq;
#pragma unroll
    for (int dt = 0; dt < 4; ++dt) { f32x4 acc = {0.f, 0.f, 0.f, 0.f};
#pragma unroll
        for (int pr = 0; pr < 5; ++pr) { const int ta = 2 * pr, tb = 2 * pr + 1;
            const u32x2 plo = pack4(st[ta]); u32x2 phi = {0u, 0u}; if (tb < 9) phi = pack4(st[tb < 9 ? tb : 8]);
            const u32x4 bu = {plo.x, plo.y, phi.x, phi.y};
            const LDSQ bf16_t* vr = VT + (16 * dt + l15) * VTP + 4 * quad;
            const u32x2 alo = *(const LDSQ u32x2*)(vr + 16 * (w + ta)), ahi = *(const LDSQ u32x2*)(vr + 16 * (w + tb));
            const u32x4 au = {alo.x, alo.y, ahi.x, ahi.y};
            acc = mfma16(__builtin_bit_cast(bf16x8, au), __builtin_bit_cast(bf16x8, bu), acc); }
        *(u32x2*)(OC + mrow * 384 + hh * 64 + 16 * dt + 4 * quad) = pack4(acc * inv); }
    if (quad == 0) LSE[mrow * 8 + hh] = mx + LOGF(den);
    SYNC();
}

constexpr int AS_NEW = 0  , AS_Q = 12288  , AS_CMB = 18432  , AS_O = 55296  , AS_L = 61440  ;
DEVFN void attn_sample_b(const Ctx& C, int l, int b) {
    const bf16_t* U = WSP(bf16_t, WS_U); const float* ROPE = WSP(float, WS_ROPE); bf16_t* MIX = WSP(bf16_t, WS_MIX);
    LDSQ float* NEW = (LDSQ float*)(C.lds + AS_NEW); LDSQ float* Qs = (LDSQ float*)(C.lds + AS_Q); LDSQ float* CMB = (LDSQ float*)(C.lds + AS_CMB);
    LDSQ float* OS = (LDSQ float*)(C.lds + AS_O); LDSQ float* LS = (LDSQ float*)(C.lds + AS_L);
    const int lane = C.lane, w = C.wave;
#pragma unroll 1
    for (int g = 0; g < 3; ++g) {
        const int i2 = C.tid >> 7, e0 = (C.tid & 127) * 2; const size_t m = M_P + 4 * b + i2; const int pos = 2048 + i2;
        float* orow = C.outp + (g == 0 ? O_K128S : g == 1 ? O_K512S : O_K2048S) + ((size_t)(l * NBS + b) * 4 + i2) * 256;
#pragma unroll
        for (int k2 = 0; k2 < 2; ++k2) { const int e = e0 + k2, kvs = e >> 7, h2 = (e >> 6) & 1, d = e & 63; const int hh = 2 * g + h2;
            const bf16_t* ur = U + m * NU + (kvs ? UC_CV : UC_CK) + hh * 64; float val = bf2f(ur[d]);
            if (!kvs && d < 16) { const int f = d & 7; const float cs = ROPE[pos * 16 + f], sn = ROPE[pos * 16 + 8 + f];
                val = d < 8 ? val * cs - bf2f(ur[d + 8]) * sn : val * cs + bf2f(ur[d - 8]) * sn; }
            NEW[(g * 4 + i2) * 256 + e] = val; orow[e] = val; }
        const int h2 = (C.tid >> 6) & 1, d = C.tid & 63, hh = 2 * g + h2; const bf16_t* ur = U + m * NU + UC_CQ + hh * 64; float val = bf2f(ur[d]);
        if (d < 16) { const int f = d & 7; const float cs = ROPE[pos * 16 + f], sn = ROPE[pos * 16 + 8 + f];
            val = d < 8 ? val * cs - bf2f(ur[d + 8]) * sn : val * cs + bf2f(ur[d - 8]) * sn; }
        Qs[(g * 4 + i2) * 128 + h2 * 64 + d] = val * 0.125f;
    }
    SYNC();
    const int i = w & 3, half = w >> 2;
#pragma unroll 1
    for (int g = 0; g < 3; ++g) {
        const int dil = g == 0 ? 1 : g == 1 ? 4 : 16, lb = g == 0 ? 128 : g == 1 ? 512 : 2048;
        const float* cache = (g == 0 ? C.kv128 : g == 1 ? C.kv512 : C.kv2048) + (size_t)(l * NBS + b) * lb * 256;
        const f32x4 q4 = *(const LDSQ f32x4*)(Qs + (g * 4 + i) * 128 + (lane & 31) * 4);
        float mrun = NEG_BIG, den = 0.f; f32x4 o4 = {0.f, 0.f, 0.f, 0.f};
        const int jn = (dil == 1) ? i + 1 : 1;
#define AS_STEP(x4) do { float part = (lane < 32) ? (q4.x * (x4).x + q4.y * (x4).y) + (q4.z * (x4).z + q4.w * (x4).w) : 0.f; \
        part += shfl_xor_f(part, 1); part += shfl_xor_f(part, 2); part += shfl_xor_f(part, 4); part += shfl_xor_f(part, 8); \
        const float s_ = shfl_f(part, lane & 31); const float mn_ = fmaxf(mrun, s_); const float sc_ = EXPF(mrun - mn_), p_ = EXPF(s_ - mn_); \
        den = den * sc_ + p_; o4 = o4 * sc_ + (x4) * p_; mrun = mn_; } while (0)
        if (half == 0) { for (int j = 0; j < jn; ++j) { const f32x4 x4 = *(const LDSQ f32x4*)(NEW + (g * 4 + i - j * dil) * 256 + lane * 4); AS_STEP(x4); } }
        const int j0 = half == 0 ? jn : 65, j1 = half == 0 ? 65 : 129;
        for (int j = j0; j < j1; j += 16) { f32x4 xb[16];
#pragma unroll
            for (int u = 0; u < 16; ++u) { const int jj = (j + u < j1) ? j + u : j1 - 1; xb[u] = *(const f32x4*)(cache + (size_t)(lb + i - jj * dil) * 256 + lane * 4); }
#pragma unroll
            for (int u = 0; u < 16; ++u) if (j + u < j1) AS_STEP(xb[u]); }
#undef AS_STEP
        { LDSQ float* cm = CMB + ((g * 8 + w) * 64 + lane) * 6; cm[0] = mrun; cm[1] = den; cm[2] = o4.x; cm[3] = o4.y; cm[4] = o4.z; cm[5] = o4.w; }
    }
    SYNC();
    if (half == 0 && lane >= 32) {
#pragma unroll 1
        for (int g = 0; g < 3; ++g) { const LDSQ float* c1 = CMB + ((g * 8 + w) * 64 + lane) * 6; const LDSQ float* c2 = CMB + ((g * 8 + w + 4) * 64 + lane) * 6;
            const float m1 = c1[0], d1 = c1[1], m2 = c2[0], d2 = c2[1]; const f32x4 o1 = {c1[2], c1[3], c1[4], c1[5]}, o2 = {c2[2], c2[3], c2[4], c2[5]};
            const float mm = fmaxf(m1, m2), a1 = EXPF(m1 - mm), a2 = EXPF(m2 - mm); const float dt = d1 * a1 + d2 * a2; const f32x4 o = (o1 * a1 + o2 * a2) * (1.0f / dt);
            const int h2 = (lane >> 4) & 1, hh = 2 * g + h2;
            *(LDSQ f32x4*)(OS + i * 384 + hh * 64 + (lane & 15) * 4) = o; if ((lane & 15) == 0) LS[i * 6 + hh] = mm + LOGF(dt); } }
    SYNC();
    for (int p = 0; p < 3; ++p) { const int idx = C.tid + 512 * p, i2 = idx / 384, c = idx % 384, hh = c >> 6, g = hh >> 1, hp = hh & 1; const size_t m = M_P + 4 * b + i2;
        const float l0 = LS[i2 * 6 + hp], l1 = LS[i2 * 6 + 2 + hp], l2 = LS[i2 * 6 + 4 + hp]; const float mx = fmaxf(l0, fmaxf(l1, l2));
        const float e0 = EXPF(l0 - mx), e1 = EXPF(l1 - mx), e2 = EXPF(l2 - mx); const float alpha = (g == 0 ? e0 : g == 1 ? e1 : e2) / (e0 + e1 + e2);
        const float z = bf2f(U[m * NU + UC_CZ + c]);
        MIX[m * 1024 + 640 + c] = (bf16_t)f2bf(OS[i2 * 384 + c] * alpha * silu_f(z)); }
    SYNC();
}

DEVFN void merge_item(const Ctx& C, int item) {
    const bf16_t* U = WSP(bf16_t, WS_U); const bf16_t* OC = WSP(bf16_t, WS_OC); const float* LSE = WSP(float, WS_LSE); bf16_t* MIX = WSP(bf16_t, WS_MIX);
    for (int p = 0; p < 3; ++p) { const int idx = C.tid + 512 * p, rl = idx / 48, c = idx % 48; const size_t m = (size_t)item * 32 + rl;
        const int hh = c >> 3, g = hh >> 1, hp = hh & 1;
        const float l0 = LSE[m * 8 + hp], l1 = LSE[m * 8 + 2 + hp], l2 = LSE[m * 8 + 4 + hp]; const float mx = fmaxf(l0, fmaxf(l1, l2));
        const float e0 = EXPF(l0 - mx), e1 = EXPF(l1 - mx), e2 = EXPF(l2 - mx); const float alpha = (g == 0 ? e0 : g == 1 ? e1 : e2) / (e0 + e1 + e2);
        float o[8], z[8]; unpack8(*(const u32x4*)(OC + m * 384 + 8 * c), o); unpack8(*(const u32x4*)(U + m * NU + UC_CZ + 8 * c), z);
#pragma unroll
        for (int e = 0; e < 8; ++e) o[e] = o[e] * alpha * silu_f(z[e]);
        *(u32x4*)(MIX + m * 1024 + 640 + 8 * c) = pack8(o); }
}

constexpr int N_PREP = 1536, N_ATTP = 768, N_ATTS = 128, N_CONVA = 264;
#ifndef DBL
#define DBL 0
#endif
DEVFN void phase_mid(const Ctx& C0, int l, bool second = false) {
    if (!second || DBL == 3 || DBL == 4) { const Ctx C = relaunder(C0);
        if (C.ncu == 256) { const int xcd = C.cu >> 5, j = C.cu & 31; for (int k = 0; k < 6; ++k) gdn_prep_item(C, l, (xcd + 8 * k) * 32 + j); }
        else for (int it = C.cu; it < N_PREP; it += C.ncu) gdn_prep_item(C, l, it); }
    if (!second || DBL == 3 || DBL == 5) { const Ctx C = relaunder(C0); for (int it = C.cu; it < N_ATTP; it += C.ncu) attn_prompt_unit(C, l, it); }
}
constexpr int N_SCAN = 48, N_GS = 96, N_MERGE = 512;
#define QUEUE_LOOP(qword, total, body) do { const Ctx C = relaunder(C0); for (;;) { \
        if (C.tid == 0) *(volatile LDSQ int*)(C.lds + LDS_QIDX) = (int)QUEUE_PULL(qword); SYNC(); const int it = *(volatile LDSQ int*)(C.lds + LDS_QIDX); SYNC(); \
        if (it >= (total)) break; body; } } while (0)
DEVFN void phase_scan(const Ctx& C0, int l, bool second = false) {
    const bool split = C0.ncu > N_SCAN;
    const bool xl = C0.ncu == 256; const bool is_scan = xl ? (C0.cu & 31) < 6 : (C0.cu < N_SCAN || !split);
    if (is_scan && (!second || DBL == 8 || DBL == 9)) { const Ctx C = relaunder(C0);
        if (xl) gdn_scan_unit(C, l, (C.cu >> 5) + 8 * (C.cu & 31)); else for (int u = C.cu; u < N_SCAN; u += C.ncu) gdn_scan_unit(C, l, u); }
    if ((xl ? !is_scan : (C0.cu >= N_SCAN || !split)) && (!second || DBL == 8 || DBL == 10)) { unsigned* qw = (unsigned*)(C0.wsp + WS_CTL) + CW_QUEUE + (l * 2 + (second ? 1 : 0)) * 4 * 64;
        QUEUE_LOOP(qw, N_ATTS, attn_sample_b(C, l, it));
        QUEUE_LOOP(qw + 64, N_GS, gdn_sample_item(C, l, it * 8 + C.wave, (LDSQ float*)(C.lds + C.wave * 512)));
        QUEUE_LOOP(qw + 128, N_CONVA, conv_a_item(C, l, it));
        QUEUE_LOOP(qw + 192, N_MERGE, merge_item(C, it)); }
}
constexpr int SG_A = 0  , SG_B = 18432  ;
struct SEpiU { bf16_t* U;
    DEVMFN void operator()(int row, int col, f32x4 v) const { *(u32x2*)(U + (size_t)(M_P + row) * NU + col) = pack4(v); } };
struct SEpiRes { const float* base; float* X; const float* gate0;
    DEVMFN void operator()(int row, int col, f32x4 v) const { const f32x4 bv = *(const f32x4*)(base + (size_t)row * 1024 + col), gv = *(const f32x4*)(gate0 + (size_t)(NBP + (row >> 2)) * NMOD + col);
        *(f32x4*)(X + (size_t)(M_P + row) * 1024 + col) = bv + (gv + 1.0f) * v; } };
template <class Epi> DEVFN void sgemm_unit(const Ctx& C, const bf16_t* A, const bf16_t* Bt, int tm, int tn, const Epi& E) {
    const int lane = C.lane, quad = lane >> 4, l15 = lane & 15, w = C.wave, wm = w & 1, wn = w >> 1;
    const int lr = C.tid >> 3, c8 = (C.tid & 7) * 8;
    const bf16_t* ga = A + (size_t)(64 * tm + lr) * 1024 + c8; const bf16_t* gb0 = Bt + (size_t)(128 * tn + lr) * 1024 + c8; const bf16_t* gb1 = gb0 + (size_t)64 * 1024;
    LDSQ bf16_t* As = (LDSQ bf16_t*)(C.lds + SG_A); LDSQ bf16_t* Bs = (LDSQ bf16_t*)(C.lds + SG_B);
    f32x4 acc[2][2];
#pragma unroll
    for (int mi = 0; mi < 2; ++mi)
#pragma unroll
        for (int ni = 0; ni < 2; ++ni) acc[mi][ni] = (f32x4){0.f, 0.f, 0.f, 0.f};
    u32x4 ra = *(const u32x4*)ga, rb0 = *(const u32x4*)gb0, rb1 = *(const u32x4*)gb1;
    *(LDSQ u32x4*)(As + lr * LDP + c8) = ra; *(LDSQ u32x4*)(Bs + lr * LDP + c8) = rb0; *(LDSQ u32x4*)(Bs + (64 + lr) * LDP + c8) = rb1;
    ra = *(const u32x4*)(ga + 64); rb0 = *(const u32x4*)(gb0 + 64); rb1 = *(const u32x4*)(gb1 + 64);
    SYNC();
#pragma unroll 1
    for (int c = 0; c < 16; ++c) {
        LDSQ bf16_t* Ac = As + (c & 1) * 4608; LDSQ bf16_t* Bc = Bs + (c & 1) * 9216;
        if (c + 1 < 16) { LDSQ bf16_t* An = As + ((c + 1) & 1) * 4608; LDSQ bf16_t* Bn = Bs + ((c + 1) & 1) * 9216;
            *(LDSQ u32x4*)(An + lr * LDP + c8) = ra; *(LDSQ u32x4*)(Bn + lr * LDP + c8) = rb0; *(LDSQ u32x4*)(Bn + (64 + lr) * LDP + c8) = rb1; }
        if (c + 2 < 16) { ra = *(const u32x4*)(ga + 64 * (c + 2)); rb0 = *(const u32x4*)(gb0 + 64 * (c + 2)); rb1 = *(const u32x4*)(gb1 + 64 * (c + 2)); }
#pragma unroll
        for (int s = 0; s < 2; ++s) { bf16x8 af[2], bfr[2];
#pragma unroll
            for (int mi = 0; mi < 2; ++mi) af[mi] = lds_frag(Ac, LDP, 32 * wm + 16 * mi + l15, 32 * s + 8 * quad);
#pragma unroll
            for (int ni = 0; ni < 2; ++ni) bfr[ni] = lds_frag(Bc, LDP, 32 * wn + 16 * ni + l15, 32 * s + 8 * quad);
#pragma unroll
            for (int mi = 0; mi < 2; ++mi)
#pragma unroll
                for (int ni = 0; ni < 2; ++ni) acc[mi][ni] = mfma16(bfr[ni], af[mi], acc[mi][ni]); }
        SYNC();
    }
#pragma unroll
    for (int mi = 0; mi < 2; ++mi)
#pragma unroll
        for (int ni = 0; ni < 2; ++ni) E(64 * tm + 32 * wm + 16 * mi + l15, 128 * tn + 32 * wn + 16 * ni + 4 * quad, acc[mi][ni]);
}
constexpr int NWAVES = 8;
constexpr int RING_BYTES = LDS_MISC, MISC_OFF = RING_BYTES + 320, LDS_BYTES = 159744;
constexpr int CW_BAR = 4096;
#ifndef DBL
#define DBL 0
#endif
#define GRID_BAR() xcd_barrier(bar)

__device__ __forceinline__ Ctx fresh_ctx(const Args* ap, LDSQ unsigned char* lds) {
    Ctx C; int tid = threadIdx.x; asm volatile("" : "+v"(tid));
    C.tid = tid; C.lane = tid & 63; C.wave = __builtin_amdgcn_readfirstlane(tid >> 6);
    C.ncu = gridDim.x; { const int bx = blockIdx.x; C.cu = (C.ncu % 8 == 0) ? (bx % 8) * (C.ncu / 8) + bx / 8 : bx; }
    C.lds = lds; C.a = ap; return C;
}
template <int L> __device__ __forceinline__ void layer_body(const Args* ap, LDSQ unsigned char* lds, const XcdBarrier& bar) {
        { const Ctx C = fresh_ctx(ap, lds); phase_norm(C, L); }
#if DBL == 1
        GRID_BAR(); { const Ctx C = fresh_ctx(ap, lds); phase_norm(C, L); }
#endif
        GRID_BAR();
        { const Ctx C = fresh_ctx(ap, lds);
            { const SEpiU SE{WSP(bf16_t, WS_U)};
                for (int u = C.cu; u < 256; u += C.ncu) sgemm_unit(C, WSP(bf16_t, WS_HN) + (size_t)M_P * 1024, WSP(bf16_t, WS_WIN) + (size_t)L * 4096 * 1024, u & 7, u >> 3, SE); }
            pg8::Gemm g{WSP(bf16_t, WS_HN), WSP(bf16_t, WS_WIN) + (size_t)L * 4096 * 1024, M_P, NU, 1024}; pg8::StaticOrder S; S.init(M_P, NU, C.ncu, (int)blockIdx.x);
            pg8::EpiU E{WSP(bf16_t, WS_U), NU};
            pg8::gemm_phase<pg8::EpiU, pg8::StaticOrder, true, true>(C.lds, g, S, E);
#if DBL == 2
            GRID_BAR(); pg8::gemm_phase<pg8::EpiU, pg8::StaticOrder, true, true>(C.lds, g, S, E);
#endif
        }
        GRID_BAR();
        { const Ctx C = fresh_ctx(ap, lds); phase_mid(C, L); }
#if DBL >= 3 && DBL <= 7
        GRID_BAR(); { const Ctx C = fresh_ctx(ap, lds); phase_mid(C, L, true); }
#endif
        GRID_BAR();
        { const Ctx C = fresh_ctx(ap, lds); phase_scan(C, L); }
#if DBL >= 8 && DBL <= 10
        GRID_BAR(); { const Ctx C = fresh_ctx(ap, lds); phase_scan(C, L, true); }
#endif
        GRID_BAR();
        { const Ctx C = fresh_ctx(ap, lds);
            const float* X = WSP(float, WS_X);
            { const SEpiRes SE{L == 0 ? C.x_sample : X + (size_t)M_P * 1024, WSP(float, WS_X), WSP(float, WS_MOD) + L * 3072 + 2048};
                for (int u = C.ncu - 1 - C.cu; u < 64; u += C.ncu) sgemm_unit(C, WSP(bf16_t, WS_MIX) + (size_t)M_P * 1024, WSP(bf16_t, WS_WOUT) + (size_t)L * 1024 * 1024, u & 7, u >> 3, SE); }
            pg8::Gemm g{WSP(bf16_t, WS_MIX), WSP(bf16_t, WS_WOUT) + (size_t)L * 1024 * 1024, M_P, 1024, 1024}; pg8::StaticOrder S; S.init(M_P, 1024, C.ncu, (int)blockIdx.x);
            pg8::EpiRes E{L == 0 ? C.x_prompt : X, L == 0 ? C.x_sample : X + (size_t)M_P * 1024, WSP(float, WS_X), WSP(float, WS_MOD) + L * 3072 + 2048};
#if DBL == 13
            { pg8::EpiRes E2 = E; E2.X = WSP(float, WS_U); pg8::gemm_phase<pg8::EpiRes, pg8::StaticOrder, true, true>(C.lds, g, S, E2); GRID_BAR(); }
#endif
            pg8::gemm_phase<pg8::EpiRes, pg8::StaticOrder, true, true>(C.lds, g, S, E);
        }
        GRID_BAR();
    }

__global__ void __launch_bounds__(NWAVES * 64, 2) mega_fwd(Args args) {
    extern __shared__ __attribute__((aligned(16))) unsigned char lds_raw[];
    Ctx C;
    C.lds = (LDSQ unsigned char*)lds_raw;
    C.tid = threadIdx.x; C.lane = C.tid & 63; C.wave = __builtin_amdgcn_readfirstlane(C.tid >> 6);
    C.ncu = gridDim.x; { const int bx = blockIdx.x; C.cu = (C.ncu % 8 == 0) ? (bx % 8) * (C.ncu / 8) + bx / 8 : bx; }
    C.a = &args;
    volatile LDSQ unsigned* MISC = (volatile LDSQ unsigned*)(C.lds + MISC_OFF);
    for (int u = C.tid; u < (LDS_BYTES - RING_BYTES) / 4; u += NWAVES * 64) ((LDSQ unsigned*)(C.lds + RING_BYTES))[u] = 0u;
    __syncthreads();
    unsigned* ctl = (unsigned*)(C.wsp + WS_CTL);
    XcdBarrier bar = xcd_barrier_post(ctl + CW_BAR, MISC + 8);

    phase_p0a(C);
#if DBL == 11
    GRID_BAR(); phase_p0a(C);
#endif
    GRID_BAR();
    {
        pg8::Gemm g{WSP(bf16_t, WS_CB), WSP(bf16_t, WS_WADA), 256, NMOD, 1024}; pg8::StaticOrder S; S.init(256, NMOD, C.ncu, (int)blockIdx.x);
        pg8::EpiMod E{WSP(float, WS_MOD), C.b_ada, C.b_ada_final};
        pg8::gemm_phase<pg8::EpiMod, pg8::StaticOrder, false, true>(C.lds, g, S, E);
#if DBL == 12
        GRID_BAR(); pg8::gemm_phase<pg8::EpiMod, pg8::StaticOrder, false, true>(C.lds, g, S, E);
#endif
    }
    GRID_BAR();
    layer_body<0>(&args, C.lds, bar); layer_body<1>(&args, C.lds, bar); layer_body<2>(&args, C.lds, bar); layer_body<3>(&args, C.lds, bar);
    { const Ctx C2 = fresh_ctx(&args, C.lds); phase_final(C2); }
#if DBL == 14
    { const Ctx C2 = fresh_ctx(&args, C.lds); phase_final(C2); }
#endif
}

extern "C" void kernel_launch(void* const* d_in, const int* in_sizes, int n_in, void* d_out, int out_size, void* d_ws, size_t ws_size, hipStream_t stream) {
    static int grid = 0;
    if (grid == 0) {
        if (n_in != 23 || out_size != (int)O_END || ws_size < WS_END) { fprintf(stderr, "kernel_launch: unexpected shapes: n_in %d out %d ws %zu\n", n_in, out_size, ws_size); grid = -1; return; }
        int dev = 0, cus = 0, per_cu = 0;
        if (hipGetDevice(&dev) != hipSuccess || hipDeviceGetAttribute(&cus, hipDeviceAttributeMultiprocessorCount, dev) != hipSuccess) { grid = -1; return; }
        if (hipFuncSetAttribute((const void*)mega_fwd, hipFuncAttributeMaxDynamicSharedMemorySize, LDS_BYTES) != hipSuccess) { fprintf(stderr, "kernel_launch: hipFuncSetAttribute failed\n"); grid = -1; return; }
        if (hipOccupancyMaxActiveBlocksPerMultiprocessor(&per_cu, (const void*)mega_fwd, NWAVES * 64, LDS_BYTES) != hipSuccess || per_cu < 1) { fprintf(stderr, "kernel_launch: occupancy query says %d\n", per_cu); }
        (void)hipGetLastError();
        grid = cus;
    }
    if (grid < 0) return;
    if (hipMemsetAsync((char*)d_ws + WS_CTL, 0, CTL_ZERO_BYTES, stream) != hipSuccess) return;
    Args ha{};
    for (int i = 0; i < 23; ++i) ha.in[i] = (const float*)d_in[i];
    ha.out_ = (float*)d_out; ha.ws_ = (unsigned char*)d_ws;
    hipLaunchKernelGGL(mega_fwd, dim3(grid), dim3(NWAVES * 64), LDS_BYTES, stream, ha);
}
```

```cpp
#include <hip/hip_runtime.h>
#include <cstdio>
#include <cstdint>
namespace pg8 {
#define PG8_LAS __attribute__((address_space(3)))
typedef unsigned short bf16_t;
typedef short bf16x8 __attribute__((ext_vector_type(8)));
typedef float f32x4 __attribute__((ext_vector_type(4)));
typedef unsigned u32x4 __attribute__((ext_vector_type(4)));
constexpr int BM = 256, BK = 64, HALF = 128, HTB = HALF * BK * 2  , STAGE_BYTES = 8 * HTB, NXCD = 8, WGM = 8;

__host__ __device__ __forceinline__ int lds_byte(int r, int c) { const int st = (r >> 4) * 2 + (c >> 5), rr = r & 15, cc = c & 31, ob = rr * 64 + cc * 2; return st * 1024 + (ob ^ (((ob >> 9) & 1) << 5)); }
__host__ __device__ __forceinline__ void stage_rc(int b, int& R, int& C) { const int st = b / 1024, sb = b % 1024, swz = sb ^ (((sb >> 9) & 1) << 5); R = (st >> 1) * 16 + swz / 64; C = (st & 1) * 32 + (swz % 64) / 2; }
__host__ __device__ __forceinline__ int perm32(int rho) { const int n = rho >> 4, i = rho & 15; return 8 * (i >> 2) + 4 * n + (i & 3); }

struct Unit { int pm, pn; };
struct Gemm { const bf16_t* A; const bf16_t* Bt; int M, N, K; };

struct StaticOrder {
    int nM, nN, nwg, G, c;
    __host__ __device__ void init(int M, int N, int G_, int c_) { nM = M / BM; nN = N / BM; nwg = nM * nN; G = G_; c = c_; }
    __host__ __device__ bool next(int i, Unit& u) const {
        const long L = (long)i * G + c; if (L >= nwg) return false;
        int wgid = (int)L; { const int q = nwg / NXCD, r = nwg % NXCD, xcd = wgid % NXCD, off = wgid / NXCD; wgid = (xcd < r ? xcd * (q + 1) : r * (q + 1) + (xcd - r) * q) + off; }
        const int nig = WGM * nN, gid = wgid / nig, fm = gid * WGM, gsz = (nM - fm) < WGM ? (nM - fm) : WGM;
        u.pm = fm + ((wgid % nig) % gsz); u.pn = (wgid % nig) / gsz; return true;
    }
    __device__ __forceinline__ void a_ready(const Unit&) const {}
    __device__ __forceinline__ void done(const Unit&) const {}
};

__device__ __forceinline__ unsigned cvt_pk_bf16(float lo, float hi) { unsigned r; asm volatile("v_cvt_pk_bf16_f32 %0, %1, %2" : "=v"(r) : "v"(lo), "v"(hi)); return r; }
template <class Epi, class Sched, bool ALIGN_EPI = false, bool SP2 = false>
__device__ __forceinline__ void gemm_phase(PG8_LAS unsigned char* lds, const Gemm g, const Sched& S, const Epi& E) {
    int tid_ = threadIdx.x; asm volatile("" : "+v"(tid_));
    const int tid = tid_, wid = __builtin_amdgcn_readfirstlane(tid >> 6), lane = tid & 63, wr = wid >> 2, wc = wid & 3, fr = lane & 15, fq = lane >> 4;
    const int K = g.K, nt = K / BK;
    unsigned voffA[2], voffB[2];
#pragma unroll
    for (int i = 0; i < 2; ++i) { int R, C; stage_rc(tid * 16 + i * 8192, R, C); const int Rb = Epi::PERM ? ((R & ~31) + perm32(R & 31)) : R;
        voffA[i] = (unsigned)(R * K + C) * 2u; voffB[i] = (unsigned)(Rb * K + C) * 2u; }
    const size_t kstep = (size_t)(BK * 2);
    const size_t hstep = (size_t)HALF * K * 2;
    const size_t tstep = 2 * hstep;
    const unsigned ldsw = (unsigned)wid * 1024u;
    const int aoff = lds_byte(wr * 64 + fr, fq * 8), boff = lds_byte(wc * 32 + fr, fq * 8);
#define PG8_SA(b, h) (((b) * 2 + (h)) * HTB)
#define PG8_SB(b, h) ((4 + (b) * 2 + (h)) * HTB)
#define PG8_STAGE(bufoff, gbase, voff) do { _Pragma("unroll") for (int _i = 0; _i < 2; ++_i) \
        __builtin_amdgcn_global_load_lds((const unsigned*)((const char*)(gbase) + (voff)[_i]), (PG8_LAS unsigned*)(lds + (bufoff) + ldsw + _i * 8192), 16, 0, 0); } while (0)
#define PG8_LDA(dst, b, h) do { _Pragma("unroll") for (int m = 0; m < 4; ++m) _Pragma("unroll") for (int k = 0; k < 2; ++k) dst[m][k] = *(const PG8_LAS bf16x8*)(lds + PG8_SA(b, h) + aoff + m * 2048 + k * 1024); } while (0)
#define PG8_LDB(dst, b, h) do { _Pragma("unroll") for (int n = 0; n < 2; ++n) _Pragma("unroll") for (int k = 0; k < 2; ++k) dst[n][k] = *(const PG8_LAS bf16x8*)(lds + PG8_SB(b, h) + boff + n * 2048 + k * 1024); } while (0)
#define PG8_MMA(ai, bj, At, Bt) do { __builtin_amdgcn_s_setprio(1); _Pragma("unroll") for (int m = 0; m < 4; ++m) _Pragma("unroll") for (int n = 0; n < 2; ++n) _Pragma("unroll") for (int k = 0; k < 2; ++k) \
        acc[ai][bj][m][n] = __builtin_amdgcn_mfma_f32_16x16x32_bf16(Bt[n][k], At[m][k], acc[ai][bj][m][n], 0, 0, 0); __builtin_amdgcn_s_setprio(0); } while (0)
#define PG8_WAIT_V(n) asm volatile("s_waitcnt vmcnt(" #n ")" ::: "memory")
#define PG8_WAIT_L(n) asm volatile("s_waitcnt lgkmcnt(" #n ")" ::: "memory")
#define PG8_BAR __builtin_amdgcn_s_barrier()
#define PG8_SCHED __builtin_amdgcn_sched_barrier(0)
    Unit cur, nxt; int ui = 0;
    if (!S.next(0, cur)) return;
    f32x4 acc[2][2][4][2];
#pragma unroll
    for (int a = 0; a < 2; ++a)
#pragma unroll
        for (int b = 0; b < 2; ++b)
#pragma unroll
            for (int m = 0; m < 4; ++m)
#pragma unroll
                for (int n = 0; n < 2; ++n) acc[a][b][m][n] = (f32x4){0.f, 0.f, 0.f, 0.f};
    bf16x8 At[4][2], B0[2][2], B1[2][2];
    const char* cA = (const char*)g.A + (size_t)cur.pm * tstep; const char* cB = (const char*)g.Bt + (size_t)cur.pn * tstep;
    S.a_ready(cur);
    if constexpr (SP2) {
        PG8_STAGE(PG8_SB(0, 0), cB, voffB); PG8_STAGE(PG8_SB(0, 1), cB + hstep, voffB); PG8_STAGE(PG8_SA(0, 0), cA, voffA); PG8_STAGE(PG8_SA(0, 1), cA + hstep, voffA);
        if (wr == 1) PG8_BAR;
        PG8_WAIT_V(2); PG8_BAR;
        PG8_STAGE(PG8_SB(1, 0), cB + kstep, voffB); PG8_STAGE(PG8_SA(1, 0), cA + kstep, voffA); PG8_STAGE(PG8_SB(1, 1), cB + hstep + kstep, voffB);
        PG8_WAIT_V(6); PG8_BAR;
    } else {
        PG8_STAGE(PG8_SB(0, 0), cB, voffB); PG8_STAGE(PG8_SA(0, 0), cA, voffA); PG8_STAGE(PG8_SB(0, 1), cB + hstep, voffB); PG8_STAGE(PG8_SA(0, 1), cA + hstep, voffA);
        if (wr == 1) PG8_BAR;
        PG8_WAIT_V(4); PG8_BAR;
        PG8_STAGE(PG8_SB(1, 0), cB + kstep, voffB); PG8_STAGE(PG8_SA(1, 0), cA + kstep, voffA); PG8_STAGE(PG8_SB(1, 1), cB + hstep + kstep, voffB);
        PG8_WAIT_V(6); PG8_BAR;
    }
    for (;;) {
        const bool has_next = S.next(ui + 1, nxt);
        const char* nA = has_next ? (const char*)g.A + (size_t)nxt.pm * tstep : cA; const char* nB = has_next ? (const char*)g.Bt + (size_t)nxt.pn * tstep : cB;
        for (int t = 0; t < nt; t += 2) {
            const bool last = (t == nt - 2);
            const char* a1 = cA + (size_t)(t + 1) * kstep;
            const char* a2 = last ? nA : cA + (size_t)(t + 2) * kstep; const char* b2 = last ? nB : cB + (size_t)(t + 2) * kstep;
            const char* a3 = a2 + kstep; const char* b3 = b2 + kstep;
            if (last && has_next) S.a_ready(nxt);
            if constexpr (SP2) {
            PG8_LDB(B0, 0, 0); PG8_LDB(B1, 0, 1); PG8_SCHED; PG8_LDA(At, 0, 0); PG8_STAGE(PG8_SA(1, 1), a1 + hstep, voffA);
            PG8_WAIT_V(8); PG8_WAIT_L(0); PG8_BAR; PG8_MMA(0, 0, At, B0); PG8_MMA(0, 1, At, B1); PG8_BAR; PG8_SCHED;
            PG8_LDA(At, 0, 1); PG8_STAGE(PG8_SB(0, 0), b2, voffB); PG8_STAGE(PG8_SB(0, 1), b2 + hstep, voffB); PG8_STAGE(PG8_SA(0, 0), a2, voffA);
            PG8_WAIT_V(8); PG8_WAIT_L(0); PG8_BAR; PG8_MMA(1, 0, At, B0); PG8_MMA(1, 1, At, B1); PG8_BAR; PG8_SCHED;
            PG8_LDB(B0, 1, 0); PG8_LDB(B1, 1, 1); PG8_SCHED; PG8_LDA(At, 1, 0); PG8_STAGE(PG8_SA(0, 1), a2 + hstep, voffA);
            PG8_WAIT_V(8); PG8_WAIT_L(0); PG8_BAR; PG8_MMA(0, 0, At, B0); PG8_MMA(0, 1, At, B1); PG8_BAR; PG8_SCHED;
            PG8_LDA(At, 1, 1); PG8_STAGE(PG8_SB(1, 0), b3, voffB); PG8_STAGE(PG8_SB(1, 1), b3 + hstep, voffB); PG8_STAGE(PG8_SA(1, 0), a3, voffA);
            PG8_WAIT_V(8); PG8_WAIT_L(0); PG8_BAR; PG8_MMA(1, 0, At, B0); PG8_MMA(1, 1, At, B1); PG8_BAR; PG8_SCHED;
            } else {
            PG8_LDB(B0, 0, 0); PG8_SCHED; PG8_LDA(At, 0, 0); PG8_STAGE(PG8_SA(1, 1), a1 + hstep, voffA);
            PG8_WAIT_L(8); PG8_BAR; PG8_WAIT_L(0); PG8_MMA(0, 0, At, B0); PG8_BAR; PG8_SCHED;
            PG8_LDB(B1, 0, 1); PG8_STAGE(PG8_SB(0, 0), b2, voffB);
            PG8_BAR; PG8_WAIT_L(0); PG8_MMA(0, 1, At, B1); PG8_BAR;
            PG8_LDA(At, 0, 1); PG8_STAGE(PG8_SA(0, 0), a2, voffA);
            PG8_BAR; PG8_WAIT_L(0); PG8_MMA(1, 0, At, B0); PG8_BAR; PG8_SCHED;
            PG8_STAGE(PG8_SB(0, 1), b2 + hstep, voffB);
            PG8_WAIT_V(6); PG8_BAR; PG8_MMA(1, 1, At, B1); PG8_BAR;
            PG8_LDB(B0, 1, 0); PG8_SCHED; PG8_LDA(At, 1, 0); PG8_STAGE(PG8_SA(0, 1), a2 + hstep, voffA);
            PG8_WAIT_L(8); PG8_BAR; PG8_WAIT_L(0); PG8_MMA(0, 0, At, B0); PG8_BAR; PG8_SCHED;
            PG8_LDB(B1, 1, 1); PG8_STAGE(PG8_SB(1, 0), b3, voffB);
            PG8_BAR; PG8_WAIT_L(0); PG8_MMA(0, 1, At, B1); PG8_BAR;
            PG8_LDA(At, 1, 1); PG8_STAGE(PG8_SA(1, 0), a3, voffA);
            PG8_BAR; PG8_WAIT_L(0); PG8_MMA(1, 0, At, B0); PG8_BAR; PG8_SCHED;
            PG8_STAGE(PG8_SB(1, 1), b3 + hstep, voffB);
            PG8_WAIT_V(6); PG8_BAR; PG8_MMA(1, 1, At, B1); PG8_BAR;
            }
        }
        if constexpr (ALIGN_EPI) { if (wr == 0) PG8_BAR; }
        if constexpr (!Epi::AFTER_DRAIN) { E(acc, cur, wr, wc, fr, fq); S.done(cur); }
        if (!has_next) break;
#pragma unroll
        for (int a = 0; a < 2; ++a)
#pragma unroll
            for (int b = 0; b < 2; ++b)
#pragma unroll
                for (int m = 0; m < 4; ++m)
#pragma unroll
                    for (int n = 0; n < 2; ++n) acc[a][b][m][n] = (f32x4){0.f, 0.f, 0.f, 0.f};
        cur = nxt; cA = nA; cB = nB; ++ui;
        if constexpr (ALIGN_EPI) { if (wr == 1) PG8_BAR; }
    }
    PG8_WAIT_V(0);
    if constexpr (!ALIGN_EPI) { if (wr == 0) PG8_BAR; }
    PG8_BAR;
    if constexpr (Epi::AFTER_DRAIN) { E.fused(acc, cur, wr, wc, fr, fq, lds, wid, lane); S.done(cur); }
#undef PG8_SA
#undef PG8_SB
#undef PG8_STAGE
#undef PG8_LDA
#undef PG8_LDB
#undef PG8_MMA
#undef PG8_WAIT_V
#undef PG8_WAIT_L
#undef PG8_BAR
#undef PG8_SCHED
}
}
namespace pg8 {
struct EpiU { static constexpr bool PERM = true, AFTER_DRAIN = false; bf16_t* O; int ldc;
    __device__ __forceinline__ void operator()(const f32x4 (&acc)[2][2][4][2], const Unit& u, int wr, int wc, int fr, int fq) const {
        const int row0 = u.pm * BM + wr * 64 + fr, col0 = u.pn * BM + wc * 32 + 8 * fq;
#pragma unroll
        for (int ai = 0; ai < 2; ++ai)
#pragma unroll
            for (int m = 0; m < 4; ++m) { bf16_t* rowp = O + (size_t)(row0 + ai * HALF + m * 16) * ldc + col0;
#pragma unroll
                for (int bj = 0; bj < 2; ++bj) { const f32x4 v0 = acc[ai][bj][m][0], v1 = acc[ai][bj][m][1];
                    u32x4 w; w.x = cvt_pk_bf16(v0[0], v0[1]); w.y = cvt_pk_bf16(v0[2], v0[3]); w.z = cvt_pk_bf16(v1[0], v1[1]); w.w = cvt_pk_bf16(v1[2], v1[3]);
                    *(u32x4*)(rowp + bj * HALF) = w; } }
    }
};
struct EpiMod { static constexpr bool PERM = false, AFTER_DRAIN = false; float* O; const float* b_ada; const float* b_fin;
    __device__ __forceinline__ void operator()(const f32x4 (&acc)[2][2][4][2], const Unit& u, int wr, int wc, int fr, int fq) const {
        const int colt = u.pn * BM; const float* bias = colt < 12288 ? b_ada + colt : b_fin + (colt - 12288);
        const int cl = wc * 32 + 4 * fq;
#pragma unroll
        for (int ai = 0; ai < 2; ++ai)
#pragma unroll
            for (int m = 0; m < 4; ++m) { const int row = ai * HALF + wr * 64 + m * 16 + fr;
                if (row < 136) {
#pragma unroll
                    for (int bj = 0; bj < 2; ++bj)
#pragma unroll
                        for (int n = 0; n < 2; ++n) { const int c = cl + bj * HALF + n * 16; const f32x4 bv = *(const f32x4*)(bias + c);
                            *(f32x4*)(O + (size_t)row * 14336 + colt + c) = acc[ai][bj][m][n] + bv; } } }
    }
};
struct EpiRes { static constexpr bool PERM = false, AFTER_DRAIN = false; const float* base_p; const float* base_s; float* X; const float* gate0;
    __device__ __forceinline__ void operator()(const f32x4 (&acc)[2][2][4][2], const Unit& u, int wr, int wc, int fr, int fq) const {
        const int cl = u.pn * BM + wc * 32 + 4 * fq;
#pragma unroll
        for (int ai = 0; ai < 2; ++ai)
#pragma unroll
            for (int m = 0; m < 4; ++m) { const int row = u.pm * BM + ai * HALF + wr * 64 + m * 16 + fr;
                const float* b = row < 16384 ? base_p + (size_t)row * 1024 : base_s + (size_t)(row - 16384) * 1024;
                const int brow = row < 16384 ? (row >> 11) : 8 + ((row - 16384) >> 2);
                const float* g = gate0 + (size_t)brow * 14336; float* o = X + (size_t)row * 1024;
#pragma unroll
                for (int bj = 0; bj < 2; ++bj)
#pragma unroll
                    for (int n = 0; n < 2; ++n) { const int c = cl + bj * HALF + n * 16; const f32x4 bv = *(const f32x4*)(b + c), gv = *(const f32x4*)(g + c);
                        *(f32x4*)(o + c) = bv + (gv + 1.0f) * acc[ai][bj][m][n]; } }
    }
};
}
using pg8::bf16_t; using pg8::bf16x8; using pg8::f32x4; using pg8::u32x4;
#ifdef HOST_EMU
#define DEVFN static inline
#define DEVMFN inline
#define LDSQ
#define GASQ
#else
#define DEVFN __device__ __forceinline__
#define DEVMFN __device__ __forceinline__
#define LDSQ __attribute__((address_space(3)))
#define GASQ __attribute__((address_space(1)))
#endif
typedef short s16x4 __attribute__((ext_vector_type(4)));
typedef float f32x2 __attribute__((ext_vector_type(2)));
typedef unsigned u32x2 __attribute__((ext_vector_type(2)));

constexpr int D_MODEL = 1024, SEQ = 2048, NBP = 8, NBS = 128, DSEQ = 4, DEPTH = 4;
constexpr int M_P = NBP * SEQ, M_S = NBS * DSEQ, M_T = M_P + M_S;
constexpr int IN_W = 4108, NU = 4096, NBROW = NBP + NBS;
constexpr int NMOD = 4 * 3072 + 2048;
constexpr int UC_AX = 0, UC_ACG = 256, UC_ABG = 512, UC_AZ = 768, UC_BQ = 1024, UC_BK = 1408, UC_BV = 1792, UC_BZ = 2176, UC_CQ = 2560, UC_CK = 2944, UC_CV = 3328, UC_CZ = 3712;
constexpr size_t MiB = 1u << 20;
constexpr size_t WS_CTL = 0, CTL_ZERO_BYTES = 1 * MiB;
constexpr size_t WS_WIN = 2 * MiB;
constexpr size_t WS_WOUT = 34 * MiB;
constexpr size_t WS_WADA = 42 * MiB;
constexpr size_t WS_WAB = 70 * MiB;
constexpr size_t WS_ROPE = 71 * MiB;
constexpr size_t WS_CB = 72 * MiB;
constexpr size_t WS_MOD = 73 * MiB;
constexpr size_t WS_AB = 82 * MiB;
constexpr size_t WS_LSE = 84 * MiB;
constexpr size_t WS_GSC = 86 * MiB;
constexpr size_t WS_X = 96 * MiB;
constexpr size_t WS_HN = 162 * MiB;
constexpr size_t WS_MIX = 196 * MiB;
constexpr size_t WS_OC = 230 * MiB;
constexpr size_t WS_U = 256 * MiB;
constexpr size_t WS_GDN = 400 * MiB;
constexpr size_t GDN_CHUNK_BYTES = 40960;
constexpr size_t WS_END = 480 * MiB;
constexpr size_t O_YP = 0, O_YS = 16777216, O_CAP = 17301504, O_CAS = 17317888, O_CBP = 17580032, O_CBS = 17690624, O_GP = 19460096, O_GS = 20246528,
                 O_K128P = 32829440, O_K128S = 33878016, O_K512P = 34402304, O_K512S = 38596608, O_K2048P = 39120896, O_K2048S = 55898112, O_END = 56422400;

DEVFN float bf_lo(unsigned u) { return __builtin_bit_cast(float, u << 16); }
DEVFN float bf_hi(unsigned u) { return __builtin_bit_cast(float, u & 0xffff0000u); }
DEVFN float bf2f(bf16_t h) { return __builtin_bit_cast(float, (unsigned)h << 16); }
#ifdef HOST_EMU
DEVFN unsigned f2bf(float f) { unsigned u = __builtin_bit_cast(unsigned, f); return (u + 0x7fffu + ((u >> 16) & 1u)) >> 16; }
DEVFN unsigned pk2(float lo, float hi) { return f2bf(lo) | (f2bf(hi) << 16); }
DEVFN float EXPF(float x) { return expf(x); }
DEVFN float LOGF(float x) { return logf(x); }
DEVFN float RCPF(float x) { return 1.0f / x; }
DEVFN float RSQF(float x) { return 1.0f / sqrtf(x); }
#else
typedef __bf16 hwbf16x2 __attribute__((ext_vector_type(2)));
DEVFN unsigned pk2(float lo, float hi) { const f32x2 v = {lo, hi}; const hwbf16x2 b = __builtin_convertvector(v, hwbf16x2); return __builtin_bit_cast(unsigned, b); }
DEVFN unsigned f2bf(float f) { return pk2(f, 0.f) & 0xffffu; }
DEVFN float EXPF(float x) { return __builtin_amdgcn_exp2f(x * 1.4426950408889634f); }
DEVFN float LOGF(float x) { return __builtin_amdgcn_logf(x) * 0.6931471805599453f; }
DEVFN float RCPF(float x) { return __builtin_amdgcn_rcpf(x); }
DEVFN float RSQF(float x) { return __builtin_amdgcn_rsqf(x); }
#endif
DEVFN void unpack8(u32x4 v, float* f) { f[0] = bf_lo(v.x); f[1] = bf_hi(v.x); f[2] = bf_lo(v.y); f[3] = bf_hi(v.y); f[4] = bf_lo(v.z); f[5] = bf_hi(v.z); f[6] = bf_lo(v.w); f[7] = bf_hi(v.w); }
DEVFN u32x4 pack8(const float* f) { u32x4 v; v.x = pk2(f[0], f[1]); v.y = pk2(f[2], f[3]); v.z = pk2(f[4], f[5]); v.w = pk2(f[6], f[7]); return v; }
DEVFN float silu_f(float x) { return x * RCPF(1.f + EXPF(-x)); }
DEVFN float sigmoid_f(float x) { return RCPF(1.f + EXPF(-x)); }
DEVFN float softplus_f(float x) { return x > 20.f ? x : log1pf(expf(x)); }

struct Args { const float* in[23]; float* out_; unsigned char* ws_; };
struct Ctx {
    int tid, lane, wave, cu, ncu;
    LDSQ unsigned char* lds;
    const Args* a;
};
#define x_prompt a->in[0]
#define x_sample a->in[1]
#define st_conv_a a->in[2]
#define st_conv_b a->in[3]
#define st_gdn a->in[4]
#define kv128 a->in[5]
#define kv512 a->in[6]
#define kv2048 a->in[7]
#define c_prompt a->in[8]
#define c_sample a->in[9]
#define w_in a->in[10]
#define w_out a->in[11]
#define w_ada a->in[12]
#define b_ada a->in[13]
#define norm_w a->in[14]
#define conv_a_w a->in[15]
#define conv_b_w a->in[16]
#define a_log a->in[17]
#define dt_bias a->in[18]
#define gdn_norm_w a->in[19]
#define final_norm_w a->in[20]
#define w_ada_final a->in[21]
#define b_ada_final a->in[22]
#define outp a->out_
#define wsp a->ws_
constexpr int LDS_MISC = 158208;
constexpr int LDS_QIDX = LDS_MISC + 320 + 64;
constexpr int CW_QUEUE = 32768;
#define WSP(T, off) ((T*)(C.wsp + (off)))
#define LAS __attribute__((address_space(3)))
#define XB_TMO      128
#define XB_XCNT(j)  (256  + 64 * (j))
#define XB_XSUB(j)  (1280 + 64 * (j))
#define XB_XGEN(j)  (2304 + 64 * (j))
#define XB_TOP      3328
#define XB_TOPGEN   3392
#define XCD_BAR_WORDS 3456
#define XB_SPIN_CAP (1u << 18)

__device__ __forceinline__ unsigned xb_ld(unsigned* p)              { return __hip_atomic_load(p, __ATOMIC_RELAXED, __HIP_MEMORY_SCOPE_AGENT); }
__device__ __forceinline__ unsigned xb_add(unsigned* p, unsigned v) { return __hip_atomic_fetch_add(p, v, __ATOMIC_RELAXED, __HIP_MEMORY_SCOPE_AGENT); }
__device__ __forceinline__ unsigned xb_xcc_id() { return (unsigned)__builtin_amdgcn_s_getreg((3 << 11) | 20) & 0xFu; }
#define XB_SPIN(cond, bar) do { unsigned _sp = 0; while (cond) { __builtin_amdgcn_s_sleep(1); \
    if ((++_sp & 255u) == 0u) { if (xb_ld(&(bar)[XB_TMO])) break; if (_sp > XB_SPIN_CAP) { atomicAdd(&(bar)[XB_TMO], 1u); break; } } } } while (0)

struct XcdBarrier {
    unsigned* bar; unsigned x;
    volatile LAS unsigned* st;
};

__device__ __forceinline__ XcdBarrier xcd_barrier_post(unsigned* bar, volatile LAS unsigned* st) {
    XcdBarrier b; b.bar = bar; b.x = xb_xcc_id(); b.st = st;
    if (threadIdx.x == 0) (void)xb_add(&bar[XB_XCNT(b.x)], 1u);
    return b;
}
__device__ __forceinline__ void xcd_barrier_complete(unsigned* bar, unsigned x, unsigned& nloc, unsigned& nx) {
    const unsigned G = gridDim.x * gridDim.y * gridDim.z;
    unsigned sum, cnt, mine, sp = 0u;
    for (;;) {
        sum = 0u; cnt = 0u; mine = 0u;
#pragma unroll
        for (unsigned j = 0; j < 16; ++j) { const unsigned c = xb_ld(&bar[XB_XCNT(j)]); sum += c; cnt += (c > 0u) ? 1u : 0u; mine = (j == x) ? c : mine; }
        if (sum == G) break;
        __builtin_amdgcn_s_sleep(1);
        if ((++sp & 255u) == 0u) { if (xb_ld(&bar[XB_TMO])) break; if (sp > XB_SPIN_CAP) { atomicAdd(&bar[XB_TMO], 1u); break; } }
    }
    nloc = mine > 0u ? mine : 1u; nx = cnt > 0u ? cnt : 1u;
}

__device__ __forceinline__ void xcd_barrier(const XcdBarrier& b) {
    asm volatile("s_waitcnt vmcnt(0)" ::: "memory");
    __syncthreads();
    if (threadIdx.x == 0) {
        unsigned* bar = b.bar;
        __builtin_amdgcn_s_waitcnt(0);
        unsigned nloc = b.st[0], nx = b.st[1];
        if (nloc == 0u) { xcd_barrier_complete(bar, b.x, nloc, nx); b.st[0] = nloc; b.st[1] = nx; }
        const unsigned old = xb_add(&bar[XB_XSUB(b.x)], 1u);
        const unsigned gen = old / nloc;
        if (old + 1u == (gen + 1u) * nloc) {
            __builtin_amdgcn_fence(__ATOMIC_RELEASE, "agent");
            asm volatile("s_waitcnt vmcnt(0)" ::: "memory");
            const unsigned og = xb_add(&bar[XB_TOP], 1u);
            const unsigned tg = og / nx;
            if (og + 1u == (tg + 1u) * nx) xb_add(&bar[XB_TOPGEN], 1u);
            else XB_SPIN(xb_ld(&bar[XB_TOPGEN]) == tg, bar);
            __builtin_amdgcn_fence(__ATOMIC_ACQUIRE, "agent");
            xb_add(&bar[XB_XGEN(b.x)], 1u);
            asm volatile("s_waitcnt vmcnt(0)" ::: "memory");
        } else {
            XB_SPIN(xb_ld(&bar[XB_XGEN(b.x)]) == gen, bar);
            __builtin_amdgcn_fence(__ATOMIC_ACQUIRE, "agent");
            asm volatile("s_waitcnt vmcnt(0)" ::: "memory");
        }
    }
    __syncthreads();
}
#define SYNC() __syncthreads()
#define WAVE_LDS_FENCE() do { asm volatile("s_waitcnt lgkmcnt(0)" ::: "memory"); } while (0)
#define COMPILER_MEM_FENCE() asm volatile("" ::: "memory")
#define FAST_SIN(x) __sinf(x)
#define FAST_COS(x) __cosf(x)
DEVFN f32x4 mfma16(bf16x8 a, bf16x8 b, f32x4 c) { return __builtin_amdgcn_mfma_f32_16x16x32_bf16(a, b, c, 0, 0, 0); }
DEVFN float shfl_xor_f(float v, int m) { return __shfl_xor(v, m); }
DEVFN float shfl_f(float v, int src) { return __shfl(v, src); }
DEVFN float shfl_up_f(float v, int d) { return __shfl_up(v, d); }
DEVFN Ctx relaunder(const Ctx& C0) {
    Ctx C = C0; int tid = C0.tid; asm volatile("" : "+v"(tid)); C.tid = tid; C.lane = tid & 63; C.wave = __builtin_amdgcn_readfirstlane(tid >> 6); return C;
}
DEVFN float FMA_OP(float a, float b, float c) { float r; asm("v_fma_f32 %0, %1, %2, %3" : "=v"(r) : "v"(a), "v"(b), "v"(c)); return r; }
#define QUEUE_PULL(p) __hip_atomic_fetch_add((p), 1u, __ATOMIC_RELAXED, __HIP_MEMORY_SCOPE_AGENT)
#define VM_DRAIN() asm volatile("s_waitcnt vmcnt(0)" ::: "memory")
#define VM_WAIT_N(n) asm volatile("s_waitcnt vmcnt(" #n ")" ::: "memory")
#define RAW_SYNC() do { asm volatile("s_waitcnt lgkmcnt(0)" ::: "memory"); __builtin_amdgcn_s_barrier(); asm volatile("" ::: "memory"); } while (0)
#define DMA16(gptr, ldsbase, lane) __builtin_amdgcn_global_load_lds((const unsigned*)(gptr), (LDSQ unsigned*)(ldsbase), 16, 0, 0)
DEVFN bf16x8 lds_frag_a(const LDSQ bf16_t* base, int ld, int row, int col) { return *(const LDSQ bf16x8*)(base + row * ld + col); }
DEVFN u32x2 pack4(f32x4 v) { u32x2 o; o.x = pk2(v.x, v.y); o.y = pk2(v.z, v.w); return o; }
DEVFN float wave_sum(float v) {
#pragma unroll
    for (int o = 1; o < 64; o <<= 1) v += shfl_xor_f(v, o);
    return v;
}
DEVFN void p0_transpose_item(const float* W, int N, int nsrc0, bf16_t* WT, int ndst0, int k0, LDSQ float* scr, int lane) {
    float tv[32];
#pragma unroll
    for (int i = 0; i < 32; ++i) tv[i] = W[(size_t)(k0 + 2 * i + (lane >> 5)) * N + nsrc0 + (lane & 31)];
#pragma unroll
    for (int i = 0; i < 32; ++i) scr[(2 * i + (lane >> 5)) * 33 + (lane & 31)] = tv[i];
    WAVE_LDS_FENCE();
    const int c = lane & 7;
#pragma unroll
    for (int j = 0; j < 4; ++j) { const int n = (lane >> 3) + 8 * j; const LDSQ float* s = scr + (8 * c) * 33 + n;
        u32x4 o; o.x = pk2(s[0 * 33], s[1 * 33]); o.y = pk2(s[2 * 33], s[3 * 33]); o.z = pk2(s[4 * 33], s[5 * 33]); o.w = pk2(s[6 * 33], s[7 * 33]);
        *(u32x4*)(WT + (size_t)(ndst0 + n) * 1024 + k0 + 8 * c) = o; }
    WAVE_LDS_FENCE();
}
constexpr int ADA_LDC = 264;
DEVFN void adaln_group(const Ctx& C, int grp) {
    const int lane = C.lane, quad = lane >> 4, l15 = lane & 15, w = C.wave;
    LDSQ bf16_t* cl = (LDSQ bf16_t*)C.lds;
    const int n0 = 16 * (4 * grp + (w & 3));
    const bool fin = n0 >= 12288; const int li = n0 / 3072;
    const float* W = fin ? C.w_ada_final + (n0 - 12288) : C.w_ada + (size_t)li * 1024 * 3072 + (n0 - li * 3072); const int ldw = fin ? 2048 : 3072;
    f32x4 acc[9];
#pragma unroll
    for (int mt = 0; mt < 9; ++mt) acc[mt] = (f32x4){0.f, 0.f, 0.f, 0.f};
#pragma unroll 1
    for (int kq = 0; kq < 4; ++kq) {
        for (int i = C.tid; i < 144 * 32; i += 512) { const int row = i >> 5, c8 = (i & 31) * 8; float v[8];
            if (row < NBROW) { const float* src = (row < NBP ? C.c_prompt + (size_t)row * 1024 : C.c_sample + (size_t)(row - NBP) * 1024) + 256 * kq + c8;
                const f32x4 a = *(const f32x4*)src, bq = *(const f32x4*)(src + 4); v[0] = a.x; v[1] = a.y; v[2] = a.z; v[3] = a.w; v[4] = bq.x; v[5] = bq.y; v[6] = bq.z; v[7] = bq.w; }
            else {
#pragma unroll
                for (int e = 0; e < 8; ++e) v[e] = 0.f; }
            *(LDSQ u32x4*)(cl + row * ADA_LDC + c8) = pack8(v); }
        SYNC();
        if (w < 4) {
#pragma unroll 2
            for (int ss = 0; ss < 8; ++ss) { const int k0 = 256 * kq + 32 * ss + 8 * quad; float wv[8];
#pragma unroll
                for (int j = 0; j < 8; ++j) wv[j] = W[(size_t)(k0 + j) * ldw + l15];
                const bf16x8 bfr = __builtin_bit_cast(bf16x8, pack8(wv));
#pragma unroll
                for (int mt = 0; mt < 9; ++mt) acc[mt] = mfma16(lds_frag_a(cl, ADA_LDC, 16 * mt + l15, 32 * ss + 8 * quad), bfr, acc[mt]); } }
        SYNC();
    }
    if (w < 4) { const float bias = fin ? C.b_ada_final[n0 - 12288 + l15] : C.b_ada[n0 + l15]; float* MOD = WSP(float, WS_MOD);
#pragma unroll
        for (int mt = 0; mt < 9; ++mt)
#pragma unroll
            for (int r = 0; r < 4; ++r) { const int row = 16 * mt + 4 * quad + r; if (row < NBROW) MOD[(size_t)row * NMOD + n0 + l15] = acc[mt][r] + bias; } }
}
DEVFN void phase_p0a(const Ctx& C) {
    for (int g = C.cu; g < 224; g += C.ncu) adaln_group(C, g);
    LDSQ float* scr = (LDSQ float*)(C.lds + C.wave * 16384);
    const int gw = C.cu * 8 + C.wave, NGW = C.ncu * 8;
    bf16_t* WIN = WSP(bf16_t, WS_WIN); bf16_t* WOUT = WSP(bf16_t, WS_WOUT);
    constexpr int I_IN = 4 * 16 * 128, I_OUT = 4 * 16 * 32;
    for (int it = gw; it < I_IN + I_OUT; it += NGW) {
        int r = it;
        if (r < I_IN) { const int l = r / 2048, rr = r % 2048, kb = rr / 128, nb = rr % 128, nd = 32 * nb, ns = nd < 2560 ? nd : nd + 12;
            p0_transpose_item(C.w_in + (size_t)l * 1024 * IN_W, IN_W, ns, WIN + (size_t)l * 4096 * 1024, nd, 64 * kb, scr, C.lane); continue; }
        r -= I_IN;
        { const int l = r / 512, rr = r % 512, kb = rr / 32, nb = rr % 32;
            p0_transpose_item(C.w_out + (size_t)l * 1024 * 1024, 1024, 32 * nb, WOUT + (size_t)l * 1024 * 1024, 32 * nb, 64 * kb, scr, C.lane); }
    }
    const int gt = C.cu * 512 + C.tid, NGT = C.ncu * 512;
    bf16_t* WABT = WSP(bf16_t, WS_WAB);
    for (int i = gt; i < 4 * 16 * 1024; i += NGT) { const int l = i >> 14, j = (i >> 10) & 15, k = i & 1023; WABT[i] = (bf16_t)f2bf(j < 12 ? C.w_in[((size_t)l * 1024 + k) * IN_W + 2560 + j] : 0.f); }
    float* ROPE = WSP(float, WS_ROPE);
    for (int i = gt; i < 2052 * 8; i += NGT) { const int pos = i >> 3, j = i & 7;
        const float invf[8] = {1.0f, 0.1939227432012558f, 0.03760603070259094f, 0.007292664609849453f, 0.0014142135623842478f, 0.00027424818836152554f, 5.3182957344688475e-05f, 1.0313385246263351e-05f};
        float fr = 1.0f;
#pragma unroll
        for (int q = 0; q < 8; ++q) fr = (j == q) ? invf[q] : fr;
        const float ang = (float)pos * fr;
        const double a = (double)ang, tw = 6.283185307179586476925;
        const double kq = __builtin_floor(a / tw + 0.5); const float red = (float)(a - kq * tw);
        ROPE[pos * 16 + j] = FAST_COS(red); ROPE[pos * 16 + 8 + j] = FAST_SIN(red); }
}
DEVFN int brow_of(int m) { return m < M_P ? (m >> 11) : NBP + ((m - M_P) >> 2); }
DEVFN const float* xrow_l0(const Ctx& C, int m) { return m < M_P ? C.x_prompt + (size_t)m * 1024 : C.x_sample + (size_t)(m - M_P) * 1024; }
constexpr int NRM_LD = 1032;
DEVFN void phase_norm(const Ctx& C, int l) {
    const int gw = C.cu * 8 + C.wave, NGW = C.ncu * 8, lane = C.lane, quad = lane >> 4, l15 = lane & 15;
    const float* X = WSP(float, WS_X); bf16_t* HN = WSP(bf16_t, WS_HN); float* AB = WSP(float, WS_AB);
    const float* MOD = WSP(float, WS_MOD); const bf16_t* WABT = WSP(bf16_t, WS_WAB) + l * 16 * 1024;
    const f32x4* nw = (const f32x4*)(C.norm_w + l * 1024) + lane;
    LDSQ bf16_t* hl = (LDSQ bf16_t*)(C.lds + C.wave * (8 * NRM_LD * 2));
    for (int grp = gw; grp < M_T / 8; grp += NGW) {
        const int m0 = grp * 8;
        f32x4 gv[4], sv[4]; int cur = -1;
#pragma unroll 2
        for (int r = 0; r < 8; ++r) { const int m = m0 + r;
            const f32x4* xr = (const f32x4*)(l == 0 ? xrow_l0(C, m) : X + (size_t)m * 1024) + lane;
            f32x4 v[4]; float s = 0.f;
#pragma unroll
            for (int j = 0; j < 4; ++j) { v[j] = xr[64 * j]; s += (v[j].x * v[j].x + v[j].y * v[j].y) + (v[j].z * v[j].z + v[j].w * v[j].w); }
            const int br = brow_of(m);
            if (br != cur) { cur = br; const float* mod = MOD + (size_t)br * NMOD + l * 3072;
#pragma unroll
                for (int j = 0; j < 4; ++j) { sv[j] = ((const f32x4*)mod)[64 * j + lane]; gv[j] = nw[64 * j] * (((const f32x4*)(mod + 1024))[64 * j + lane] + 1.0f); } }
            const float rstd = RSQF(wave_sum(s) * (1.f / 1024.f) + 1e-6f);
            u32x2* o8 = (u32x2*)(HN + (size_t)m * 1024) + lane;
#pragma unroll
            for (int j = 0; j < 4; ++j) { const f32x4 y = v[j] * rstd * gv[j] + sv[j]; const u32x2 o = pack4(y); o8[64 * j] = o; *(LDSQ u32x2*)(hl + r * NRM_LD + 256 * j + 4 * lane) = o; } }
        WAVE_LDS_FENCE();
        f32x4 a0 = {0.f, 0.f, 0.f, 0.f}, a1 = a0, a2 = a0, a3 = a0;
#pragma unroll
        for (int s = 0; s < 32; s += 4) {
            a0 = mfma16(lds_frag_a(hl, NRM_LD, l15 & 7, 32 * s + 8 * quad), *(const bf16x8*)(WABT + l15 * 1024 + 32 * s + 8 * quad), a0);
            a1 = mfma16(lds_frag_a(hl, NRM_LD, l15 & 7, 32 * (s + 1) + 8 * quad), *(const bf16x8*)(WABT + l15 * 1024 + 32 * (s + 1) + 8 * quad), a1);
            a2 = mfma16(lds_frag_a(hl, NRM_LD, l15 & 7, 32 * (s + 2) + 8 * quad), *(const bf16x8*)(WABT + l15 * 1024 + 32 * (s + 2) + 8 * quad), a2);
            a3 = mfma16(lds_frag_a(hl, NRM_LD, l15 & 7, 32 * (s + 3) + 8 * quad), *(const bf16x8*)(WABT + l15 * 1024 + 32 * (s + 3) + 8 * quad), a3); }
        const f32x4 acc = (a0 + a1) + (a2 + a3);
        if (quad < 2 && l15 < 12) {
#pragma unroll
            for (int r = 0; r < 4; ++r) AB[(size_t)(m0 + 4 * quad + r) * 16 + l15] = acc[r]; }
        WAVE_LDS_FENCE();
    }
}
DEVFN void phase_final(const Ctx& C) {
    const int gw = C.cu * 8 + C.wave, NGW = C.ncu * 8;
    const float* X = WSP(float, WS_X); const float* MOD = WSP(float, WS_MOD);
    const f32x4* nw = (const f32x4*)C.final_norm_w + C.lane;
    for (int grp = gw; grp < M_T / 8; grp += NGW) {
        f32x4 gv[4], sv[4]; int cur = -1;
#pragma unroll 2
        for (int r = 0; r < 8; ++r) { const int m = grp * 8 + r;
            const f32x4* xr = (const f32x4*)(X + (size_t)m * 1024) + C.lane;
            f32x4 v[4]; float s = 0.f;
#pragma unroll
            for (int j = 0; j < 4; ++j) { v[j] = xr[64 * j]; s += (v[j].x * v[j].x + v[j].y * v[j].y) + (v[j].z * v[j].z + v[j].w * v[j].w); }
            const int br = brow_of(m);
            if (br != cur) { cur = br; const float* mod = MOD + (size_t)br * NMOD + 12288;
#pragma unroll
                for (int j = 0; j < 4; ++j) { sv[j] = ((const f32x4*)mod)[64 * j + C.lane]; gv[j] = nw[64 * j] * (((const f32x4*)(mod + 1024))[64 * j + C.lane] + 1.0f); } }
            const float rstd = RSQF(wave_sum(s) * (1.f / 1024.f) + 1e-6f);
            f32x4* o = (f32x4*)(C.outp + (m < M_P ? O_YP + (size_t)m * 1024 : O_YS + (size_t)(m - M_P) * 1024)) + C.lane;
#pragma unroll
            for (int j = 0; j < 4; ++j) o[64 * j] = v[j] * rstd * gv[j] + sv[j]; }
    }
}
DEVFN bf16x8 lds_frag(const LDSQ bf16_t* base, int ld, int row, int col) { return *(const LDSQ bf16x8*)(base + row * ld + col); }
DEVFN bf16x8 glb_frag(const bf16_t* base, int ld, int row, int col) { return *(const bf16x8*)(base + (size_t)row * ld + col); }
DEVFN bf16x8 zero_frag() { bf16x8 z = {0, 0, 0, 0, 0, 0, 0, 0}; return z; }
constexpr int LDP = 72;
constexpr float NEG_BIG = -1e30f;
DEVFN int inv_perm(int c) { return (c & 32) | (((c >> 2) & 3) << 3) | (((c >> 4) & 1) << 2) | (c & 3); }
DEVFN bf16x8 acc_pair_frag(f32x4 lo, f32x4 hi) { const u32x4 u = {pk2(lo.x, lo.y), pk2(lo.z, lo.w), pk2(hi.x, hi.y), pk2(hi.z, hi.w)}; return __builtin_bit_cast(bf16x8, u); }

DEVFN void conv_a_item(const Ctx& C, int l, int item) {
    const bf16_t* U = WSP(bf16_t, WS_U); bf16_t* MIX = WSP(bf16_t, WS_MIX);
    const int rl = C.tid >> 5, ch = (C.tid & 31) * 8;
    float w[3][8];
#pragma unroll
    for (int j = 0; j < 3; ++j)
#pragma unroll
        for (int e = 0; e < 8; ++e) w[j][e] = C.conv_a_w[(l * 3 + j) * 256 + ch + e];
    for (int pass = 0; pass < 4; ++pass) {
        const int m = item * 64 + pass * 16 + rl;
        const bool smp = m >= M_P; const int b = smp ? (m - M_P) >> 2 : m >> 11, t = smp ? (m - M_P) & 3 : m & 2047;
        float P[3][8];
#pragma unroll
        for (int j = 0; j < 3; ++j) { const int tt = t - 2 + j;
            if (tt >= 0) { const size_t r = (size_t)(m - 2 + j) * NU; float a[8], c[8];
                unpack8(*(const u32x4*)(U + r + UC_AX + ch), a); unpack8(*(const u32x4*)(U + r + UC_ACG + ch), c);
#pragma unroll
                for (int e = 0; e < 8; ++e) P[j][e] = a[e] * c[e]; }
            else if (smp) { const float* s = C.st_conv_a + ((size_t)(l * NBS + b) * 2 + (tt + 2)) * 256 + ch;
#pragma unroll
                for (int e = 0; e < 8; ++e) P[j][e] = s[e]; }
            else {
#pragma unroll
                for (int e = 0; e < 8; ++e) P[j][e] = 0.f; } }
        float bg[8], z[8], y[8];
        unpack8(*(const u32x4*)(U + (size_t)m * NU + UC_ABG + ch), bg); unpack8(*(const u32x4*)(U + (size_t)m * NU + UC_AZ + ch), z);
#pragma unroll
        for (int e = 0; e < 8; ++e) y[e] = bg[e] * (w[0][e] * P[0][e] + w[1][e] * P[1][e] + w[2][e] * P[2][e]) * silu_f(z[e]);
        *(u32x4*)(MIX + (size_t)m * 1024 + ch) = pack8(y);
        const int last = smp ? 4 : 2048;
        if (t >= last - 2) { float* o = C.outp + (smp ? O_CAS + ((size_t)(l * NBS + b) * 2 + (t - 2)) * 256 : O_CAP + ((size_t)(l * NBP + b) * 2 + (t - 2046)) * 256) + ch;
#pragma unroll
            for (int e = 0; e < 8; ++e) o[e] = P[2][e]; }
    }
}

constexpr int GP_KN = 0, GP_QN = 9216, GP_VBT = 18432, GP_KBGT = 27648, GP_KDT = 36864, GP_LB = 46080, GP_TR = 55296, GP_TT = 64512, GP_AM = 73728, GP_WM = 82944,
              GP_LF = 92160  , GP_PT = 109568  , GP_QT = 112128  , GP_G = 114688  ;
DEVFN void gdn_prep_item(const Ctx& C, int l, int item) {
    const int b = item / 192, h = (item / 32) % 6, n = item % 32;
    const int lane = C.lane, quad = lane >> 4, l15 = lane & 15, wave = C.wave;
    const bf16_t* U = WSP(bf16_t, WS_U); const float* AB = WSP(float, WS_AB);
    unsigned char* cbase = C.wsp + WS_GDN + (size_t)item * GDN_CHUNK_BYTES;
    bf16_t* gWm = (bf16_t*)cbase; bf16_t* gQG = (bf16_t*)(cbase + 8192); bf16_t* gAm = (bf16_t*)(cbase + 16384); bf16_t* gKDt = (bf16_t*)(cbase + 24576); bf16_t* gUt = (bf16_t*)(cbase + 32768);
    LDSQ bf16_t* Kn = (LDSQ bf16_t*)(C.lds + GP_KN); LDSQ bf16_t* Qn = (LDSQ bf16_t*)(C.lds + GP_QN); LDSQ bf16_t* VbT = (LDSQ bf16_t*)(C.lds + GP_VBT);
    LDSQ bf16_t* KbgT = (LDSQ bf16_t*)(C.lds + GP_KBGT); LDSQ bf16_t* KDt = (LDSQ bf16_t*)(C.lds + GP_KDT); LDSQ bf16_t* Lb = (LDSQ bf16_t*)(C.lds + GP_LB);
    LDSQ bf16_t* Tr = (LDSQ bf16_t*)(C.lds + GP_TR); LDSQ bf16_t* Tt = (LDSQ bf16_t*)(C.lds + GP_TT); LDSQ bf16_t* Am = (LDSQ bf16_t*)(C.lds + GP_AM); LDSQ bf16_t* Wm = (LDSQ bf16_t*)(C.lds + GP_WM);
    LDSQ float* Lf = (LDSQ float*)(C.lds + GP_LF); LDSQ bf16_t* PT = (LDSQ bf16_t*)(C.lds + GP_PT); LDSQ bf16_t* QT = (LDSQ bf16_t*)(C.lds + GP_QT);
    LDSQ float* gl = (LDSQ float*)(C.lds + GP_G); LDSQ float* gcl = gl + 64; LDSQ float* betal = gl + 128;
    const int i = C.tid >> 3, cg = C.tid & 7, t = 64 * n + i;
    const size_t row = (size_t)b * 2048 + t;
    float q[8], k[8], v[8], xq[8], xk[8], xv[8];
#pragma unroll
    for (int e = 0; e < 8; ++e) { q[e] = 0.f; k[e] = 0.f; v[e] = 0.f; xq[e] = 0.f; xk[e] = 0.f; xv[e] = 0.f; }
    const int cq = h * 64 + 8 * cg;
#pragma unroll
    for (int j = 0; j < 4; ++j) { const int tt = t - 3 + j;
        if (tt >= 0) { const bf16_t* ur = U + (row - 3 + j) * NU + cq;
            unpack8(*(const u32x4*)(ur + UC_BQ), xq); unpack8(*(const u32x4*)(ur + UC_BK), xk); unpack8(*(const u32x4*)(ur + UC_BV), xv);
            const float* wr_ = C.conv_b_w + (size_t)(l * 4 + j) * 1152 + cq;
#pragma unroll
            for (int e = 0; e < 8; ++e) { q[e] += xq[e] * wr_[e]; k[e] += xk[e] * wr_[384 + e]; v[e] += xv[e] * wr_[768 + e]; } } }
    if (n == 31 && i >= 61) { float* o = C.outp + O_CBP + ((size_t)(l * NBP + b) * 3 + (i - 61)) * 1152 + cq;
#pragma unroll
        for (int e = 0; e < 8; ++e) { o[e] = xq[e]; o[384 + e] = xk[e]; o[768 + e] = xv[e]; } }
    float sq = 0.f, sk = 0.f;
#pragma unroll
    for (int e = 0; e < 8; ++e) { q[e] = silu_f(q[e]); k[e] = silu_f(k[e]); v[e] = silu_f(v[e]); sq += q[e] * q[e]; sk += k[e] * k[e]; }
    sq += shfl_xor_f(sq, 1); sq += shfl_xor_f(sq, 2); sq += shfl_xor_f(sq, 4);
    sk += shfl_xor_f(sk, 1); sk += shfl_xor_f(sk, 2); sk += shfl_xor_f(sk, 4);
    const float rq = 0.125f * RSQF(sq + 1e-6f), rk = RSQF(sk + 1e-6f);
#pragma unroll
    for (int e = 0; e < 8; ++e) { q[e] *= rq; k[e] *= rk; }
    if (cg == 0) { const float ga = AB[row * 16 + h], gb = AB[row * 16 + 6 + h];
        gl[i] = -EXPF(C.a_log[l * 6 + h]) * softplus_f(ga + C.dt_bias[l * 6 + h]); betal[i] = sigmoid_f(gb); }
    for (int e = C.tid; e < 2 * 64 * LDP / 2; e += 512) ((LDSQ unsigned*)Tr)[e] = 0u;
    SYNC();
    if (wave == 0) { float x = gl[lane];
#pragma unroll
        for (int d = 1; d < 64; d <<= 1) { const float y = shfl_up_f(x, d); if (lane >= d) x += y; }
        gcl[lane] = x; }
    SYNC();
    const float gci = gcl[i], glast = gcl[63], bi = betal[i];
    const float egc = EXPF(gci), ekd = EXPF(glast - gci);
    {
        float tq[8];
#pragma unroll
        for (int e = 0; e < 8; ++e) tq[e] = q[e] * egc;
        { const int c0 = 32 * (cg >> 2) + 16 * (cg & 1) + 4 * ((cg >> 1) & 1);
            *(u32x2*)(gQG + i * 64 + c0) = (u32x2){pk2(tq[0], tq[1]), pk2(tq[2], tq[3])}; *(u32x2*)(gQG + i * 64 + c0 + 8) = (u32x2){pk2(tq[4], tq[5]), pk2(tq[6], tq[7])}; }
        *(LDSQ u32x4*)(Kn + i * LDP + 8 * cg) = pack8(k); *(LDSQ u32x4*)(Qn + i * LDP + 8 * cg) = pack8(q);
#pragma unroll
        for (int e = 0; e < 8; ++e) { const int d = 8 * cg + e;
            VbT[d * LDP + i] = (bf16_t)f2bf(v[e] * bi); KbgT[d * LDP + i] = (bf16_t)f2bf(k[e] * bi * egc); KDt[d * LDP + inv_perm(i)] = (bf16_t)f2bf(k[e] * ekd); }
    }
    SYNC();
#pragma unroll 1
    for (int jj = 0; jj < 4; ++jj) { const int job = wave * 4 + jj, type = job >> 4, it = (job & 15) >> 2, jt = job & 3;
        if (it < jt) { if (type == 1) {
#pragma unroll
                for (int r = 0; r < 4; ++r) Am[(16 * it + 4 * quad + r) * LDP + inv_perm(16 * jt + l15)] = 0; }
            continue; }
        f32x4 acc = {0.f, 0.f, 0.f, 0.f};
#pragma unroll
        for (int s = 0; s < 2; ++s) { const bf16x8 a = lds_frag(type ? Qn : Kn, LDP, 16 * it + l15, 32 * s + 8 * quad), bb = lds_frag(Kn, LDP, 16 * jt + l15, 32 * s + 8 * quad);
            acc = mfma16(a, bb, acc); }
        const int jc = 16 * jt + l15; const float gj = gcl[jc];
#pragma unroll
        for (int r = 0; r < 4; ++r) { const int ir = 16 * it + 4 * quad + r; const float gi = gcl[ir];
            if (type == 0) { const float val = (ir > jc) ? betal[ir] * acc[r] * EXPF(gi - gj) : 0.f; Lf[ir * 68 + jc] = val; Lb[ir * LDP + jc] = (bf16_t)f2bf(val); }
            else { const float val = (ir >= jc) ? acc[r] * EXPF(gi - gj) : 0.f; Am[ir * LDP + inv_perm(jc)] = (bf16_t)f2bf(val); } }
    }
    SYNC();
    if (wave == 0) { const int blk = quad, c = l15; float x[16];
#pragma unroll
        for (int ii = 0; ii < 16; ++ii) { float s = (ii == c) ? 1.f : 0.f;
#pragma unroll
            for (int jx = 0; jx < ii; ++jx) s -= Lf[(16 * blk + ii) * 68 + 16 * blk + jx] * x[jx];
            x[ii] = s; }
#pragma unroll
        for (int ii = 0; ii < 16; ++ii) Tr[(16 * blk + ii) * LDP + 16 * blk + c] = (bf16_t)f2bf(x[ii]);
        *(LDSQ u32x4*)(Tt + (16 * blk + c) * LDP + 16 * blk) = pack8(x); *(LDSQ u32x4*)(Tt + (16 * blk + c) * LDP + 16 * blk + 8) = pack8(x + 8); }
    SYNC();
    if (wave < 2) { const int rb = 2 * wave + 1, cb = 2 * wave; LDSQ bf16_t* pt = PT + wave * 16 * 40;
        bf16x8 a = quad < 2 ? lds_frag(Lb, LDP, 16 * rb + l15, 16 * cb + 8 * quad) : zero_frag();
        bf16x8 bb = quad < 2 ? lds_frag(Tt, LDP, 16 * cb + l15, 16 * cb + 8 * quad) : zero_frag();
        f32x4 z = {0.f, 0.f, 0.f, 0.f}; f32x4 p = mfma16(a, bb, z);
        *(LDSQ u32x2*)(pt + l15 * 40 + 4 * quad) = pack4(p);
        WAVE_LDS_FENCE();
        a = quad < 2 ? lds_frag(Tr, LDP, 16 * rb + l15, 16 * rb + 8 * quad) : zero_frag();
        bb = quad < 2 ? lds_frag(pt, 40, l15, 8 * quad) : zero_frag();
        f32x4 r4 = mfma16(a, bb, z); r4 = -r4;
#pragma unroll
        for (int r = 0; r < 4; ++r) Tr[(16 * rb + 4 * quad + r) * LDP + 16 * cb + l15] = (bf16_t)f2bf(r4[r]);
        *(LDSQ u32x2*)(Tt + (16 * cb + l15) * LDP + 16 * rb + 4 * quad) = pack4(r4); }
    SYNC();
    if (wave < 4) { const int it2 = wave >> 1, jt2 = wave & 1;
        const bf16x8 a = lds_frag(Lb, LDP, 32 + 16 * it2 + l15, 8 * quad), bb = lds_frag(Tt, LDP, 16 * jt2 + l15, 8 * quad);
        f32x4 z = {0.f, 0.f, 0.f, 0.f}; const f32x4 p = mfma16(a, bb, z);
        *(LDSQ u32x2*)(QT + (16 * jt2 + l15) * 40 + 16 * it2 + 4 * quad) = pack4(p); }
    SYNC();
    if (wave < 4) { const int it2 = wave >> 1, jt2 = wave & 1;
        const bf16x8 a = lds_frag(Tr, LDP, 32 + 16 * it2 + l15, 32 + 8 * quad), bb = lds_frag(QT, 40, 16 * jt2 + l15, 8 * quad);
        f32x4 z = {0.f, 0.f, 0.f, 0.f}; f32x4 r4 = mfma16(a, bb, z); r4 = -r4;
#pragma unroll
        for (int r = 0; r < 4; ++r) Tr[(32 + 16 * it2 + 4 * quad + r) * LDP + 16 * jt2 + l15] = (bf16_t)f2bf(r4[r]);
        *(LDSQ u32x2*)(Tt + (16 * jt2 + l15) * LDP + 32 + 16 * it2 + 4 * quad) = pack4(r4); }
    SYNC();
#pragma unroll 1
    for (int jj = 0; jj < 4; ++jj) { const int job = wave * 4 + jj, type = job >> 4, it = (job & 15) >> 2, nt = job & 3;
        f32x4 acc = {0.f, 0.f, 0.f, 0.f};
#pragma unroll
        for (int s = 0; s < 2; ++s) { const bf16x8 a = lds_frag(Tr, LDP, 16 * it + l15, 32 * s + 8 * quad), bb = lds_frag(type ? KbgT : VbT, LDP, 16 * nt + l15, 32 * s + 8 * quad);
            acc = mfma16(a, bb, acc); }
        if (type == 0) *(u32x2*)(gUt + (16 * nt + l15) * 64 + 16 * it + 4 * quad) = pack4(acc);
        else {
#pragma unroll
            for (int r = 0; r < 4; ++r) Wm[(16 * it + 4 * quad + r) * LDP + inv_perm(16 * nt + l15)] = (bf16_t)f2bf(acc[r]); } }
    SYNC();
    { const int r = C.tid >> 3, c8 = (C.tid & 7) * 8;
        *(u32x4*)(gWm + r * 64 + c8) = *(const LDSQ u32x4*)(Wm + r * LDP + c8);
        *(u32x4*)(gAm + r * 64 + c8) = *(const LDSQ u32x4*)(Am + r * LDP + c8);
        *(u32x4*)(gKDt + r * 64 + c8) = *(const LDSQ u32x4*)(KDt + r * LDP + c8);
        if (C.tid == 0) WSP(float, WS_GSC)[item] = EXPF(glast); }
    SYNC();
}

constexpr int SB_RING = 0, SB_RBUF = 40960, SB_Z = 122880, SB_ZBUF = 8192, SB_O = 139264, SB_OBUF = 9216, SB_DEC = 157696, SB_END = 158080;
DEVFN int sw_off(int row, int col) { return row * 64 + ((((col >> 3) ^ row) & 7) << 3) + (col & 7); }
DEVFN bf16x8 sw_frag(const LDSQ bf16_t* base, int row, int col) { return *(const LDSQ bf16x8*)(base + sw_off(row, col)); }
DEVFN void scan_dma_chunk(const unsigned char* cbase, LDSQ unsigned char* rbuf, int w, int lane) {
    const int row = 8 * w + (lane >> 3), c = (lane & 7) ^ (lane >> 3);
#pragma unroll
    for (int j = 0; j < 5; ++j) DMA16(cbase + j * 8192 + row * 128 + c * 16, rbuf + j * 8192 + w * 1024, lane);
}
DEVFN void scan_dma_z(const bf16_t* Uz, int n, LDSQ unsigned char* zbuf, int rg, int lane) {
    const int row = 8 * rg + (lane >> 3), c = (lane & 7) ^ (lane >> 3);
    DMA16((const unsigned char*)(Uz + (size_t)(64 * n + row) * NU) + c * 16, zbuf + rg * 1024, lane);
}
DEVFN void scan_epi(const Ctx& C, const bf16_t* Uz, LDSQ unsigned char* zbuf, const LDSQ bf16_t* obuf, const LDSQ float* nw, int b, int h, int n, bool next_z, int lw, int lane) {
    const int row = 16 * lw + (lane >> 2), c0 = 16 * (lane & 3); float o[16], zf[16]; float ss = 0.f;
    unpack8(*(const LDSQ u32x4*)(obuf + row * LDP + c0), o); unpack8(*(const LDSQ u32x4*)(obuf + row * LDP + c0 + 8), o + 8);
    unpack8(*(const LDSQ u32x4*)((const LDSQ bf16_t*)zbuf + sw_off(row, c0)), zf); unpack8(*(const LDSQ u32x4*)((const LDSQ bf16_t*)zbuf + sw_off(row, c0 + 8)), zf + 8);
    WAVE_LDS_FENCE();
    if (next_z) { scan_dma_z(Uz, n + 2, zbuf, 2 * lw, lane); scan_dma_z(Uz, n + 2, zbuf, 2 * lw + 1, lane); }
#pragma unroll
    for (int e = 0; e < 16; ++e) ss += o[e] * o[e];
    ss += shfl_xor_f(ss, 1); ss += shfl_xor_f(ss, 2);
    const float rstd = RSQF(ss * (1.f / 64.f) + 1e-6f);
#pragma unroll
    for (int e = 0; e < 16; ++e) o[e] = o[e] * rstd * nw[e] * silu_f(zf[e]);
    bf16_t* mp = WSP(bf16_t, WS_MIX) + ((size_t)b * 2048 + 64 * n + row) * 1024 + 256 + h * 64 + c0;
    *(u32x4*)mp = pack8(o); *(u32x4*)(mp + 8) = pack8(o + 8);
}
DEVFN void scan_compute(const LDSQ unsigned char* rbuf, LDSQ bf16_t* obuf, f32x4 (&S)[4], float dec, int w, int quad, int l15) {
    const LDSQ bf16_t* Wm = (const LDSQ bf16_t*)rbuf; const LDSQ bf16_t* QG = Wm + 4096; const LDSQ bf16_t* Am = Wm + 2 * 4096; const LDSQ bf16_t* KD = Wm + 3 * 4096; const LDSQ bf16_t* Ut = Wm + 4 * 4096;
    const bf16x8 bS0 = acc_pair_frag(S[0], S[1]), bS1 = acc_pair_frag(S[2], S[3]);
    f32x4 vn[4];
#pragma unroll
    for (int it = 0; it < 4; ++it) { f32x4 acc = {0.f, 0.f, 0.f, 0.f};
        acc = mfma16(sw_frag(Wm, 16 * it + l15, 8 * quad), bS0, acc); acc = mfma16(sw_frag(Wm, 16 * it + l15, 32 + 8 * quad), bS1, acc);
        const u32x2 u2 = *(const LDSQ u32x2*)(Ut + sw_off(16 * w + l15, 16 * it + 4 * quad));
        vn[it] = (f32x4){bf_lo(u2.x), bf_hi(u2.x), bf_lo(u2.y), bf_hi(u2.y)} - acc; }
    const bf16x8 bV0 = acc_pair_frag(vn[0], vn[1]), bV1 = acc_pair_frag(vn[2], vn[3]);
#pragma unroll
    for (int kt = 0; kt < 4; ++kt) { f32x4 acc = S[kt] * dec;
        acc = mfma16(sw_frag(KD, 16 * kt + l15, 8 * quad), bV0, acc); acc = mfma16(sw_frag(KD, 16 * kt + l15, 32 + 8 * quad), bV1, acc);
        S[kt] = acc; }
#pragma unroll
    for (int it = 0; it < 4; ++it) { f32x4 acc = {0.f, 0.f, 0.f, 0.f};
        acc = mfma16(sw_frag(QG, 16 * it + l15, 8 * quad), bS0, acc); acc = mfma16(sw_frag(QG, 16 * it + l15, 32 + 8 * quad), bS1, acc);
        acc = mfma16(sw_frag(Am, 16 * it + l15, 8 * quad), bV0, acc); acc = mfma16(sw_frag(Am, 16 * it + l15, 32 + 8 * quad), bV1, acc);
#pragma unroll
        for (int r = 0; r < 4; ++r) obuf[(16 * it + 4 * quad + r) * LDP + 16 * w + l15] = (bf16_t)f2bf(acc[r]); }
}
DEVFN void gdn_scan_unit(const Ctx& C, int l, int unit) {
    const int b = unit / 6, h = unit % 6;
    const int lane = C.lane, quad = lane >> 4, l15 = lane & 15, w = C.wave;
    const bf16_t* Uz = WSP(bf16_t, WS_U) + (size_t)b * 2048 * NU + UC_BZ + h * 64;
    const unsigned char* g0 = C.wsp + WS_GDN + (size_t)unit * 32 * GDN_CHUNK_BYTES;
    LDSQ unsigned char* R0 = C.lds + SB_RING; LDSQ unsigned char* Z0 = C.lds + SB_Z; LDSQ bf16_t* O0 = (LDSQ bf16_t*)(C.lds + SB_O); LDSQ float* decl = (LDSQ float*)(C.lds + SB_DEC);
    const bool comp = w < 4; const int lw = w & 3, lt = C.tid & 255;
    f32x4 S[4];
#pragma unroll
    for (int kt = 0; kt < 4; ++kt) S[kt] = (f32x4){0.f, 0.f, 0.f, 0.f};
    LDSQ float* nwl = decl + 32; const LDSQ float* nw = nwl + 16 * (lane & 3);
    if (!comp) { if (lt < 32) decl[lt] = WSP(float, WS_GSC)[unit * 32 + lt]; else if (lt < 96) nwl[lt - 32] = C.gdn_norm_w[l * 64 + lt - 32]; }
    VM_DRAIN();
    scan_dma_chunk(g0, R0, w, lane); scan_dma_chunk(g0 + GDN_CHUNK_BYTES, R0 + SB_RBUF, w, lane);
    if (!comp) { scan_dma_z(Uz, 0, Z0, 2 * lw, lane); scan_dma_z(Uz, 0, Z0, 2 * lw + 1, lane); }
    VM_DRAIN(); RAW_SYNC();
#pragma unroll 1
    for (int n = 0; n < 32; ++n) {
        const bool more = n + 2 < 32;
        if (more) scan_dma_chunk(g0 + (size_t)(n + 2) * GDN_CHUNK_BYTES, R0 + ((n + 2) % 3) * SB_RBUF, w, lane);
        if (comp) { scan_compute(R0 + (n % 3) * SB_RBUF, O0 + (n & 1) * (SB_OBUF / 2), S, decl[n], w, quad, l15);
            if (more) VM_WAIT_N(5); else VM_DRAIN(); }
        else { if (n > 0) scan_epi(C, Uz, Z0 + ((n - 1) & 1) * SB_ZBUF, O0 + ((n - 1) & 1) * (SB_OBUF / 2), nw, b, h, n - 1, n + 1 < 32, lw, lane);
            else { scan_dma_z(Uz, 1, Z0 + SB_ZBUF, 2 * lw, lane); scan_dma_z(Uz, 1, Z0 + SB_ZBUF, 2 * lw + 1, lane); }
            if (more) VM_WAIT_N(9); else VM_DRAIN(); }
        RAW_SYNC();
    }
    if (!comp) scan_epi(C, Uz, Z0 + SB_ZBUF, O0 + SB_OBUF / 2, nw, b, h, 31, false, lw, lane);
    else { float* og = C.outp + O_GP + ((size_t)(l * NBP + b) * 6 + h) * 4096;
#pragma unroll
        for (int kt = 0; kt < 4; ++kt)
#pragma unroll
            for (int r = 0; r < 4; ++r) og[(16 * kt + 4 * quad + r) * 64 + 16 * w + l15] = S[kt][r]; }
    SYNC();
}

DEVFN void gdn_sample_item(const Ctx& C, int l, int witem, LDSQ float* kq) {
    const int b = witem / 6, h = witem % 6, d = C.lane, m0 = M_P + 4 * b;
    const bf16_t* U = WSP(bf16_t, WS_U); bf16_t* MIX = WSP(bf16_t, WS_MIX); const float* AB = WSP(float, WS_AB);
    float qv[4], kv[4], vv[4];
    {
        float xp[3][7];
#pragma unroll
        for (int c = 0; c < 3; ++c) { const int ch = c * 384 + h * 64 + d;
#pragma unroll
            for (int j = 0; j < 3; ++j) xp[c][j] = C.st_conv_b[((size_t)(l * NBS + b) * 3 + j) * 1152 + ch];
#pragma unroll
            for (int i = 0; i < 4; ++i) xp[c][3 + i] = bf2f(U[(size_t)(m0 + i) * NU + (c == 0 ? UC_BQ : c == 1 ? UC_BK : UC_BV) + h * 64 + d]);
#pragma unroll
            for (int j = 0; j < 3; ++j) C.outp[O_CBS + ((size_t)(l * NBS + b) * 3 + j) * 1152 + ch] = xp[c][4 + j];
            float wt[4];
#pragma unroll
            for (int j = 0; j < 4; ++j) wt[j] = C.conv_b_w[(size_t)(l * 4 + j) * 1152 + ch];
#pragma unroll
            for (int i = 0; i < 4; ++i) { const float y = silu_f(wt[0] * xp[c][i] + wt[1] * xp[c][i + 1] + wt[2] * xp[c][i + 2] + wt[3] * xp[c][i + 3]);
                if (c == 0) qv[i] = y; else if (c == 1) kv[i] = y; else vv[i] = y; } }
    }
#pragma unroll
    for (int i = 0; i < 4; ++i) { const float sq = wave_sum(qv[i] * qv[i]), sk = wave_sum(kv[i] * kv[i]); qv[i] *= 0.125f * RSQF(sq + 1e-6f); kv[i] *= RSQF(sk + 1e-6f); }
    float S[64];
    const float* s0 = C.st_gdn + ((size_t)(l * NBS + b) * 6 + h) * 4096 + d;
#pragma unroll
    for (int dk = 0; dk < 64; ++dk) S[dk] = s0[dk * 64];
    const float alog = -EXPF(C.a_log[l * 6 + h]), dtb = C.dt_bias[l * 6 + h], nw = C.gdn_norm_w[l * 64 + d];
#pragma unroll 1
    for (int i = 0; i < 4; ++i) {
        const float g = alog * softplus_f(AB[(size_t)(m0 + i) * 16 + h] + dtb), beta = sigmoid_f(AB[(size_t)(m0 + i) * 16 + 6 + h]);
        const float eg = EXPF(g);
        float qi = qv[0], ki = kv[0], vi = vv[0];
#pragma unroll
        for (int j = 1; j < 4; ++j) { qi = (i == j) ? qv[j] : qi; ki = (i == j) ? kv[j] : ki; vi = (i == j) ? vv[j] : vi; }
        WAVE_LDS_FENCE();
        kq[d] = ki; kq[64 + d] = qi;
        WAVE_LDS_FENCE();
        float ks0 = 0.f, ks1 = 0.f, ks2 = 0.f, ks3 = 0.f;
#pragma unroll
        for (int d0 = 0; d0 < 64; d0 += 4) { const f32x4 ka = *(const LDSQ f32x4*)(kq + d0);
            ks0 = FMA_OP(ka.x, S[d0], ks0); ks1 = FMA_OP(ka.y, S[d0 + 1], ks1); ks2 = FMA_OP(ka.z, S[d0 + 2], ks2); ks3 = FMA_OP(ka.w, S[d0 + 3], ks3); }
        const float vn = beta * (vi - eg * ((ks0 + ks1) + (ks2 + ks3)));
        float o0 = 0.f, o1 = 0.f, o2 = 0.f, o3 = 0.f;
#pragma unroll
        for (int d0 = 0; d0 < 64; d0 += 4) { const f32x4 ka = *(const LDSQ f32x4*)(kq + d0), qa = *(const LDSQ f32x4*)(kq + 64 + d0);
            S[d0] = FMA_OP(eg, S[d0], ka.x * vn); S[d0 + 1] = FMA_OP(eg, S[d0 + 1], ka.y * vn); S[d0 + 2] = FMA_OP(eg, S[d0 + 2], ka.z * vn); S[d0 + 3] = FMA_OP(eg, S[d0 + 3], ka.w * vn);
            o0 = FMA_OP(qa.x, S[d0], o0); o1 = FMA_OP(qa.y, S[d0 + 1], o1); o2 = FMA_OP(qa.z, S[d0 + 2], o2); o3 = FMA_OP(qa.w, S[d0 + 3], o3); }
        const float o = (o0 + o1) + (o2 + o3);
        const float ssq = wave_sum(o * o); const float rstd = RSQF(ssq * (1.f / 64.f) + 1e-6f);
        const float z = bf2f(U[(size_t)(m0 + i) * NU + UC_BZ + h * 64 + d]);
        MIX[(size_t)(m0 + i) * 1024 + 256 + h * 64 + d] = (bf16_t)f2bf(o * rstd * nw * silu_f(z));
    }
    float* so = C.outp + O_GS + ((size_t)(l * NBS + b) * 6 + h) * 4096 + d;
#pragma unroll
    for (int dk = 0; dk < 64; ++dk) so[dk * 64] = S[dk];
}

constexpr int AT_K = 0  , AT_Q = 36864  , AT_VT = 55296  , VTP = 296;
DEVFN void rope8(float* x1, float* x2, const float* cs) {
#pragma unroll
    for (int e = 0; e < 8; ++e) { const float a = x1[e], bq = x2[e]; x1[e] = a * cs[e] - bq * cs[8 + e]; x2[e] = bq * cs[e] + a * cs[8 + e]; }
}
DEVFN void attn_prompt_unit(const Ctx& C, int l, int unit) {
    const int g = unit >> 8, uu = unit & 255, b = uu >> 5, h2 = (uu >> 4) & 1, rest = uu & 15;
    const int dil = g == 0 ? 1 : g == 1 ? 4 : 16, nb = g == 0 ? 16 : g == 1 ? 4 : 1, win = g == 0 ? 128 : g == 1 ? 512 : 2048;
    const int r = rest / nb, n = rest % nb, hh = 2 * g + h2;
    const int lane = C.lane, quad = lane >> 4, l15 = lane & 15, w = C.wave;
    const bf16_t* U = WSP(bf16_t, WS_U); const float* ROPE = WSP(float, WS_ROPE); bf16_t* OC = WSP(bf16_t, WS_OC); float* LSE = WSP(float, WS_LSE);
    LDSQ bf16_t* Kl = (LDSQ bf16_t*)(C.lds + AT_K); LDSQ bf16_t* Ql = (LDSQ bf16_t*)(C.lds + AT_Q); LDSQ bf16_t* VT = (LDSQ bf16_t*)(C.lds + AT_VT);
    float* kvout = C.outp + (g == 0 ? O_K128P : g == 1 ? O_K512P : O_K2048P) + (size_t)(l * NBP + b) * win * 256;
    for (int p = 0; p < 4; ++p) { const int idx = C.tid + 512 * p, kk = idx >> 3, c = idx & 7;
        const int mpos = 128 * (n - 1) + kk; const bool ok = mpos >= 0; const int t = mpos * dil + r;
        const bf16_t* ur = U + ((size_t)b * 2048 + (ok ? t : 0)) * NU + hh * 64;
        float v8[8];
        if (ok) unpack8(*(const u32x4*)(ur + UC_CV + 8 * c), v8); else {
#pragma unroll
            for (int e = 0; e < 8; ++e) v8[e] = 0.f; }
#pragma unroll
        for (int e = 0; e < 8; ++e) VT[(8 * c + e) * VTP + kk] = (bf16_t)f2bf(v8[e]);
        const bool wout = (n == nb - 1) && kk >= 128; float* orow = kvout + (size_t)(t - (2048 - win)) * 256 + h2 * 64;
        if (wout) {
#pragma unroll
            for (int e = 0; e < 8; ++e) orow[128 + 8 * c + e] = v8[e]; }
        if (c == 0) { float x1[8], x2[8];
            if (ok) { unpack8(*(const u32x4*)(ur + UC_CK), x1); unpack8(*(const u32x4*)(ur + UC_CK + 8), x2); float cs[16];
#pragma unroll
                for (int e = 0; e < 16; ++e) cs[e] = ROPE[t * 16 + e];
                rope8(x1, x2, cs); }
            else {
#pragma unroll
                for (int e = 0; e < 8; ++e) { x1[e] = 0.f; x2[e] = 0.f; } }
            *(LDSQ u32x4*)(Kl + kk * LDP) = pack8(x1); *(LDSQ u32x4*)(Kl + kk * LDP + 8) = pack8(x2);
            if (wout) {
#pragma unroll
                for (int e = 0; e < 8; ++e) { orow[e] = x1[e]; orow[8 + e] = x2[e]; } } }
        else if (c >= 2) { u32x4 kx = {0u, 0u, 0u, 0u}; if (ok) kx = *(const u32x4*)(ur + UC_CK + 8 * c);
            *(LDSQ u32x4*)(Kl + kk * LDP + 8 * c) = kx;
            if (wout) { float k8[8]; unpack8(kx, k8);
#pragma unroll
                for (int e = 0; e < 8; ++e) orow[8 * c + e] = k8[e]; } }
    }
    for (int p = 0; p < 2; ++p) { const int idx = C.tid + 512 * p, qq = idx >> 3, c = idx & 7;
        const int t = (128 * n + qq) * dil + r; const bf16_t* ur = U + ((size_t)b * 2048 + t) * NU + UC_CQ + hh * 64;
        if (c == 0) { float x1[8], x2[8], cs[16]; unpack8(*(const u32x4*)(ur), x1); unpack8(*(const u32x4*)(ur + 8), x2);
#pragma unroll
            for (int e = 0; e < 16; ++e) cs[e] = ROPE[t * 16 + e];
            rope8(x1, x2, cs);
            *(LDSQ u32x4*)(Ql + qq * LDP) = pack8(x1); *(LDSQ u32x4*)(Ql + qq * LDP + 8) = pack8(x2); }
        else if (c >= 2) *(LDSQ u32x4*)(Ql + qq * LDP + 8 * c) = *(const u32x4*)(ur + 8 * c); }
    for (int e = C.tid; e < 64 * 40; e += 512) VT[(e / 40) * VTP + 256 + (e % 40)] = 0;
    SYNC();
    const int q0 = 16 * w, qi = q0 + l15;
    f32x4 st[9]; float mx = NEG_BIG;
#pragma unroll
    for (int kt = 0; kt < 9; ++kt) { f32x4 acc = {0.f, 0.f, 0.f, 0.f};
#pragma unroll
        for (int s = 0; s < 2; ++s) acc = mfma16(lds_frag(Kl, LDP, 16 * (w + kt) + l15, 32 * s + 8 * quad), lds_frag(Ql, LDP, qi, 32 * s + 8 * quad), acc);
#pragma unroll
        for (int rr = 0; rr < 4; ++rr) { const int kj = 16 * (w + kt) + 4 * quad + rr, dist = 128 + qi - kj; const bool valid = dist >= 0 && dist <= 128 && (n > 0 || kj >= 128);
            acc[rr] = valid ? acc[rr] * 0.125f : NEG_BIG; mx = fmaxf(mx, acc[rr]); }
        st[kt] = acc; }
    mx = fmaxf(mx, shfl_xor_f(mx, 16)); mx = fmaxf(mx, shfl_xor_f(mx, 32));
    float den = 0.f;
#pragma unroll
    for (int kt = 0; kt < 9; ++kt)
#pragma unroll
        for (int rr = 0; rr < 4; ++rr) { const float p = st[kt][rr] > -1e29f ? EXPF(st[kt][rr] - mx) : 0.f; st[kt][rr] = p; den += p; }
    den += shfl_xor_f(den, 16); den += shfl_xor_f(den, 32);
    const float inv = 1.0f / den;
    const int tq = (128 * n + qi) * dil + r; const size_t mrow = (size_t)b * 2048 + tq;
#pragma unroll
    for (int dt = 0; dt < 4; ++dt) { f32x4 acc = {0.f, 0.f, 0.f, 0.f};
#pragma unroll
        for (int pr = 0; pr < 5; ++pr) { const int ta = 2 * pr, tb = 2 * pr + 1;
            const u32x2 plo = pack4(st[ta]); u32x2 phi = {0u, 0u}; if (tb < 9) phi = pack4(st[tb < 9 ? tb : 8]);
            const u32x4 bu = {plo.x, plo.y, phi.x, phi.y};
            const LDSQ bf16_t* vr = VT + (16 * dt + l15) * VTP + 4 * quad;
            const u32x2 alo = *(const LDSQ u32x2*)(vr + 16 * (w + ta)), ahi = *(const LDSQ u32x2*)(vr + 16 * (w + tb));
            const u32x4 au = {alo.x, alo.y, ahi.x, ahi.y};
            acc = mfma16(__builtin_bit_cast(bf16x8, au), __builtin_bit_cast(bf16x8, bu), acc); }
        *(u32x2*)(OC + mrow * 384 + hh * 64 + 16 * dt + 4 * quad) = pack4(acc * inv); }
    if (quad == 0) LSE[mrow * 8 + hh] = mx + LOGF(den);
    SYNC();
}

constexpr int AS_NEW = 0  , AS_Q = 12288  , AS_CMB = 18432  , AS_O = 55296  , AS_L = 61440  ;
DEVFN void attn_sample_b(const Ctx& C, int l, int b) {
    const bf16_t* U = WSP(bf16_t, WS_U); const float* ROPE = WSP(float, WS_ROPE); bf16_t* MIX = WSP(bf16_t, WS_MIX);
    LDSQ float* NEW = (LDSQ float*)(C.lds + AS_NEW); LDSQ float* Qs = (LDSQ float*)(C.lds + AS_Q); LDSQ float* CMB = (LDSQ float*)(C.lds + AS_CMB);
    LDSQ float* OS = (LDSQ float*)(C.lds + AS_O); LDSQ float* LS = (LDSQ float*)(C.lds + AS_L);
    const int lane = C.lane, w = C.wave;
#pragma unroll 1
    for (int g = 0; g < 3; ++g) {
        const int i2 = C.tid >> 7, e0 = (C.tid & 127) * 2; const size_t m = M_P + 4 * b + i2; const int pos = 2048 + i2;
        float* orow = C.outp + (g == 0 ? O_K128S : g == 1 ? O_K512S : O_K2048S) + ((size_t)(l * NBS + b) * 4 + i2) * 256;
#pragma unroll
        for (int k2 = 0; k2 < 2; ++k2) { const int e = e0 + k2, kvs = e >> 7, h2 = (e >> 6) & 1, d = e & 63; const int hh = 2 * g + h2;
            const bf16_t* ur = U + m * NU + (kvs ? UC_CV : UC_CK) + hh * 64; float val = bf2f(ur[d]);
            if (!kvs && d < 16) { const int f = d & 7; const float cs = ROPE[pos * 16 + f], sn = ROPE[pos * 16 + 8 + f];
                val = d < 8 ? val * cs - bf2f(ur[d + 8]) * sn : val * cs + bf2f(ur[d - 8]) * sn; }
            NEW[(g * 4 + i2) * 256 + e] = val; orow[e] = val; }
        const int h2 = (C.tid >> 6) & 1, d = C.tid & 63, hh = 2 * g + h2; const bf16_t* ur = U + m * NU + UC_CQ + hh * 64; float val = bf2f(ur[d]);
        if (d < 16) { const int f = d & 7; const float cs = ROPE[pos * 16 + f], sn = ROPE[pos * 16 + 8 + f];
            val = d < 8 ? val * cs - bf2f(ur[d + 8]) * sn : val * cs + bf2f(ur[d - 8]) * sn; }
        Qs[(g * 4 + i2) * 128 + h2 * 64 + d] = val * 0.125f;
    }
    SYNC();
    const int i = w & 3, half = w >> 2;
#pragma unroll 1
    for (int g = 0; g < 3; ++g) {
        const int dil = g == 0 ? 1 : g == 1 ? 4 : 16, lb = g == 0 ? 128 : g == 1 ? 512 : 2048;
        const float* cache = (g == 0 ? C.kv128 : g == 1 ? C.kv512 : C.kv2048) + (size_t)(l * NBS + b) * lb * 256;
        const f32x4 q4 = *(const LDSQ f32x4*)(Qs + (g * 4 + i) * 128 + (lane & 31) * 4);
        float mrun = NEG_BIG, den = 0.f; f32x4 o4 = {0.f, 0.f, 0.f, 0.f};
        const int jn = (dil == 1) ? i + 1 : 1;
#define AS_STEP(x4) do { float part = (lane < 32) ? (q4.x * (x4).x + q4.y * (x4).y) + (q4.z * (x4).z + q4.w * (x4).w) : 0.f; \
        part += shfl_xor_f(part, 1); part += shfl_xor_f(part, 2); part += shfl_xor_f(part, 4); part += shfl_xor_f(part, 8); \
        const float s_ = shfl_f(part, lane & 31); const float mn_ = fmaxf(mrun, s_); const float sc_ = EXPF(mrun - mn_), p_ = EXPF(s_ - mn_); \
        den = den * sc_ + p_; o4 = o4 * sc_ + (x4) * p_; mrun = mn_; } while (0)
        if (half == 0) { for (int j = 0; j < jn; ++j) { const f32x4 x4 = *(const LDSQ f32x4*)(NEW + (g * 4 + i - j * dil) * 256 + lane * 4); AS_STEP(x4); } }
        const int j0 = half == 0 ? jn : 65, j1 = half == 0 ? 65 : 129;
        for (int j = j0; j < j1; j += 16) { f32x4 xb[16];
#pragma unroll
            for (int u = 0; u < 16; ++u) { const int jj = (j + u < j1) ? j + u : j1 - 1; xb[u] = *(const f32x4*)(cache + (size_t)(lb + i - jj * dil) * 256 + lane * 4); }
#pragma unroll
            for (int u = 0; u < 16; ++u) if (j + u < j1) AS_STEP(xb[u]); }
#undef AS_STEP
        { LDSQ float* cm = CMB + ((g * 8 + w) * 64 + lane) * 6; cm[0] = mrun; cm[1] = den; cm[2] = o4.x; cm[3] = o4.y; cm[4] = o4.z; cm[5] = o4.w; }
    }
    SYNC();
    if (half == 0 && lane >= 32) {
#pragma unroll 1
        for (int g = 0; g < 3; ++g) { const LDSQ float* c1 = CMB + ((g * 8 + w) * 64 + lane) * 6; const LDSQ float* c2 = CMB + ((g * 8 + w + 4) * 64 + lane) * 6;
            const float m1 = c1[0], d1 = c1[1], m2 = c2[0], d2 = c2[1]; const f32x4 o1 = {c1[2], c1[3], c1[4], c1[5]}, o2 = {c2[2], c2[3], c2[4], c2[5]};
            const float mm = fmaxf(m1, m2), a1 = EXPF(m1 - mm), a2 = EXPF(m2 - mm); const float dt = d1 * a1 + d2 * a2; const f32x4 o = (o1 * a1 + o2 * a2) * (1.0f / dt);
            const int h2 = (lane >> 4) & 1, hh = 2 * g + h2;
            *(LDSQ f32x4*)(OS + i * 384 + hh * 64 + (lane & 15) * 4) = o; if ((lane & 15) == 0) LS[i * 6 + hh] = mm + LOGF(dt); } }
    SYNC();
    for (int p = 0; p < 3; ++p) { const int idx = C.tid + 512 * p, i2 = idx / 384, c = idx % 384, hh = c >> 6, g = hh >> 1, hp = hh & 1; const size_t m = M_P + 4 * b + i2;
        const float l0 = LS[i2 * 6 + hp], l1 = LS[i2 * 6 + 2 + hp], l2 = LS[i2 * 6 + 4 + hp]; const float mx = fmaxf(l0, fmaxf(l1, l2));
        const float e0 = EXPF(l0 - mx), e1 = EXPF(l1 - mx), e2 = EXPF(l2 - mx); const float alpha = (g == 0 ? e0 : g == 1 ? e1 : e2) / (e0 + e1 + e2);
        const float z = bf2f(U[m * NU + UC_CZ + c]);
        MIX[m * 1024 + 640 + c] = (bf16_t)f2bf(OS[i2 * 384 + c] * alpha * silu_f(z)); }
    SYNC();
}

DEVFN void merge_item(const Ctx& C, int item) {
    const bf16_t* U = WSP(bf16_t, WS_U); const bf16_t* OC = WSP(bf16_t, WS_OC); const float* LSE = WSP(float, WS_LSE); bf16_t* MIX = WSP(bf16_t, WS_MIX);
    for (int p = 0; p < 3; ++p) { const int idx = C.tid + 512 * p, rl = idx / 48, c = idx % 48; const size_t m = (size_t)item * 32 + rl;
        const int hh = c >> 3, g = hh >> 1, hp = hh & 1;
        const float l0 = LSE[m * 8 + hp], l1 = LSE[m * 8 + 2 + hp], l2 = LSE[m * 8 + 4 + hp]; const float mx = fmaxf(l0, fmaxf(l1, l2));
        const float e0 = EXPF(l0 - mx), e1 = EXPF(l1 - mx), e2 = EXPF(l2 - mx); const float alpha = (g == 0 ? e0 : g == 1 ? e1 : e2) / (e0 + e1 + e2);
        float o[8], z[8]; unpack8(*(const u32x4*)(OC + m * 384 + 8 * c), o); unpack8(*(const u32x4*)(U + m * NU + UC_CZ + 8 * c), z);
#pragma unroll
        for (int e = 0; e < 8; ++e) o[e] = o[e] * alpha * silu_f(z[e]);
        *(u32x4*)(MIX + m * 1024 + 640 + 8 * c) = pack8(o); }
}

constexpr int N_PREP = 1536, N_ATTP = 768, N_ATTS = 128, N_CONVA = 264;
#ifndef DBL
#define DBL 0
#endif
DEVFN void phase_mid(const Ctx& C0, int l, bool second = false) {
    if (!second || DBL == 3 || DBL == 4) { const Ctx C = relaunder(C0);
        if (C.ncu == 256) { const int xcd = C.cu >> 5, j = C.cu & 31; for (int k = 0; k < 6; ++k) gdn_prep_item(C, l, (xcd + 8 * k) * 32 + j); }
        else for (int it = C.cu; it < N_PREP; it += C.ncu) gdn_prep_item(C, l, it); }
    if (!second || DBL == 3 || DBL == 5) { const Ctx C = relaunder(C0); for (int it = C.cu; it < N_ATTP; it += C.ncu) attn_prompt_unit(C, l, it); }
}
constexpr int N_SCAN = 48, N_GS = 96, N_MERGE = 512;
#define QUEUE_LOOP(qword, total, body) do { const Ctx C = relaunder(C0); for (;;) { \
        if (C.tid == 0) *(volatile LDSQ int*)(C.lds + LDS_QIDX) = (int)QUEUE_PULL(qword); SYNC(); const int it = *(volatile LDSQ int*)(C.lds + LDS_QIDX); SYNC(); \
        if (it >= (total)) break; body; } } while (0)
DEVFN void phase_scan(const Ctx& C0, int l, bool second = false) {
    const bool split = C0.ncu > N_SCAN;
    const bool xl = C0.ncu == 256; const bool is_scan = xl ? (C0.cu & 31) < 6 : (C0.cu < N_SCAN || !split);
    if (is_scan && (!second || DBL == 8 || DBL == 9)) { const Ctx C = relaunder(C0);
        if (xl) gdn_scan_unit(C, l, (C.cu >> 5) + 8 * (C.cu & 31)); else for (int u = C.cu; u < N_SCAN; u += C.ncu) gdn_scan_unit(C, l, u); }
    if ((xl ? !is_scan : (C0.cu >= N_SCAN || !split)) && (!second || DBL == 8 || DBL == 10)) { unsigned* qw = (unsigned*)(C0.wsp + WS_CTL) + CW_QUEUE + (l * 2 + (second ? 1 : 0)) * 4 * 64;
        QUEUE_LOOP(qw, N_ATTS, attn_sample_b(C, l, it));
        QUEUE_LOOP(qw + 64, N_GS, gdn_sample_item(C, l, it * 8 + C.wave, (LDSQ float*)(C.lds + C.wave * 512)));
        QUEUE_LOOP(qw + 128, N_CONVA, conv_a_item(C, l, it));
        QUEUE_LOOP(qw + 192, N_MERGE, merge_item(C, it)); }
}
constexpr int SG_A = 0  , SG_B = 18432  ;
struct SEpiU { bf16_t* U;
    DEVMFN void operator()(int row, int col, f32x4 v) const { *(u32x2*)(U + (size_t)(M_P + row) * NU + col) = pack4(v); } };
struct SEpiRes { const float* base; float* X; const float* gate0;
    DEVMFN void operator()(int row, int col, f32x4 v) const { const f32x4 bv = *(const f32x4*)(base + (size_t)row * 1024 + col), gv = *(const f32x4*)(gate0 + (size_t)(NBP + (row >> 2)) * NMOD + col);
        *(f32x4*)(X + (size_t)(M_P + row) * 1024 + col) = bv + (gv + 1.0f) * v; } };
template <class Epi> DEVFN void sgemm_unit(const Ctx& C, const bf16_t* A, const bf16_t* Bt, int tm, int tn, const Epi& E) {
    const int lane = C.lane, quad = lane >> 4, l15 = lane & 15, w = C.wave, wm = w & 1, wn = w >> 1;
    const int lr = C.tid >> 3, c8 = (C.tid & 7) * 8;
    const bf16_t* ga = A + (size_t)(64 * tm + lr) * 1024 + c8; const bf16_t* gb0 = Bt + (size_t)(128 * tn + lr) * 1024 + c8; const bf16_t* gb1 = gb0 + (size_t)64 * 1024;
    LDSQ bf16_t* As = (LDSQ bf16_t*)(C.lds + SG_A); LDSQ bf16_t* Bs = (LDSQ bf16_t*)(C.lds + SG_B);
    f32x4 acc[2][2];
#pragma unroll
    for (int mi = 0; mi < 2; ++mi)
#pragma unroll
        for (int ni = 0; ni < 2; ++ni) acc[mi][ni] = (f32x4){0.f, 0.f, 0.f, 0.f};
    u32x4 ra = *(const u32x4*)ga, rb0 = *(const u32x4*)gb0, rb1 = *(const u32x4*)gb1;
    *(LDSQ u32x4*)(As + lr * LDP + c8) = ra; *(LDSQ u32x4*)(Bs + lr * LDP + c8) = rb0; *(LDSQ u32x4*)(Bs + (64 + lr) * LDP + c8) = rb1;
    ra = *(const u32x4*)(ga + 64); rb0 = *(const u32x4*)(gb0 + 64); rb1 = *(const u32x4*)(gb1 + 64);
    SYNC();
#pragma unroll 1
    for (int c = 0; c < 16; ++c) {
        LDSQ bf16_t* Ac = As + (c & 1) * 4608; LDSQ bf16_t* Bc = Bs + (c & 1) * 9216;
        if (c + 1 < 16) { LDSQ bf16_t* An = As + ((c + 1) & 1) * 4608; LDSQ bf16_t* Bn = Bs + ((c + 1) & 1) * 9216;
            *(LDSQ u32x4*)(An + lr * LDP + c8) = ra; *(LDSQ u32x4*)(Bn + lr * LDP + c8) = rb0; *(LDSQ u32x4*)(Bn + (64 + lr) * LDP + c8) = rb1; }
        if (c + 2 < 16) { ra = *(const u32x4*)(ga + 64 * (c + 2)); rb0 = *(const u32x4*)(gb0 + 64 * (c + 2)); rb1 = *(const u32x4*)(gb1 + 64 * (c + 2)); }
#pragma unroll
        for (int s = 0; s < 2; ++s) { bf16x8 af[2], bfr[2];
#pragma unroll
            for (int mi = 0; mi < 2; ++mi) af[mi] = lds_frag(Ac, LDP, 32 * wm + 16 * mi + l15, 32 * s + 8 * quad);
#pragma unroll
            for (int ni = 0; ni < 2; ++ni) bfr[ni] = lds_frag(Bc, LDP, 32 * wn + 16 * ni + l15, 32 * s + 8 * quad);
#pragma unroll
            for (int mi = 0; mi < 2; ++mi)
#pragma unroll
                for (int ni = 0; ni < 2; ++ni) acc[mi][ni] = mfma16(bfr[ni], af[mi], acc[mi][ni]); }
        SYNC();
    }
#pragma unroll
    for (int mi = 0; mi < 2; ++mi)
#pragma unroll
        for (int ni = 0; ni < 2; ++ni) E(64 * tm + 32 * wm + 16 * mi + l15, 128 * tn + 32 * wn + 16 * ni + 4 * quad, acc[mi][ni]);
}
constexpr int NWAVES = 8;
constexpr int RING_BYTES = LDS_MISC, MISC_OFF = RING_BYTES + 320, LDS_BYTES = 159744;
constexpr int CW_BAR = 4096;
#ifndef DBL
#define DBL 0
#endif
#define GRID_BAR() xcd_barrier(bar)

__device__ __forceinline__ Ctx fresh_ctx(const Args* ap, LDSQ unsigned char* lds) {
    Ctx C; int tid = threadIdx.x; asm volatile("" : "+v"(tid));
    C.tid = tid; C.lane = tid & 63; C.wave = __builtin_amdgcn_readfirstlane(tid >> 6);
    C.ncu = gridDim.x; { const int bx = blockIdx.x; C.cu = (C.ncu % 8 == 0) ? (bx % 8) * (C.ncu / 8) + bx / 8 : bx; }
    C.lds = lds; C.a = ap; return C;
}
template <int L> __device__ __forceinline__ void layer_body(const Args* ap, LDSQ unsigned char* lds, const XcdBarrier& bar) {
        { const Ctx C = fresh_ctx(ap, lds); phase_norm(C, L); }
#if DBL == 1
        GRID_BAR(); { const Ctx C = fresh_ctx(ap, lds); phase_norm(C, L); }
#endif
        GRID_BAR();
        { const Ctx C = fresh_ctx(ap, lds);
            { const SEpiU SE{WSP(bf16_t, WS_U)};
                for (int u = C.cu; u < 256; u += C.ncu) sgemm_unit(C, WSP(bf16_t, WS_HN) + (size_t)M_P * 1024, WSP(bf16_t, WS_WIN) + (size_t)L * 4096 * 1024, u & 7, u >> 3, SE); }
            pg8::Gemm g{WSP(bf16_t, WS_HN), WSP(bf16_t, WS_WIN) + (size_t)L * 4096 * 1024, M_P, NU, 1024}; pg8::StaticOrder S; S.init(M_P, NU, C.ncu, (int)blockIdx.x);
            pg8::EpiU E{WSP(bf16_t, WS_U), NU};
            pg8::gemm_phase<pg8::EpiU, pg8::StaticOrder, true, true>(C.lds, g, S, E);
#if DBL == 2
            GRID_BAR(); pg8::gemm_phase<pg8::EpiU, pg8::StaticOrder, true, true>(C.lds, g, S, E);
#endif
        }
        GRID_BAR();
        { const Ctx C = fresh_ctx(ap, lds); phase_mid(C, L); }
#if DBL >= 3 && DBL <= 7
        GRID_BAR(); { const Ctx C = fresh_ctx(ap, lds); phase_mid(C, L, true); }
#endif
        GRID_BAR();
        { const Ctx C = fresh_ctx(ap, lds); phase_scan(C, L); }
#if DBL >= 8 && DBL <= 10
        GRID_BAR(); { const Ctx C = fresh_ctx(ap, lds); phase_scan(C, L, true); }
#endif
        GRID_BAR();
        { const Ctx C = fresh_ctx(ap, lds);
            const float* X = WSP(float, WS_X);
            { const SEpiRes SE{L == 0 ? C.x_sample : X + (size_t)M_P * 1024, WSP(float, WS_X), WSP(float, WS_MOD) + L * 3072 + 2048};
                for (int u = C.ncu - 1 - C.cu; u < 64; u += C.ncu) sgemm_unit(C, WSP(bf16_t, WS_MIX) + (size_t)M_P * 1024, WSP(bf16_t, WS_WOUT) + (size_t)L * 1024 * 1024, u & 7, u >> 3, SE); }
            pg8::Gemm g{WSP(bf16_t, WS_MIX), WSP(bf16_t, WS_WOUT) + (size_t)L * 1024 * 1024, M_P, 1024, 1024}; pg8::StaticOrder S; S.init(M_P, 1024, C.ncu, (int)blockIdx.x);
            pg8::EpiRes E{L == 0 ? C.x_prompt : X, L == 0 ? C.x_sample : X + (size_t)M_P * 1024, WSP(float, WS_X), WSP(float, WS_MOD) + L * 3072 + 2048};
#if DBL == 13
            { pg8::EpiRes E2 = E; E2.X = WSP(float, WS_U); pg8::gemm_phase<pg8::EpiRes, pg8::StaticOrder, true, true>(C.lds, g, S, E2); GRID_BAR(); }
#endif
            pg8::gemm_phase<pg8::EpiRes, pg8::StaticOrder, true, true>(C.lds, g, S, E);
        }
        GRID_BAR();
    }

__global__ void __launch_bounds__(NWAVES * 64, 2) mega_fwd(Args args) {
    extern __shared__ __attribute__((aligned(16))) unsigned char lds_raw[];
    Ctx C;
    C.lds = (LDSQ unsigned char*)lds_raw;
    C.tid = threadIdx.x; C.lane = C.tid & 63; C.wave = __builtin_amdgcn_readfirstlane(C.tid >> 6);
    C.ncu = gridDim.x; { const int bx = blockIdx.x; C.cu = (C.ncu % 8 == 0) ? (bx % 8) * (C.ncu / 8) + bx / 8 : bx; }
    C.a = &args;
    volatile LDSQ unsigned* MISC = (volatile LDSQ unsigned*)(C.lds + MISC_OFF);
    for (int u = C.tid; u < (LDS_BYTES - RING_BYTES) / 4; u += NWAVES * 64) ((LDSQ unsigned*)(C.lds + RING_BYTES))[u] = 0u;
    __syncthreads();
    unsigned* ctl = (unsigned*)(C.wsp + WS_CTL);
    XcdBarrier bar = xcd_barrier_post(ctl + CW_BAR, MISC + 8);

    phase_p0a(C);
#if DBL == 11
    GRID_BAR(); phase_p0a(C);
#endif
    GRID_BAR();
    layer_body<0>(&args, C.lds, bar); layer_body<1>(&args, C.lds, bar); layer_body<2>(&args, C.lds, bar); layer_body<3>(&args, C.lds, bar);
    { const Ctx C2 = fresh_ctx(&args, C.lds); phase_final(C2); }
#if DBL == 14
    { const Ctx C2 = fresh_ctx(&args, C.lds); phase_final(C2); }
#endif
}

extern "C" void kernel_launch(void* const* d_in, const int* in_sizes, int n_in, void* d_out, int out_size, void* d_ws, size_t ws_size, hipStream_t stream) {
    static int grid = 0;
    if (grid == 0) {
        if (n_in != 23 || out_size != (int)O_END || ws_size < WS_END) { fprintf(stderr, "kernel_launch: unexpected shapes: n_in %d out %d ws %zu\n", n_in, out_size, ws_size); grid = -1; return; }
        int dev = 0, cus = 0, per_cu = 0;
        if (hipGetDevice(&dev) != hipSuccess || hipDeviceGetAttribute(&cus, hipDeviceAttributeMultiprocessorCount, dev) != hipSuccess) { grid = -1; return; }
        if (hipFuncSetAttribute((const void*)mega_fwd, hipFuncAttributeMaxDynamicSharedMemorySize, LDS_BYTES) != hipSuccess) { fprintf(stderr, "kernel_launch: hipFuncSetAttribute failed\n"); grid = -1; return; }
        if (hipOccupancyMaxActiveBlocksPerMultiprocessor(&per_cu, (const void*)mega_fwd, NWAVES * 64, LDS_BYTES) != hipSuccess || per_cu < 1) { fprintf(stderr, "kernel_launch: occupancy query says %d\n", per_cu); }
        (void)hipGetLastError();
        grid = cus;
    }
    if (grid < 0) return;
    if (hipMemsetAsync((char*)d_ws + WS_CTL, 0, CTL_ZERO_BYTES, stream) != hipSuccess) return;
    Args ha{};
    for (int i = 0; i < 23; ++i) ha.in[i] = (const float*)d_in[i];
    ha.out_ = (float*)d_out; ha.ws_ = (unsigned char*)d_ws;
    hipLaunchKernelGGL(mega_fwd, dim3(grid), dim3(NWAVES * 64), LDS_BYTES, stream, ha);
}
```

```cpp
#include <hip/hip_runtime.h>
#include <cstdio>
#include <cstdint>
namespace pg8 {
#define PG8_LAS __attribute__((address_space(3)))
typedef unsigned short bf16_t;
typedef short bf16x8 __attribute__((ext_vector_type(8)));
typedef float f32x4 __attribute__((ext_vector_type(4)));
typedef unsigned u32x4 __attribute__((ext_vector_type(4)));
constexpr int BM = 256, BK = 64, HALF = 128, HTB = HALF * BK * 2  , STAGE_BYTES = 8 * HTB, NXCD = 8, WGM = 8;

__host__ __device__ __forceinline__ int lds_byte(int r, int c) { const int st = (r >> 4) * 2 + (c >> 5), rr = r & 15, cc = c & 31, ob = rr * 64 + cc * 2; return st * 1024 + (ob ^ (((ob >> 9) & 1) << 5)); }
__host__ __device__ __forceinline__ void stage_rc(int b, int& R, int& C) { const int st = b / 1024, sb = b % 1024, swz = sb ^ (((sb >> 9) & 1) << 5); R = (st >> 1) * 16 + swz / 64; C = (st & 1) * 32 + (swz % 64) / 2; }
__host__ __device__ __forceinline__ int perm32(int rho) { const int n = rho >> 4, i = rho & 15; return 8 * (i >> 2) + 4 * n + (i & 3); }

struct Unit { int pm, pn; };
struct Gemm { const bf16_t* A; const bf16_t* Bt; int M, N, K; };

struct StaticOrder {
    int nM, nN, nwg, G, c;
    __host__ __device__ void init(int M, int N, int G_, int c_) { nM = M / BM; nN = N / BM; nwg = nM * nN; G = G_; c = c_; }
    __host__ __device__ bool next(int i, Unit& u) const {
        const long L = (long)i * G + c; if (L >= nwg) return false;
        int wgid = (int)L; { const int q = nwg / NXCD, r = nwg % NXCD, xcd = wgid % NXCD, off = wgid / NXCD; wgid = (xcd < r ? xcd * (q + 1) : r * (q + 1) + (xcd - r) * q) + off; }
        const int nig = WGM * nN, gid = wgid / nig, fm = gid * WGM, gsz = (nM - fm) < WGM ? (nM - fm) : WGM;
        u.pm = fm + ((wgid % nig) % gsz); u.pn = (wgid % nig) / gsz; return true;
    }
    __device__ __forceinline__ void a_ready(const Unit&) const {}
    __device__ __forceinline__ void done(const Unit&) const {}
};

__device__ __forceinline__ unsigned cvt_pk_bf16(float lo, float hi) { unsigned r; asm volatile("v_cvt_pk_bf16_f32 %0, %1, %2" : "=v"(r) : "v"(lo), "v"(hi)); return r; }
template <class Epi, class Sched, bool ALIGN_EPI = false, bool SP2 = false>
__device__ __forceinline__ void gemm_phase(PG8_LAS unsigned char* lds, const Gemm g, const Sched& S, const Epi& E) {
    int tid_ = threadIdx.x; asm volatile("" : "+v"(tid_));
    const int tid = tid_, wid = __builtin_amdgcn_readfirstlane(tid >> 6), lane = tid & 63, wr = wid >> 2, wc = wid & 3, fr = lane & 15, fq = lane >> 4;
    const int K = g.K, nt = K / BK;
    unsigned voffA[2], voffB[2];
#pragma unroll
    for (int i = 0; i < 2; ++i) { int R, C; stage_rc(tid * 16 + i * 8192, R, C); const int Rb = Epi::PERM ? ((R & ~31) + perm32(R & 31)) : R;
        voffA[i] = (unsigned)(R * K + C) * 2u; voffB[i] = (unsigned)(Rb * K + C) * 2u; }
    const size_t kstep = (size_t)(BK * 2);
    const size_t hstep = (size_t)HALF * K * 2;
    const size_t tstep = 2 * hstep;
    const unsigned ldsw = (unsigned)wid * 1024u;
    const int aoff = lds_byte(wr * 64 + fr, fq * 8), boff = lds_byte(wc * 32 + fr, fq * 8);
#define PG8_SA(b, h) (((b) * 2 + (h)) * HTB)
#define PG8_SB(b, h) ((4 + (b) * 2 + (h)) * HTB)
#define PG8_STAGE(bufoff, gbase, voff) do { _Pragma("unroll") for (int _i = 0; _i < 2; ++_i) \
        __builtin_amdgcn_global_load_lds((const unsigned*)((const char*)(gbase) + (voff)[_i]), (PG8_LAS unsigned*)(lds + (bufoff) + ldsw + _i * 8192), 16, 0, 0); } while (0)
#define PG8_LDA(dst, b, h) do { _Pragma("unroll") for (int m = 0; m < 4; ++m) _Pragma("unroll") for (int k = 0; k < 2; ++k) dst[m][k] = *(const PG8_LAS bf16x8*)(lds + PG8_SA(b, h) + aoff + m * 2048 + k * 1024); } while (0)
#define PG8_LDB(dst, b, h) do { _Pragma("unroll") for (int n = 0; n < 2; ++n) _Pragma("unroll") for (int k = 0; k < 2; ++k) dst[n][k] = *(const PG8_LAS bf16x8*)(lds + PG8_SB(b, h) + boff + n * 2048 + k * 1024); } while (0)
#define PG8_MMA(ai, bj, At, Bt) do { __builtin_amdgcn_s_setprio(1); _Pragma("unroll") for (int m = 0; m < 4; ++m) _Pragma("unroll") for (int n = 0; n < 2; ++n) _Pragma("unroll") for (int k = 0; k < 2; ++k) \
        acc[ai][bj][m][n] = __builtin_amdgcn_mfma_f32_16x16x32_bf16(Bt[n][k], At[m][k], acc[ai][bj][m][n], 0, 0, 0); __builtin_amdgcn_s_setprio(0); } while (0)
#define PG8_WAIT_V(n) asm volatile("s_waitcnt vmcnt(" #n ")" ::: "memory")
#define PG8_WAIT_L(n) asm volatile("s_waitcnt lgkmcnt(" #n ")" ::: "memory")
#define PG8_BAR __builtin_amdgcn_s_barrier()
#define PG8_SCHED __builtin_amdgcn_sched_barrier(0)
    Unit cur, nxt; int ui = 0;
    if (!S.next(0, cur)) return;
    f32x4 acc[2][2][4][2];
#pragma unroll
    for (int a = 0; a < 2; ++a)
#pragma unroll
        for (int b = 0; b < 2; ++b)
#pragma unroll
            for (int m = 0; m < 4; ++m)
#pragma unroll
                for (int n = 0; n < 2; ++n) acc[a][b][m][n] = (f32x4){0.f, 0.f, 0.f, 0.f};
    bf16x8 At[4][2], B0[2][2], B1[2][2];
    const char* cA = (const char*)g.A + (size_t)cur.pm * tstep; const char* cB = (const char*)g.Bt + (size_t)cur.pn * tstep;
    S.a_ready(cur);
    if constexpr (SP2) {
        PG8_STAGE(PG8_SB(0, 0), cB, voffB); PG8_STAGE(PG8_SB(0, 1), cB + hstep, voffB); PG8_STAGE(PG8_SA(0, 0), cA, voffA); PG8_STAGE(PG8_SA(0, 1), cA + hstep, voffA);
        if (wr == 1) PG8_BAR;
        PG8_WAIT_V(2); PG8_BAR;
        PG8_STAGE(PG8_SB(1, 0), cB + kstep, voffB); PG8_STAGE(PG8_SA(1, 0), cA + kstep, voffA); PG8_STAGE(PG8_SB(1, 1), cB + hstep + kstep, voffB);
        PG8_WAIT_V(6); PG8_BAR;
    } else {
        PG8_STAGE(PG8_SB(0, 0), cB, voffB); PG8_STAGE(PG8_SA(0, 0), cA, voffA); PG8_STAGE(PG8_SB(0, 1), cB + hstep, voffB); PG8_STAGE(PG8_SA(0, 1), cA + hstep, voffA);
        if (wr == 1) PG8_BAR;
        PG8_WAIT_V(4); PG8_BAR;
        PG8_STAGE(PG8_SB(1, 0), cB + kstep, voffB); PG8_STAGE(PG8_SA(1, 0), cA + kstep, voffA); PG8_STAGE(PG8_SB(1, 1), cB + hstep + kstep, voffB);
        PG8_WAIT_V(6); PG8_BAR;
    }
    for (;;) {
        const bool has_next = S.next(ui + 1, nxt);
        const char* nA = has_next ? (const char*)g.A + (size_t)nxt.pm * tstep : cA; const char* nB = has_next ? (const char*)g.Bt + (size_t)nxt.pn * tstep : cB;
        for (int t = 0; t < nt; t += 2) {
            const bool last = (t == nt - 2);
            const char* a1 = cA + (size_t)(t + 1) * kstep;
            const char* a2 = last ? nA : cA + (size_t)(t + 2) * kstep; const char* b2 = last ? nB : cB + (size_t)(t + 2) * kstep;
            const char* a3 = a2 + kstep; const char* b3 = b2 + kstep;
            if (last && has_next) S.a_ready(nxt);
            if constexpr (SP2) {
            PG8_LDB(B0, 0, 0); PG8_LDB(B1, 0, 1); PG8_SCHED; PG8_LDA(At, 0, 0); PG8_STAGE(PG8_SA(1, 1), a1 + hstep, voffA);
            PG8_WAIT_V(8); PG8_WAIT_L(0); PG8_BAR; PG8_MMA(0, 0, At, B0); PG8_MMA(0, 1, At, B1); PG8_BAR; PG8_SCHED;
            PG8_LDA(At, 0, 1); PG8_STAGE(PG8_SB(0, 0), b2, voffB); PG8_STAGE(PG8_SB(0, 1), b2 + hstep, voffB); PG8_STAGE(PG8_SA(0, 0), a2, voffA);
            PG8_WAIT_V(8); PG8_WAIT_L(0); PG8_BAR; PG8_MMA(1, 0, At, B0); PG8_MMA(1, 1, At, B1); PG8_BAR; PG8_SCHED;
            PG8_LDB(B0, 1, 0); PG8_LDB(B1, 1, 1); PG8_SCHED; PG8_LDA(At, 1, 0); PG8_STAGE(PG8_SA(0, 1), a2 + hstep, voffA);
            PG8_WAIT_V(8); PG8_WAIT_L(0); PG8_BAR; PG8_MMA(0, 0, At, B0); PG8_MMA(0, 1, At, B1); PG8_BAR; PG8_SCHED;
            PG8_LDA(At, 1, 1); PG8_STAGE(PG8_SB(1, 0), b3, voffB); PG8_STAGE(PG8_SB(1, 1), b3 + hstep, voffB); PG8_STAGE(PG8_SA(1, 0), a3, voffA);
            PG8_WAIT_V(8); PG8_WAIT_L(0); PG8_BAR; PG8_MMA(1, 0, At, B0); PG8_MMA(1, 1, At, B1); PG8_BAR; PG8_SCHED;
            } else {
            PG8_LDB(B0, 0, 0); PG8_SCHED; PG8_LDA(At, 0, 0); PG8_STAGE(PG8_SA(1, 1), a1 + hstep, voffA);
            PG8_WAIT_L(8); PG8_BAR; PG8_WAIT_L(0); PG8_MMA(0, 0, At, B0); PG8_BAR; PG8_SCHED;
            PG8_LDB(B1, 0, 1); PG8_STAGE(PG8_SB(0, 0), b2, voffB);
            PG8_BAR; PG8_WAIT_L(0); PG8_MMA(0, 1, At, B1); PG8_BAR;
            PG8_LDA(At, 0, 1); PG8_STAGE(PG8_SA(0, 0), a2, voffA);
            PG8_BAR; PG8_WAIT_L(0); PG8_MMA(1, 0, At, B0); PG8_BAR; PG8_SCHED;
            PG8_STAGE(PG8_SB(0, 1), b2 + hstep, voffB);
            PG8_WAIT_V(6); PG8_BAR; PG8_MMA(1, 1, At, B1); PG8_BAR;
            PG8_LDB(B0, 1, 0); PG8_SCHED; PG8_LDA(At, 1, 0); PG8_STAGE(PG8_SA(0, 1), a2 + hstep, voffA);
            PG8_WAIT_L(8); PG8_BAR; PG8_WAIT_L(0); PG8_MMA(0, 0, At, B0); PG8_BAR; PG8_SCHED;
            PG8_LDB(B1, 1, 1); PG8_STAGE(PG8_SB(1, 0), b3, voffB);
            PG8_BAR; PG8_WAIT_L(0); PG8_MMA(0, 1, At, B1); PG8_BAR;
            PG8_LDA(At, 1, 1); PG8_STAGE(PG8_SA(1, 0), a3, voffA);
            PG8_BAR; PG8_WAIT_L(0); PG8_MMA(1, 0, At, B0); PG8_BAR; PG8_SCHED;
            PG8_STAGE(PG8_SB(1, 1), b3 + hstep, voffB);
            PG8_WAIT_V(6); PG8_BAR; PG8_MMA(1, 1, At, B1); PG8_BAR;
            }
        }
        if constexpr (ALIGN_EPI) { if (wr == 0) PG8_BAR; }
        if constexpr (!Epi::AFTER_DRAIN) { E(acc, cur, wr, wc, fr, fq); S.done(cur); }
        if (!has_next) break;
#pragma unroll
        for (int a = 0; a < 2; ++a)
#pragma unroll
            for (int b = 0; b < 2; ++b)
#pragma unroll
                for (int m = 0; m < 4; ++m)
#pragma unroll
                    for (int n = 0; n < 2; ++n) acc[a][b][m][n] = (f32x4){0.f, 0.f, 0.f, 0.f};
        cur = nxt; cA = nA; cB = nB; ++ui;
        if constexpr (ALIGN_EPI) { if (wr == 1) PG8_BAR; }
    }
    PG8_WAIT_V(0);
    if constexpr (!ALIGN_EPI) { if (wr == 0) PG8_BAR; }
    PG8_BAR;
    if constexpr (Epi::AFTER_DRAIN) { E.fused(acc, cur, wr, wc, fr, fq, lds, wid, lane); S.done(cur); }
#undef PG8_SA
#undef PG8_SB
#undef PG8_STAGE
#undef PG8_LDA
#undef PG8_LDB
#undef PG8_MMA
#undef PG8_WAIT_V
#undef PG8_WAIT_L
#undef PG8_BAR
#undef PG8_SCHED
}
}
namespace pg8 {
struct EpiU { static constexpr bool PERM = true, AFTER_DRAIN = false; bf16_t* O; int ldc;
    __device__ __forceinline__ void operator()(const f32x4 (&acc)[2][2][4][2], const Unit& u, int wr, int wc, int fr, int fq) const {
        const int row0 = u.pm * BM + wr * 64 + fr, col0 = u.pn * BM + wc * 32 + 8 * fq;
#pragma unroll
        for (int ai = 0; ai < 2; ++ai)
#pragma unroll
            for (int m = 0; m < 4; ++m) { bf16_t* rowp = O + (size_t)(row0 + ai * HALF + m * 16) * ldc + col0;
#pragma unroll
                for (int bj = 0; bj < 2; ++bj) { const f32x4 v0 = acc[ai][bj][m][0], v1 = acc[ai][bj][m][1];
                    u32x4 w; w.x = cvt_pk_bf16(v0[0], v0[1]); w.y = cvt_pk_bf16(v0[2], v0[3]); w.z = cvt_pk_bf16(v1[0], v1[1]); w.w = cvt_pk_bf16(v1[2], v1[3]);
                    *(u32x4*)(rowp + bj * HALF) = w; } }
    }
};
struct EpiMod { static constexpr bool PERM = false, AFTER_DRAIN = false; float* O; const float* b_ada; const float* b_fin;
    __device__ __forceinline__ void operator()(const f32x4 (&acc)[2][2][4][2], const Unit& u, int wr, int wc, int fr, int fq) const {
        const int colt = u.pn * BM; const float* bias = colt < 12288 ? b_ada + colt : b_fin + (colt - 12288);
        const int cl = wc * 32 + 4 * fq;
#pragma unroll
        for (int ai = 0; ai < 2; ++ai)
#pragma unroll
            for (int m = 0; m < 4; ++m) { const int row = ai * HALF + wr * 64 + m * 16 + fr;
                if (row < 136) {
#pragma unroll
                    for (int bj = 0; bj < 2; ++bj)
#pragma unroll
                        for (int n = 0; n < 2; ++n) { const int c = cl + bj * HALF + n * 16; const f32x4 bv = *(const f32x4*)(bias + c);
                            *(f32x4*)(O + (size_t)row * 14336 + colt + c) = acc[ai][bj][m][n] + bv; } } }
    }
};
struct EpiRes { static constexpr bool PERM = false, AFTER_DRAIN = false; const float* base_p; const float* base_s; float* X; const float* gate0;
    __device__ __forceinline__ void operator()(const f32x4 (&acc)[2][2][4][2], const Unit& u, int wr, int wc, int fr, int fq) const {
        const int cl = u.pn * BM + wc * 32 + 4 * fq;
#pragma unroll
        for (int ai = 0; ai < 2; ++ai)
#pragma unroll
            for (int m = 0; m < 4; ++m) { const int row = u.pm * BM + ai * HALF + wr * 64 + m * 16 + fr;
                const float* b = row < 16384 ? base_p + (size_t)row * 1024 : base_s + (size_t)(row - 16384) * 1024;
                const int brow = row < 16384 ? (row >> 11) : 8 + ((row - 16384) >> 2);
                const float* g = gate0 + (size_t)brow * 14336; float* o = X + (size_t)row * 1024;
#pragma unroll
                for (int bj = 0; bj < 2; ++bj)
#pragma unroll
                    for (int n = 0; n < 2; ++n) { const int c = cl + bj * HALF + n * 16; const f32x4 bv = *(const f32x4*)(b + c), gv = *(const f32x4*)(g + c);
                        *(f32x4*)(o + c) = bv + (gv + 1.0f) * acc[ai][bj][m][n]; } }
    }
};
}
using pg8::bf16_t; using pg8::bf16x8; using pg8::f32x4; using pg8::u32x4;
#ifdef HOST_EMU
#define DEVFN static inline
#define DEVMFN inline
#define LDSQ
#define GASQ
#else
#define DEVFN __device__ __forceinline__
#define DEVMFN __device__ __forceinline__
#define LDSQ __attribute__((address_space(3)))
#define GASQ __attribute__((address_space(1)))
#endif
typedef short s16x4 __attribute__((ext_vector_type(4)));
typedef float f32x2 __attribute__((ext_vector_type(2)));
typedef unsigned u32x2 __attribute__((ext_vector_type(2)));

constexpr int D_MODEL = 1024, SEQ = 2048, NBP = 8, NBS = 128, DSEQ = 4, DEPTH = 4;
constexpr int M_P = NBP * SEQ, M_S = NBS * DSEQ, M_T = M_P + M_S;
constexpr int IN_W = 4108, NU = 4096, NBROW = NBP + NBS;
constexpr int NMOD = 4 * 3072 + 2048;
constexpr int UC_AX = 0, UC_ACG = 256, UC_ABG = 512, UC_AZ = 768, UC_BQ = 1024, UC_BK = 1408, UC_BV = 1792, UC_BZ = 2176, UC_CQ = 2560, UC_CK = 2944, UC_CV = 3328, UC_CZ = 3712;
constexpr size_t MiB = 1u << 20;
constexpr size_t WS_CTL = 0, CTL_ZERO_BYTES = 1 * MiB;
constexpr size_t WS_WIN = 2 * MiB;
constexpr size_t WS_WOUT = 34 * MiB;
constexpr size_t WS_WADA = 42 * MiB;
constexpr size_t WS_WAB = 70 * MiB;
constexpr size_t WS_ROPE = 71 * MiB;
constexpr size_t WS_CB = 72 * MiB;
constexpr size_t WS_MOD = 73 * MiB;
constexpr size_t WS_AB = 82 * MiB;
constexpr size_t WS_LSE = 84 * MiB;
constexpr size_t WS_GSC = 86 * MiB;
constexpr size_t WS_X = 96 * MiB;
constexpr size_t WS_HN = 162 * MiB;
constexpr size_t WS_MIX = 196 * MiB;
constexpr size_t WS_OC = 230 * MiB;
constexpr size_t WS_U = 256 * MiB;
constexpr size_t WS_GDN = 400 * MiB;
constexpr size_t GDN_CHUNK_BYTES = 40960;
constexpr size_t WS_END = 480 * MiB;
constexpr size_t O_YP = 0, O_YS = 16777216, O_CAP = 17301504, O_CAS = 17317888, O_CBP = 17580032, O_CBS = 17690624, O_GP = 19460096, O_GS = 20246528,
                 O_K128P = 32829440, O_K128S = 33878016, O_K512P = 34402304, O_K512S = 38596608, O_K2048P = 39120896, O_K2048S = 55898112, O_END = 56422400;

DEVFN float bf_lo(unsigned u) { return __builtin_bit_cast(float, u << 16); }
DEVFN float bf_hi(unsigned u) { return __builtin_bit_cast(float, u & 0xffff0000u); }
DEVFN float bf2f(bf16_t h) { return __builtin_bit_cast(float, (unsigned)h << 16); }
#ifdef HOST_EMU
DEVFN unsigned f2bf(float f) { unsigned u = __builtin_bit_cast(unsigned, f); return (u + 0x7fffu + ((u >> 16) & 1u)) >> 16; }
DEVFN unsigned pk2(float lo, float hi) { return f2bf(lo) | (f2bf(hi) << 16); }
DEVFN float EXPF(float x) { return expf(x); }
DEVFN float LOGF(float x) { return logf(x); }
DEVFN float RCPF(float x) { return 1.0f / x; }
DEVFN float RSQF(float x) { return 1.0f / sqrtf(x); }
#else
typedef __bf16 hwbf16x2 __attribute__((ext_vector_type(2)));
DEVFN unsigned pk2(float lo, float hi) { const f32x2 v = {lo, hi}; const hwbf16x2 b = __builtin_convertvector(v, hwbf16x2); return __builtin_bit_cast(unsigned, b); }
DEVFN unsigned f2bf(float f) { return pk2(f, 0.f) & 0xffffu; }
DEVFN float EXPF(float x) { return __builtin_amdgcn_exp2f(x * 1.4426950408889634f); }
DEVFN float LOGF(float x) { return __builtin_amdgcn_logf(x) * 0.6931471805599453f; }
DEVFN float RCPF(float x) { return __builtin_amdgcn_rcpf(x); }
DEVFN float RSQF(float x) { return __builtin_amdgcn_rsqf(x); }
#endif
DEVFN void unpack8(u32x4 v, float* f) { f[0] = bf_lo(v.x); f[1] = bf_hi(v.x); f[2] = bf_lo(v.y); f[3] = bf_hi(v.y); f[4] = bf_lo(v.z); f[5] = bf_hi(v.z); f[6] = bf_lo(v.w); f[7] = bf_hi(v.w); }
DEVFN u32x4 pack8(const float* f) { u32x4 v; v.x = pk2(f[0], f[1]); v.y = pk2(f[2], f[3]); v.z = pk2(f[4], f[5]); v.w = pk2(f[6], f[7]); return v; }
DEVFN float silu_f(float x) { return x * RCPF(1.f + EXPF(-x)); }
DEVFN float sigmoid_f(float x) { return RCPF(1.f + EXPF(-x)); }
DEVFN float softplus_f(float x) { return x > 20.f ? x : log1pf(expf(x)); }

struct Args { const float* in[23]; float* out_; unsigned char* ws_; };
struct Ctx {
    int tid, lane, wave, cu, ncu;
    LDSQ unsigned char* lds;
    const Args* a;
};
#define x_prompt a->in[0]
#define x_sample a->in[1]
#define st_conv_a a->in[2]
#define st_conv_b a->in[3]
#define st_gdn a->in[4]
#define kv128 a->in[5]
#define kv512 a->in[6]
#define kv2048 a->in[7]
#define c_prompt a->in[8]
#define c_sample a->in[9]
#define w_in a->in[10]
#define w_out a->in[11]
#define w_ada a->in[12]
#define b_ada a->in[13]
#define norm_w a->in[14]
#define conv_a_w a->in[15]
#define conv_b_w a->in[16]
#define a_log a->in[17]
#define dt_bias a->in[18]
#define gdn_norm_w a->in[19]
#define final_norm_w a->in[20]
#define w_ada_final a->in[21]
#define b_ada_final a->in[22]
#define outp a->out_
#define wsp a->ws_
constexpr int LDS_MISC = 158208;
constexpr int LDS_QIDX = LDS_MISC + 320 + 64;
constexpr int CW_QUEUE = 32768;
#define WSP(T, off) ((T*)(C.wsp + (off)))
#define LAS __attribute__((address_space(3)))
#define XB_TMO      128
#define XB_XCNT(j)  (256  + 64 * (j))
#define XB_XSUB(j)  (1280 + 64 * (j))
#define XB_XGEN(j)  (2304 + 64 * (j))
#define XB_TOP      3328
#define XB_TOPGEN   3392
#define XCD_BAR_WORDS 3456
#define XB_SPIN_CAP (1u << 18)

__device__ __forceinline__ unsigned xb_ld(unsigned* p)              { return __hip_atomic_load(p, __ATOMIC_RELAXED, __HIP_MEMORY_SCOPE_AGENT); }
__device__ __forceinline__ unsigned xb_add(unsigned* p, unsigned v) { return __hip_atomic_fetch_add(p, v, __ATOMIC_RELAXED, __HIP_MEMORY_SCOPE_AGENT); }
__device__ __forceinline__ unsigned xb_xcc_id() { return (unsigned)__builtin_amdgcn_s_getreg((3 << 11) | 20) & 0xFu; }
#define XB_SPIN(cond, bar) do { unsigned _sp = 0; while (cond) { __builtin_amdgcn_s_sleep(1); \
    if ((++_sp & 255u) == 0u) { if (xb_ld(&(bar)[XB_TMO])) break; if (_sp > XB_SPIN_CAP) { atomicAdd(&(bar)[XB_TMO], 1u); break; } } } } while (0)

struct XcdBarrier {
    unsigned* bar; unsigned x;
    volatile LAS unsigned* st;
};

__device__ __forceinline__ XcdBarrier xcd_barrier_post(unsigned* bar, volatile LAS unsigned* st) {
    XcdBarrier b; b.bar = bar; b.x = xb_xcc_id(); b.st = st;
    if (threadIdx.x == 0) (void)xb_add(&bar[XB_XCNT(b.x)], 1u);
    return b;
}
__device__ __forceinline__ void xcd_barrier_complete(unsigned* bar, unsigned x, unsigned& nloc, unsigned& nx) {
    const unsigned G = gridDim.x * gridDim.y * gridDim.z;
    unsigned sum, cnt, mine, sp = 0u;
    for (;;) {
        sum = 0u; cnt = 0u; mine = 0u;
#pragma unroll
        for (unsigned j = 0; j < 16; ++j) { const unsigned c = xb_ld(&bar[XB_XCNT(j)]); sum += c; cnt += (c > 0u) ? 1u : 0u; mine = (j == x) ? c : mine; }
        if (sum == G) break;
        __builtin_amdgcn_s_sleep(1);
        if ((++sp & 255u) == 0u) { if (xb_ld(&bar[XB_TMO])) break; if (sp > XB_SPIN_CAP) { atomicAdd(&bar[XB_TMO], 1u); break; } }
    }
    nloc = mine > 0u ? mine : 1u; nx = cnt > 0u ? cnt : 1u;
}

__device__ __forceinline__ void xcd_barrier(const XcdBarrier& b) {
    asm volatile("s_waitcnt vmcnt(0)" ::: "memory");
    __syncthreads();
    if (threadIdx.x == 0) {
        unsigned* bar = b.bar;
        __builtin_amdgcn_s_waitcnt(0);
        unsigned nloc = b.st[0], nx = b.st[1];
        if (nloc == 0u) { xcd_barrier_complete(bar, b.x, nloc, nx); b.st[0] = nloc; b.st[1] = nx; }
        const unsigned old = xb_add(&bar[XB_XSUB(b.x)], 1u);
        const unsigned gen = old / nloc;
        if (old + 1u == (gen + 1u) * nloc) {
            __builtin_amdgcn_fence(__ATOMIC_RELEASE, "agent");
            asm volatile("s_waitcnt vmcnt(0)" ::: "memory");
            const unsigned og = xb_add(&bar[XB_TOP], 1u);
            const unsigned tg = og / nx;
            if (og + 1u == (tg + 1u) * nx) xb_add(&bar[XB_TOPGEN], 1u);
            else XB_SPIN(xb_ld(&bar[XB_TOPGEN]) == tg, bar);
            __builtin_amdgcn_fence(__ATOMIC_ACQUIRE, "agent");
            xb_add(&bar[XB_XGEN(b.x)], 1u);
            asm volatile("s_waitcnt vmcnt(0)" ::: "memory");
        } else {
            XB_SPIN(xb_ld(&bar[XB_XGEN(b.x)]) == gen, bar);
            __builtin_amdgcn_fence(__ATOMIC_ACQUIRE, "agent");
            asm volatile("s_waitcnt vmcnt(0)" ::: "memory");
        }
    }
    __syncthreads();
}
#define SYNC() __syncthreads()
#define WAVE_LDS_FENCE() do { asm volatile("s_waitcnt lgkmcnt(0)" ::: "memory"); } while (0)
#define COMPILER_MEM_FENCE() asm volatile("" ::: "memory")
#define FAST_SIN(x) __sinf(x)
#define FAST_COS(x) __cosf(x)
DEVFN f32x4 mfma16(bf16x8 a, bf16x8 b, f32x4 c) { return __builtin_amdgcn_mfma_f32_16x16x32_bf16(a, b, c, 0, 0, 0); }
DEVFN float shfl_xor_f(float v, int m) { return __shfl_xor(v, m); }
DEVFN float shfl_f(float v, int src) { return __shfl(v, src); }
DEVFN float shfl_up_f(float v, int d) { return __shfl_up(v, d); }
DEVFN Ctx relaunder(const Ctx& C0) {
    Ctx C = C0; int tid = C0.tid; asm volatile("" : "+v"(tid)); C.tid = tid; C.lane = tid & 63; C.wave = __builtin_amdgcn_readfirstlane(tid >> 6); return C;
}
DEVFN float FMA_OP(float a, float b, float c) { float r; asm("v_fma_f32 %0, %1, %2, %3" : "=v"(r) : "v"(a), "v"(b), "v"(c)); return r; }
#define QUEUE_PULL(p) __hip_atomic_fetch_add((p), 1u, __ATOMIC_RELAXED, __HIP_MEMORY_SCOPE_AGENT)
#define VM_DRAIN() asm volatile("s_waitcnt vmcnt(0)" ::: "memory")
#define VM_WAIT_N(n) asm volatile("s_waitcnt vmcnt(" #n ")" ::: "memory")
#define RAW_SYNC() do { asm volatile("s_waitcnt lgkmcnt(0)" ::: "memory"); __builtin_amdgcn_s_barrier(); asm volatile("" ::: "memory"); } while (0)
#define DMA16(gptr, ldsbase, lane) __builtin_amdgcn_global_load_lds((const unsigned*)(gptr), (LDSQ unsigned*)(ldsbase), 16, 0, 0)
DEVFN bf16x8 lds_frag_a(const LDSQ bf16_t* base, int ld, int row, int col) { return *(const LDSQ bf16x8*)(base + row * ld + col); }
DEVFN u32x2 pack4(f32x4 v) { u32x2 o; o.x = pk2(v.x, v.y); o.y = pk2(v.z, v.w); return o; }
DEVFN float wave_sum(float v) {
#pragma unroll
    for (int o = 1; o < 64; o <<= 1) v += shfl_xor_f(v, o);
    return v;
}
DEVFN void p0_transpose_item(const float* W, int N, int nsrc0, bf16_t* WT, int ndst0, int k0, LDSQ float* scr, int lane) {
    float tv[32];
#pragma unroll
    for (int i = 0; i < 32; ++i) tv[i] = W[(size_t)(k0 + 2 * i + (lane >> 5)) * N + nsrc0 + (lane & 31)];
#pragma unroll
    for (int i = 0; i < 32; ++i) scr[(2 * i + (lane >> 5)) * 33 + (lane & 31)] = tv[i];
    WAVE_LDS_FENCE();
    const int c = lane & 7;
#pragma unroll
    for (int j = 0; j < 4; ++j) { const int n = (lane >> 3) + 8 * j; const LDSQ float* s = scr + (8 * c) * 33 + n;
        u32x4 o; o.x = pk2(s[0 * 33], s[1 * 33]); o.y = pk2(s[2 * 33], s[3 * 33]); o.z = pk2(s[4 * 33], s[5 * 33]); o.w = pk2(s[6 * 33], s[7 * 33]);
        *(u32x4*)(WT + (size_t)(ndst0 + n) * 1024 + k0 + 8 * c) = o; }
    WAVE_LDS_FENCE();
}
constexpr int ADA_LDC = 264;
DEVFN void adaln_group(const Ctx& C, int grp) {
    const int lane = C.lane, quad = lane >> 4, l15 = lane & 15, w = C.wave;
    LDSQ bf16_t* cl = (LDSQ bf16_t*)C.lds;
    const int n0 = 16 * (4 * grp + (w & 3));
    const bool fin = n0 >= 12288; const int li = n0 / 3072;
    const float* W = fin ? C.w_ada_final + (n0 - 12288) : C.w_ada + (size_t)li * 1024 * 3072 + (n0 - li * 3072); const int ldw = fin ? 2048 : 3072;
    f32x4 acc[9];
#pragma unroll
    for (int mt = 0; mt < 9; ++mt) acc[mt] = (f32x4){0.f, 0.f, 0.f, 0.f};
#pragma unroll 1
    for (int kq = 0; kq < 4; ++kq) {
        for (int i = C.tid; i < 144 * 32; i += 512) { const int row = i >> 5, c8 = (i & 31) * 8; float v[8];
            if (row < NBROW) { const float* src = (row < NBP ? C.c_prompt + (size_t)row * 1024 : C.c_sample + (size_t)(row - NBP) * 1024) + 256 * kq + c8;
                const f32x4 a = *(const f32x4*)src, bq = *(const f32x4*)(src + 4); v[0] = a.x; v[1] = a.y; v[2] = a.z; v[3] = a.w; v[4] = bq.x; v[5] = bq.y; v[6] = bq.z; v[7] = bq.w; }
            else {
#pragma unroll
                for (int e = 0; e < 8; ++e) v[e] = 0.f; }
            *(LDSQ u32x4*)(cl + row * ADA_LDC + c8) = pack8(v); }
        SYNC();
        if (w < 4) {
#pragma unroll 2
            for (int ss = 0; ss < 8; ++ss) { const int k0 = 256 * kq + 32 * ss + 8 * quad; float wv[8];
#pragma unroll
                for (int j = 0; j < 8; ++j) wv[j] = W[(size_t)(k0 + j) * ldw + l15];
                const bf16x8 bfr = __builtin_bit_cast(bf16x8, pack8(wv));
#pragma unroll
                for (int mt = 0; mt < 9; ++mt) acc[mt] = mfma16(lds_frag_a(cl, ADA_LDC, 16 * mt + l15, 32 * ss + 8 * quad), bfr, acc[mt]); } }
        SYNC();
    }
    if (w < 4) { const float bias = fin ? C.b_ada_final[n0 - 12288 + l15] : C.b_ada[n0 + l15]; float* MOD = WSP(float, WS_MOD);
#pragma unroll
        for (int mt = 0; mt < 9; ++mt)
#pragma unroll
            for (int r = 0; r < 4; ++r) { const int row = 16 * mt + 4 * quad + r; if (row < NBROW) MOD[(size_t)row * NMOD + n0 + l15] = acc[mt][r] + bias; } }
}
DEVFN void phase_p0a(const Ctx& C) {
    for (int g = C.cu; g < 224; g += C.ncu) adaln_group(C, g);
    LDSQ float* scr = (LDSQ float*)(C.lds + C.wave * 16384);
    const int gw = C.cu * 8 + C.wave, NGW = C.ncu * 8;
    bf16_t* WIN = WSP(bf16_t, WS_WIN); bf16_t* WOUT = WSP(bf16_t, WS_WOUT);
    constexpr int I_IN = 4 * 16 * 128, I_OUT = 4 * 16 * 32;
    for (int it = gw; it < I_IN + I_OUT; it += NGW) {
        int r = it;
        if (r < I_IN) { const int l = r / 2048, rr = r % 2048, kb = rr / 128, nb = rr % 128, nd = 32 * nb, ns = nd < 2560 ? nd : nd + 12;
            p0_transpose_item(C.w_in + (size_t)l * 1024 * IN_W, IN_W, ns, WIN + (size_t)l * 4096 * 1024, nd, 64 * kb, scr, C.lane); continue; }
        r -= I_IN;
        { const int l = r / 512, rr = r % 512, kb = rr / 32, nb = rr % 32;
            p0_transpose_item(C.w_out + (size_t)l * 1024 * 1024, 1024, 32 * nb, WOUT + (size_t)l * 1024 * 1024, 32 * nb, 64 * kb, scr, C.lane); }
    }
    const int gt = C.cu * 512 + C.tid, NGT = C.ncu * 512;
    bf16_t* WABT = WSP(bf16_t, WS_WAB);
    for (int i = gt; i < 4 * 16 * 1024; i += NGT) { const int l = i >> 14, j = (i >> 10) & 15, k = i & 1023; WABT[i] = (bf16_t)f2bf(j < 12 ? C.w_in[((size_t)l * 1024 + k) * IN_W + 2560 + j] : 0.f); }
    float* ROPE = WSP(float, WS_ROPE);
    for (int i = gt; i < 2052 * 8; i += NGT) { const int pos = i >> 3, j = i & 7;
        const float invf[8] = {1.0f, 0.1939227432012558f, 0.03760603070259094f, 0.007292664609849453f, 0.0014142135623842478f, 0.00027424818836152554f, 5.3182957344688475e-05f, 1.0313385246263351e-05f};
        float fr = 1.0f;
#pragma unroll
        for (int q = 0; q < 8; ++q) fr = (j == q) ? invf[q] : fr;
        const float ang = (float)pos * fr;
        const double a = (double)ang, tw = 6.283185307179586476925;
        const double kq = __builtin_floor(a / tw + 0.5); const float red = (float)(a - kq * tw);
        ROPE[pos * 16 + j] = FAST_COS(red); ROPE[pos * 16 + 8 + j] = FAST_SIN(red); }
}
DEVFN int brow_of(int m) { return m < M_P ? (m >> 11) : NBP + ((m - M_P) >> 2); }
DEVFN const float* xrow_l0(const Ctx& C, int m) { return m < M_P ? C.x_prompt + (size_t)m * 1024 : C.x_sample + (size_t)(m - M_P) * 1024; }
constexpr int NRM_LD = 1032;
DEVFN void phase_norm(const Ctx& C, int l) {
    const int gw = C.cu * 8 + C.wave, NGW = C.ncu * 8, lane = C.lane, quad = lane >> 4, l15 = lane & 15;
    const float* X = WSP(float, WS_X); bf16_t* HN = WSP(bf16_t, WS_HN); float* AB = WSP(float, WS_AB);
    const float* MOD = WSP(float, WS_MOD); const bf16_t* WABT = WSP(bf16_t, WS_WAB) + l * 16 * 1024;
    const f32x4* nw = (const f32x4*)(C.norm_w + l * 1024) + lane;
    LDSQ bf16_t* hl = (LDSQ bf16_t*)(C.lds + C.wave * (9 * NRM_LD * 2));
    const bool even = NGW == 2048; const int ngrp = even ? NGW : M_T / 8;
    for (int grp = gw; grp < ngrp; grp += NGW) {
        const int m0 = even ? grp * 8 + (grp < 512 ? grp : 512) : grp * 8, nrow = even && grp < 512 ? 9 : 8;
        f32x4 gv[4], sv[4]; int cur = -1;
#pragma unroll 2
        for (int r = 0; r < nrow; ++r) { const int m = m0 + r;
            const f32x4* xr = (const f32x4*)(l == 0 ? xrow_l0(C, m) : X + (size_t)m * 1024) + lane;
            f32x4 v[4]; float s = 0.f;
#pragma unroll
            for (int j = 0; j < 4; ++j) { v[j] = xr[64 * j]; s += (v[j].x * v[j].x + v[j].y * v[j].y) + (v[j].z * v[j].z + v[j].w * v[j].w); }
            const int br = brow_of(m);
            if (br != cur) { cur = br; const float* mod = MOD + (size_t)br * NMOD + l * 3072;
#pragma unroll
                for (int j = 0; j < 4; ++j) { sv[j] = ((const f32x4*)mod)[64 * j + lane]; gv[j] = nw[64 * j] * (((const f32x4*)(mod + 1024))[64 * j + lane] + 1.0f); } }
            const float rstd = RSQF(wave_sum(s) * (1.f / 1024.f) + 1e-6f);
            u32x2* o8 = (u32x2*)(HN + (size_t)m * 1024) + lane;
#pragma unroll
            for (int j = 0; j < 4; ++j) { const f32x4 y = v[j] * rstd * gv[j] + sv[j]; const u32x2 o = pack4(y); o8[64 * j] = o; *(LDSQ u32x2*)(hl + r * NRM_LD + 256 * j + 4 * lane) = o; } }
        WAVE_LDS_FENCE();
        f32x4 a0 = {0.f, 0.f, 0.f, 0.f}, a1 = a0, a2 = a0, a3 = a0; const int rsel = l15 < nrow ? l15 : nrow - 1;
#pragma unroll
        for (int s = 0; s < 32; s += 4) {
            a0 = mfma16(lds_frag_a(hl, NRM_LD, rsel, 32 * s + 8 * quad), *(const bf16x8*)(WABT + l15 * 1024 + 32 * s + 8 * quad), a0);
            a1 = mfma16(lds_frag_a(hl, NRM_LD, rsel, 32 * (s + 1) + 8 * quad), *(const bf16x8*)(WABT + l15 * 1024 + 32 * (s + 1) + 8 * quad), a1);
            a2 = mfma16(lds_frag_a(hl, NRM_LD, rsel, 32 * (s + 2) + 8 * quad), *(const bf16x8*)(WABT + l15 * 1024 + 32 * (s + 2) + 8 * quad), a2);
            a3 = mfma16(lds_frag_a(hl, NRM_LD, rsel, 32 * (s + 3) + 8 * quad), *(const bf16x8*)(WABT + l15 * 1024 + 32 * (s + 3) + 8 * quad), a3); }
        const f32x4 acc = (a0 + a1) + (a2 + a3);
        if (l15 < 12) {
#pragma unroll
            for (int r = 0; r < 4; ++r) if (4 * quad + r < nrow) AB[(size_t)(m0 + 4 * quad + r) * 16 + l15] = acc[r]; }
        WAVE_LDS_FENCE();
    }
}
DEVFN void phase_final(const Ctx& C) {
    const int gw = C.cu * 8 + C.wave, NGW = C.ncu * 8;
    const float* X = WSP(float, WS_X); const float* MOD = WSP(float, WS_MOD);
    const f32x4* nw = (const f32x4*)C.final_norm_w + C.lane;
    const bool even = NGW == 2048; const int ngrp = even ? NGW : M_T / 8;
    for (int grp = gw; grp < ngrp; grp += NGW) {
        const int m0 = even ? grp * 8 + (grp < 512 ? grp : 512) : grp * 8, nrow = even && grp < 512 ? 9 : 8;
        f32x4 gv[4], sv[4]; int cur = -1;
#pragma unroll 2
        for (int r = 0; r < nrow; ++r) { const int m = m0 + r;
            const f32x4* xr = (const f32x4*)(X + (size_t)m * 1024) + C.lane;
            f32x4 v[4]; float s = 0.f;
#pragma unroll
            for (int j = 0; j < 4; ++j) { v[j] = xr[64 * j]; s += (v[j].x * v[j].x + v[j].y * v[j].y) + (v[j].z * v[j].z + v[j].w * v[j].w); }
            const int br = brow_of(m);
            if (br != cur) { cur = br; const float* mod = MOD + (size_t)br * NMOD + 12288;
#pragma unroll
                for (int j = 0; j < 4; ++j) { sv[j] = ((const f32x4*)mod)[64 * j + C.lane]; gv[j] = nw[64 * j] * (((const f32x4*)(mod + 1024))[64 * j + C.lane] + 1.0f); } }
            const float rstd = RSQF(wave_sum(s) * (1.f / 1024.f) + 1e-6f);
            f32x4* o = (f32x4*)(C.outp + (m < M_P ? O_YP + (size_t)m * 1024 : O_YS + (size_t)(m - M_P) * 1024)) + C.lane;
#pragma unroll
            for (int j = 0; j < 4; ++j) o[64 * j] = v[j] * rstd * gv[j] + sv[j]; }
    }
}
DEVFN bf16x8 lds_frag(const LDSQ bf16_t* base, int ld, int row, int col) { return *(const LDSQ bf16x8*)(base + row * ld + col); }
DEVFN bf16x8 glb_frag(const bf16_t* base, int ld, int row, int col) { return *(const bf16x8*)(base + (size_t)row * ld + col); }
DEVFN bf16x8 zero_frag() { bf16x8 z = {0, 0, 0, 0, 0, 0, 0, 0}; return z; }
constexpr int LDP = 72;
constexpr float NEG_BIG = -1e30f;
DEVFN int inv_perm(int c) { return (c & 32) | (((c >> 2) & 3) << 3) | (((c >> 4) & 1) << 2) | (c & 3); }
DEVFN bf16x8 acc_pair_frag(f32x4 lo, f32x4 hi) { const u32x4 u = {pk2(lo.x, lo.y), pk2(lo.z, lo.w), pk2(hi.x, hi.y), pk2(hi.z, hi.w)}; return __builtin_bit_cast(bf16x8, u); }

DEVFN void conv_a_item(const Ctx& C, int l, int item) {
    const bf16_t* U = WSP(bf16_t, WS_U); bf16_t* MIX = WSP(bf16_t, WS_MIX);
    const int rl = C.tid >> 5, ch = (C.tid & 31) * 8;
    float w[3][8];
#pragma unroll
    for (int j = 0; j < 3; ++j)
#pragma unroll
        for (int e = 0; e < 8; ++e) w[j][e] = C.conv_a_w[(l * 3 + j) * 256 + ch + e];
    for (int pass = 0; pass < 4; ++pass) {
        const int m = item * 64 + pass * 16 + rl;
        const bool smp = m >= M_P; const int b = smp ? (m - M_P) >> 2 : m >> 11, t = smp ? (m - M_P) & 3 : m & 2047;
        float P[3][8];
#pragma unroll
        for (int j = 0; j < 3; ++j) { const int tt = t - 2 + j;
            if (tt >= 0) { const size_t r = (size_t)(m - 2 + j) * NU; float a[8], c[8];
                unpack8(*(const u32x4*)(U + r + UC_AX + ch), a); unpack8(*(const u32x4*)(U + r + UC_ACG + ch), c);
#pragma unroll
                for (int e = 0; e < 8; ++e) P[j][e] = a[e] * c[e]; }
            else if (smp) { const float* s = C.st_conv_a + ((size_t)(l * NBS + b) * 2 + (tt + 2)) * 256 + ch;
#pragma unroll
                for (int e = 0; e < 8; ++e) P[j][e] = s[e]; }
            else {
#pragma unroll
                for (int e = 0; e < 8; ++e) P[j][e] = 0.f; } }
        float bg[8], z[8], y[8];
        unpack8(*(const u32x4*)(U + (size_t)m * NU + UC_ABG + ch), bg); unpack8(*(const u32x4*)(U + (size_t)m * NU + UC_AZ + ch), z);
#pragma unroll
        for (int e = 0; e < 8; ++e) y[e] = bg[e] * (w[0][e] * P[0][e] + w[1][e] * P[1][e] + w[2][e] * P[2][e]) * silu_f(z[e]);
        *(u32x4*)(MIX + (size_t)m * 1024 + ch) = pack8(y);
        const int last = smp ? 4 : 2048;
        if (t >= last - 2) { float* o = C.outp + (smp ? O_CAS + ((size_t)(l * NBS + b) * 2 + (t - 2)) * 256 : O_CAP + ((size_t)(l * NBP + b) * 2 + (t - 2046)) * 256) + ch;
#pragma unroll
            for (int e = 0; e < 8; ++e) o[e] = P[2][e]; }
    }
}

constexpr int GP_KN = 0, GP_QN = 9216, GP_VBT = 18432, GP_KBGT = 27648, GP_KDT = 36864, GP_LB = 46080, GP_TR = 55296, GP_TT = 64512, GP_AM = 73728, GP_WM = 82944,
              GP_LF = 92160  , GP_PT = 109568  , GP_QT = 112128  , GP_G = 114688  ;
DEVFN void gdn_prep_item(const Ctx& C, int l, int item) {
    const int b = item / 192, h = (item / 32) % 6, n = item % 32;
    const int lane = C.lane, quad = lane >> 4, l15 = lane & 15, wave = C.wave;
    const bf16_t* U = WSP(bf16_t, WS_U); const float* AB = WSP(float, WS_AB);
    unsigned char* cbase = C.wsp + WS_GDN + (size_t)item * GDN_CHUNK_BYTES;
    bf16_t* gWm = (bf16_t*)cbase; bf16_t* gQG = (bf16_t*)(cbase + 8192); bf16_t* gAm = (bf16_t*)(cbase + 16384); bf16_t* gKDt = (bf16_t*)(cbase + 24576); bf16_t* gUt = (bf16_t*)(cbase + 32768);
    LDSQ bf16_t* Kn = (LDSQ bf16_t*)(C.lds + GP_KN); LDSQ bf16_t* Qn = (LDSQ bf16_t*)(C.lds + GP_QN); LDSQ bf16_t* VbT = (LDSQ bf16_t*)(C.lds + GP_VBT);
    LDSQ bf16_t* KbgT = (LDSQ bf16_t*)(C.lds + GP_KBGT); LDSQ bf16_t* KDt = (LDSQ bf16_t*)(C.lds + GP_KDT); LDSQ bf16_t* Lb = (LDSQ bf16_t*)(C.lds + GP_LB);
    LDSQ bf16_t* Tr = (LDSQ bf16_t*)(C.lds + GP_TR); LDSQ bf16_t* Tt = (LDSQ bf16_t*)(C.lds + GP_TT); LDSQ bf16_t* Am = (LDSQ bf16_t*)(C.lds + GP_AM); LDSQ bf16_t* Wm = (LDSQ bf16_t*)(C.lds + GP_WM);
    LDSQ float* Lf = (LDSQ float*)(C.lds + GP_LF); LDSQ bf16_t* PT = (LDSQ bf16_t*)(C.lds + GP_PT); LDSQ bf16_t* QT = (LDSQ bf16_t*)(C.lds + GP_QT);
    LDSQ float* gl = (LDSQ float*)(C.lds + GP_G); LDSQ float* gcl = gl + 64; LDSQ float* betal = gl + 128;
    const int i = C.tid >> 3, cg = C.tid & 7, t = 64 * n + i;
    const size_t row = (size_t)b * 2048 + t;
    float q[8], k[8], v[8], xq[8], xk[8], xv[8];
#pragma unroll
    for (int e = 0; e < 8; ++e) { q[e] = 0.f; k[e] = 0.f; v[e] = 0.f; xq[e] = 0.f; xk[e] = 0.f; xv[e] = 0.f; }
    const int cq = h * 64 + 8 * cg;
#pragma unroll
    for (int j = 0; j < 4; ++j) { const int tt = t - 3 + j;
        if (tt >= 0) { const bf16_t* ur = U + (row - 3 + j) * NU + cq;
            unpack8(*(const u32x4*)(ur + UC_BQ), xq); unpack8(*(const u32x4*)(ur + UC_BK), xk); unpack8(*(const u32x4*)(ur + UC_BV), xv);
            const float* wr_ = C.conv_b_w + (size_t)(l * 4 + j) * 1152 + cq;
#pragma unroll
            for (int e = 0; e < 8; ++e) { q[e] += xq[e] * wr_[e]; k[e] += xk[e] * wr_[384 + e]; v[e] += xv[e] * wr_[768 + e]; } } }
    if (n == 31 && i >= 61) { float* o = C.outp + O_CBP + ((size_t)(l * NBP + b) * 3 + (i - 61)) * 1152 + cq;
#pragma unroll
        for (int e = 0; e < 8; ++e) { o[e] = xq[e]; o[384 + e] = xk[e]; o[768 + e] = xv[e]; } }
    float sq = 0.f, sk = 0.f;
#pragma unroll
    for (int e = 0; e < 8; ++e) { q[e] = silu_f(q[e]); k[e] = silu_f(k[e]); v[e] = silu_f(v[e]); sq += q[e] * q[e]; sk += k[e] * k[e]; }
    sq += shfl_xor_f(sq, 1); sq += shfl_xor_f(sq, 2); sq += shfl_xor_f(sq, 4);
    sk += shfl_xor_f(sk, 1); sk += shfl_xor_f(sk, 2); sk += shfl_xor_f(sk, 4);
    const float rq = 0.125f * RSQF(sq + 1e-6f), rk = RSQF(sk + 1e-6f);
#pragma unroll
    for (int e = 0; e < 8; ++e) { q[e] *= rq; k[e] *= rk; }
    if (cg == 0) { const float ga = AB[row * 16 + h], gb = AB[row * 16 + 6 + h];
        gl[i] = -EXPF(C.a_log[l * 6 + h]) * softplus_f(ga + C.dt_bias[l * 6 + h]); betal[i] = sigmoid_f(gb); }
    for (int e = C.tid; e < 2 * 64 * LDP / 2; e += 512) ((LDSQ unsigned*)Tr)[e] = 0u;
    SYNC();
    if (wave == 0) { float x = gl[lane];
#pragma unroll
        for (int d = 1; d < 64; d <<= 1) { const float y = shfl_up_f(x, d); if (lane >= d) x += y; }
        gcl[lane] = x; }
    SYNC();
    const float gci = gcl[i], glast = gcl[63], bi = betal[i];
    const float egc = EXPF(gci), ekd = EXPF(glast - gci);
    {
        float tq[8];
#pragma unroll
        for (int e = 0; e < 8; ++e) tq[e] = q[e] * egc;
        { const int c0 = 32 * (cg >> 2) + 16 * (cg & 1) + 4 * ((cg >> 1) & 1);
            *(u32x2*)(gQG + i * 64 + c0) = (u32x2){pk2(tq[0], tq[1]), pk2(tq[2], tq[3])}; *(u32x2*)(gQG + i * 64 + c0 + 8) = (u32x2){pk2(tq[4], tq[5]), pk2(tq[6], tq[7])}; }
        *(LDSQ u32x4*)(Kn + i * LDP + 8 * cg) = pack8(k); *(LDSQ u32x4*)(Qn + i * LDP + 8 * cg) = pack8(q);
#pragma unroll
        for (int e = 0; e < 8; ++e) { const int d = 8 * cg + e;
            VbT[d * LDP + i] = (bf16_t)f2bf(v[e] * bi); KbgT[d * LDP + i] = (bf16_t)f2bf(k[e] * bi * egc); KDt[d * LDP + inv_perm(i)] = (bf16_t)f2bf(k[e] * ekd); }
    }
    SYNC();
#pragma unroll 1
    for (int jj = 0; jj < 4; ++jj) { const int job = wave * 4 + jj, type = job >> 4, it = (job & 15) >> 2, jt = job & 3;
        if (it < jt) { if (type == 1) {
#pragma unroll
                for (int r = 0; r < 4; ++r) Am[(16 * it + 4 * quad + r) * LDP + inv_perm(16 * jt + l15)] = 0; }
            continue; }
        f32x4 acc = {0.f, 0.f, 0.f, 0.f};
#pragma unroll
        for (int s = 0; s < 2; ++s) { const bf16x8 a = lds_frag(type ? Qn : Kn, LDP, 16 * it + l15, 32 * s + 8 * quad), bb = lds_frag(Kn, LDP, 16 * jt + l15, 32 * s + 8 * quad);
            acc = mfma16(a, bb, acc); }
        const int jc = 16 * jt + l15; const float gj = gcl[jc];
#pragma unroll
        for (int r = 0; r < 4; ++r) { const int ir = 16 * it + 4 * quad + r; const float gi = gcl[ir];
            if (type == 0) { const float val = (ir > jc) ? betal[ir] * acc[r] * EXPF(gi - gj) : 0.f; Lf[ir * 68 + jc] = val; Lb[ir * LDP + jc] = (bf16_t)f2bf(val); }
            else { const float val = (ir >= jc) ? acc[r] * EXPF(gi - gj) : 0.f; Am[ir * LDP + inv_perm(jc)] = (bf16_t)f2bf(val); } }
    }
    SYNC();
    if (wave == 0) { const int blk = quad, c = l15; float x[16];
#pragma unroll
        for (int ii = 0; ii < 16; ++ii) { float s = (ii == c) ? 1.f : 0.f;
#pragma unroll
            for (int jx = 0; jx < ii; ++jx) s -= Lf[(16 * blk + ii) * 68 + 16 * blk + jx] * x[jx];
            x[ii] = s; }
#pragma unroll
        for (int ii = 0; ii < 16; ++ii) Tr[(16 * blk + ii) * LDP + 16 * blk + c] = (bf16_t)f2bf(x[ii]);
        *(LDSQ u32x4*)(Tt + (16 * blk + c) * LDP + 16 * blk) = pack8(x); *(LDSQ u32x4*)(Tt + (16 * blk + c) * LDP + 16 * blk + 8) = pack8(x + 8); }
    SYNC();
    if (wave < 2) { const int rb = 2 * wave + 1, cb = 2 * wave; LDSQ bf16_t* pt = PT + wave * 16 * 40;
        bf16x8 a = quad < 2 ? lds_frag(Lb, LDP, 16 * rb + l15, 16 * cb + 8 * quad) : zero_frag();
        bf16x8 bb = quad < 2 ? lds_frag(Tt, LDP, 16 * cb + l15, 16 * cb + 8 * quad) : zero_frag();
        f32x4 z = {0.f, 0.f, 0.f, 0.f}; f32x4 p = mfma16(a, bb, z);
        *(LDSQ u32x2*)(pt + l15 * 40 + 4 * quad) = pack4(p);
        WAVE_LDS_FENCE();
        a = quad < 2 ? lds_frag(Tr, LDP, 16 * rb + l15, 16 * rb + 8 * quad) : zero_frag();
        bb = quad < 2 ? lds_frag(pt, 40, l15, 8 * quad) : zero_frag();
        f32x4 r4 = mfma16(a, bb, z); r4 = -r4;
#pragma unroll
        for (int r = 0; r < 4; ++r) Tr[(16 * rb + 4 * quad + r) * LDP + 16 * cb + l15] = (bf16_t)f2bf(r4[r]);
        *(LDSQ u32x2*)(Tt + (16 * cb + l15) * LDP + 16 * rb + 4 * quad) = pack4(r4); }
    SYNC();
    if (wave < 4) { const int it2 = wave >> 1, jt2 = wave & 1;
        const bf16x8 a = lds_frag(Lb, LDP, 32 + 16 * it2 + l15, 8 * quad), bb = lds_frag(Tt, LDP, 16 * jt2 + l15, 8 * quad);
        f32x4 z = {0.f, 0.f, 0.f, 0.f}; const f32x4 p = mfma16(a, bb, z);
        *(LDSQ u32x2*)(QT + (16 * jt2 + l15) * 40 + 16 * it2 + 4 * quad) = pack4(p); }
    SYNC();
    if (wave < 4) { const int it2 = wave >> 1, jt2 = wave & 1;
        const bf16x8 a = lds_frag(Tr, LDP, 32 + 16 * it2 + l15, 32 + 8 * quad), bb = lds_frag(QT, 40, 16 * jt2 + l15, 8 * quad);
        f32x4 z = {0.f, 0.f, 0.f, 0.f}; f32x4 r4 = mfma16(a, bb, z); r4 = -r4;
#pragma unroll
        for (int r = 0; r < 4; ++r) Tr[(32 + 16 * it2 + 4 * quad + r) * LDP + 16 * jt2 + l15] = (bf16_t)f2bf(r4[r]);
        *(LDSQ u32x2*)(Tt + (16 * jt2 + l15) * LDP + 32 + 16 * it2 + 4 * quad) = pack4(r4); }
    SYNC();
#pragma unroll 1
    for (int jj = 0; jj < 4; ++jj) { const int job = wave * 4 + jj, type = job >> 4, it = (job & 15) >> 2, nt = job & 3;
        f32x4 acc = {0.f, 0.f, 0.f, 0.f};
#pragma unroll
        for (int s = 0; s < 2; ++s) { const bf16x8 a = lds_frag(Tr, LDP, 16 * it + l15, 32 * s + 8 * quad), bb = lds_frag(type ? KbgT : VbT, LDP, 16 * nt + l15, 32 * s + 8 * quad);
            acc = mfma16(a, bb, acc); }
        if (type == 0) *(u32x2*)(gUt + (16 * nt + l15) * 64 + 16 * it + 4 * quad) = pack4(acc);
        else {
#pragma unroll
            for (int r = 0; r < 4; ++r) Wm[(16 * it + 4 * quad + r) * LDP + inv_perm(16 * nt + l15)] = (bf16_t)f2bf(acc[r]); } }
    SYNC();
    { const int r = C.tid >> 3, c8 = (C.tid & 7) * 8;
        *(u32x4*)(gWm + r * 64 + c8) = *(const LDSQ u32x4*)(Wm + r * LDP + c8);
        *(u32x4*)(gAm + r * 64 + c8) = *(const LDSQ u32x4*)(Am + r * LDP + c8);
        *(u32x4*)(gKDt + r * 64 + c8) = *(const LDSQ u32x4*)(KDt + r * LDP + c8);
        if (C.tid == 0) WSP(float, WS_GSC)[item] = EXPF(glast); }
    SYNC();
}

constexpr int SB_RING = 0, SB_RBUF = 40960, SB_Z = 122880, SB_ZBUF = 8192, SB_O = 139264, SB_OBUF = 9216, SB_DEC = 157696, SB_END = 158080;
DEVFN int sw_off(int row, int col) { return row * 64 + ((((col >> 3) ^ row) & 7) << 3) + (col & 7); }
DEVFN bf16x8 sw_frag(const LDSQ bf16_t* base, int row, int col) { return *(const LDSQ bf16x8*)(base + sw_off(row, col)); }
DEVFN void scan_dma_chunk(const unsigned char* cbase, LDSQ unsigned char* rbuf, int w, int lane) {
    const int row = 8 * w + (lane >> 3), c = (lane & 7) ^ (lane >> 3);
#pragma unroll
    for (int j = 0; j < 5; ++j) DMA16(cbase + j * 8192 + row * 128 + c * 16, rbuf + j * 8192 + w * 1024, lane);
}
DEVFN void scan_dma_z(const bf16_t* Uz, int n, LDSQ unsigned char* zbuf, int rg, int lane) {
    const int row = 8 * rg + (lane >> 3), c = (lane & 7) ^ (lane >> 3);
    DMA16((const unsigned char*)(Uz + (size_t)(64 * n + row) * NU) + c * 16, zbuf + rg * 1024, lane);
}
DEVFN void scan_epi(const Ctx& C, const bf16_t* Uz, LDSQ unsigned char* zbuf, const LDSQ bf16_t* obuf, const LDSQ float* nw, int b, int h, int n, bool next_z, int lw, int lane) {
    const int row = 16 * lw + (lane >> 2), c0 = 16 * (lane & 3); float o[16], zf[16]; float ss = 0.f;
    unpack8(*(const LDSQ u32x4*)(obuf + row * LDP + c0), o); unpack8(*(const LDSQ u32x4*)(obuf + row * LDP + c0 + 8), o + 8);
    unpack8(*(const LDSQ u32x4*)((const LDSQ bf16_t*)zbuf + sw_off(row, c0)), zf); unpack8(*(const LDSQ u32x4*)((const LDSQ bf16_t*)zbuf + sw_off(row, c0 + 8)), zf + 8);
    WAVE_LDS_FENCE();
    if (next_z) { scan_dma_z(Uz, n + 2, zbuf, 2 * lw, lane); scan_dma_z(Uz, n + 2, zbuf, 2 * lw + 1, lane); }
#pragma unroll
    for (int e = 0; e < 16; ++e) ss += o[e] * o[e];
    ss += shfl_xor_f(ss, 1); ss += shfl_xor_f(ss, 2);
    const float rstd = RSQF(ss * (1.f / 64.f) + 1e-6f);
#pragma unroll
    for (int e = 0; e < 16; ++e) o[e] = o[e] * rstd * nw[e] * silu_f(zf[e]);
    bf16_t* mp = WSP(bf16_t, WS_MIX) + ((size_t)b * 2048 + 64 * n + row) * 1024 + 256 + h * 64 + c0;
    *(u32x4*)mp = pack8(o); *(u32x4*)(mp + 8) = pack8(o + 8);
}
DEVFN void scan_compute(const LDSQ unsigned char* rbuf, LDSQ bf16_t* obuf, f32x4 (&S)[4], float dec, int w, int quad, int l15) {
    const LDSQ bf16_t* Wm = (const LDSQ bf16_t*)rbuf; const LDSQ bf16_t* QG = Wm + 4096; const LDSQ bf16_t* Am = Wm + 2 * 4096; const LDSQ bf16_t* KD = Wm + 3 * 4096; const LDSQ bf16_t* Ut = Wm + 4 * 4096;
    const bf16x8 bS0 = acc_pair_frag(S[0], S[1]), bS1 = acc_pair_frag(S[2], S[3]);
    f32x4 vn[4];
#pragma unroll
    for (int it = 0; it < 4; ++it) { f32x4 acc = {0.f, 0.f, 0.f, 0.f};
        acc = mfma16(sw_frag(Wm, 16 * it + l15, 8 * quad), bS0, acc); acc = mfma16(sw_frag(Wm, 16 * it + l15, 32 + 8 * quad), bS1, acc);
        const u32x2 u2 = *(const LDSQ u32x2*)(Ut + sw_off(16 * w + l15, 16 * it + 4 * quad));
        vn[it] = (f32x4){bf_lo(u2.x), bf_hi(u2.x), bf_lo(u2.y), bf_hi(u2.y)} - acc; }
    const bf16x8 bV0 = acc_pair_frag(vn[0], vn[1]), bV1 = acc_pair_frag(vn[2], vn[3]);
#pragma unroll
    for (int kt = 0; kt < 4; ++kt) { f32x4 acc = S[kt] * dec;
        acc = mfma16(sw_frag(KD, 16 * kt + l15, 8 * quad), bV0, acc); acc = mfma16(sw_frag(KD, 16 * kt + l15, 32 + 8 * quad), bV1, acc);
        S[kt] = acc; }
#pragma unroll
    for (int it = 0; it < 4; ++it) { f32x4 acc = {0.f, 0.f, 0.f, 0.f};
        acc = mfma16(sw_frag(QG, 16 * it + l15, 8 * quad), bS0, acc); acc = mfma16(sw_frag(QG, 16 * it + l15, 32 + 8 * quad), bS1, acc);
        acc = mfma16(sw_frag(Am, 16 * it + l15, 8 * quad), bV0, acc); acc = mfma16(sw_frag(Am, 16 * it + l15, 32 + 8 * quad), bV1, acc);
#pragma unroll
        for (int r = 0; r < 4; ++r) obuf[(16 * it + 4 * quad + r) * LDP + 16 * w + l15] = (bf16_t)f2bf(acc[r]); }
}
DEVFN void gdn_scan_unit(const Ctx& C, int l, int unit) {
    const int b = unit / 6, h = unit % 6;
    const int lane = C.lane, quad = lane >> 4, l15 = lane & 15, w = C.wave;
    const bf16_t* Uz = WSP(bf16_t, WS_U) + (size_t)b * 2048 * NU + UC_BZ + h * 64;
    const unsigned char* g0 = C.wsp + WS_GDN + (size_t)unit * 32 * GDN_CHUNK_BYTES;
    LDSQ unsigned char* R0 = C.lds + SB_RING; LDSQ unsigned char* Z0 = C.lds + SB_Z; LDSQ bf16_t* O0 = (LDSQ bf16_t*)(C.lds + SB_O); LDSQ float* decl = (LDSQ float*)(C.lds + SB_DEC);
    const bool comp = w < 4; const int lw = w & 3, lt = C.tid & 255;
    f32x4 S[4];
#pragma unroll
    for (int kt = 0; kt < 4; ++kt) S[kt] = (f32x4){0.f, 0.f, 0.f, 0.f};
    LDSQ float* nwl = decl + 32; const LDSQ float* nw = nwl + 16 * (lane & 3);
    if (!comp) { if (lt < 32) decl[lt] = WSP(float, WS_GSC)[unit * 32 + lt]; else if (lt < 96) nwl[lt - 32] = C.gdn_norm_w[l * 64 + lt - 32]; }
    VM_DRAIN();
    scan_dma_chunk(g0, R0, w, lane); scan_dma_chunk(g0 + GDN_CHUNK_BYTES, R0 + SB_RBUF, w, lane);
    if (!comp) { scan_dma_z(Uz, 0, Z0, 2 * lw, lane); scan_dma_z(Uz, 0, Z0, 2 * lw + 1, lane); }
    VM_DRAIN(); RAW_SYNC();
#pragma unroll 1
    for (int n = 0; n < 32; ++n) {
        const bool more = n + 2 < 32;
        if (more) scan_dma_chunk(g0 + (size_t)(n + 2) * GDN_CHUNK_BYTES, R0 + ((n + 2) % 3) * SB_RBUF, w, lane);
        if (comp) { scan_compute(R0 + (n % 3) * SB_RBUF, O0 + (n & 1) * (SB_OBUF / 2), S, decl[n], w, quad, l15);
            if (more) VM_WAIT_N(5); else VM_DRAIN(); }
        else { if (n > 0) scan_epi(C, Uz, Z0 + ((n - 1) & 1) * SB_ZBUF, O0 + ((n - 1) & 1) * (SB_OBUF / 2), nw, b, h, n - 1, n + 1 < 32, lw, lane);
            else { scan_dma_z(Uz, 1, Z0 + SB_ZBUF, 2 * lw, lane); scan_dma_z(Uz, 1, Z0 + SB_ZBUF, 2 * lw + 1, lane); }
            if (more) VM_WAIT_N(9); else VM_DRAIN(); }
        RAW_SYNC();
    }
    if (!comp) scan_epi(C, Uz, Z0 + SB_ZBUF, O0 + SB_OBUF / 2, nw, b, h, 31, false, lw, lane);
    else { float* og = C.outp + O_GP + ((size_t)(l * NBP + b) * 6 + h) * 4096;
#pragma unroll
        for (int kt = 0; kt < 4; ++kt)
#pragma unroll
            for (int r = 0; r < 4; ++r) og[(16 * kt + 4 * quad + r) * 64 + 16 * w + l15] = S[kt][r]; }
    SYNC();
}

DEVFN void gdn_sample_item(const Ctx& C, int l, int witem, LDSQ float* kq) {
    const int b = witem / 6, h = witem % 6, d = C.lane, m0 = M_P + 4 * b;
    const bf16_t* U = WSP(bf16_t, WS_U); bf16_t* MIX = WSP(bf16_t, WS_MIX); const float* AB = WSP(float, WS_AB);
    float qv[4], kv[4], vv[4];
    {
        float xp[3][7];
#pragma unroll
        for (int c = 0; c < 3; ++c) { const int ch = c * 384 + h * 64 + d;
#pragma unroll
            for (int j = 0; j < 3; ++j) xp[c][j] = C.st_conv_b[((size_t)(l * NBS + b) * 3 + j) * 1152 + ch];
#pragma unroll
            for (int i = 0; i < 4; ++i) xp[c][3 + i] = bf2f(U[(size_t)(m0 + i) * NU + (c == 0 ? UC_BQ : c == 1 ? UC_BK : UC_BV) + h * 64 + d]);
#pragma unroll
            for (int j = 0; j < 3; ++j) C.outp[O_CBS + ((size_t)(l * NBS + b) * 3 + j) * 1152 + ch] = xp[c][4 + j];
            float wt[4];
#pragma unroll
            for (int j = 0; j < 4; ++j) wt[j] = C.conv_b_w[(size_t)(l * 4 + j) * 1152 + ch];
#pragma unroll
            for (int i = 0; i < 4; ++i) { const float y = silu_f(wt[0] * xp[c][i] + wt[1] * xp[c][i + 1] + wt[2] * xp[c][i + 2] + wt[3] * xp[c][i + 3]);
                if (c == 0) qv[i] = y; else if (c == 1) kv[i] = y; else vv[i] = y; } }
    }
#pragma unroll
    for (int i = 0; i < 4; ++i) { const float sq = wave_sum(qv[i] * qv[i]), sk = wave_sum(kv[i] * kv[i]); qv[i] *= 0.125f * RSQF(sq + 1e-6f); kv[i] *= RSQF(sk + 1e-6f); }
    float S[64];
    const float* s0 = C.st_gdn + ((size_t)(l * NBS + b) * 6 + h) * 4096 + d;
#pragma unroll
    for (int dk = 0; dk < 64; ++dk) S[dk] = s0[dk * 64];
    const float alog = -EXPF(C.a_log[l * 6 + h]), dtb = C.dt_bias[l * 6 + h], nw = C.gdn_norm_w[l * 64 + d];
#pragma unroll 1
    for (int i = 0; i < 4; ++i) {
        const float g = alog * softplus_f(AB[(size_t)(m0 + i) * 16 + h] + dtb), beta = sigmoid_f(AB[(size_t)(m0 + i) * 16 + 6 + h]);
        const float eg = EXPF(g);
        float qi = qv[0], ki = kv[0], vi = vv[0];
#pragma unroll
        for (int j = 1; j < 4; ++j) { qi = (i == j) ? qv[j] : qi; ki = (i == j) ? kv[j] : ki; vi = (i == j) ? vv[j] : vi; }
        WAVE_LDS_FENCE();
        kq[d] = ki; kq[64 + d] = qi;
        WAVE_LDS_FENCE();
        float ks0 = 0.f, ks1 = 0.f, ks2 = 0.f, ks3 = 0.f;
#pragma unroll
        for (int d0 = 0; d0 < 64; d0 += 4) { const f32x4 ka = *(const LDSQ f32x4*)(kq + d0);
            ks0 = FMA_OP(ka.x, S[d0], ks0); ks1 = FMA_OP(ka.y, S[d0 + 1], ks1); ks2 = FMA_OP(ka.z, S[d0 + 2], ks2); ks3 = FMA_OP(ka.w, S[d0 + 3], ks3); }
        const float vn = beta * (vi - eg * ((ks0 + ks1) + (ks2 + ks3)));
        float o0 = 0.f, o1 = 0.f, o2 = 0.f, o3 = 0.f;
#pragma unroll
        for (int d0 = 0; d0 < 64; d0 += 4) { const f32x4 ka = *(const LDSQ f32x4*)(kq + d0), qa = *(const LDSQ f32x4*)(kq + 64 + d0);
            S[d0] = FMA_OP(eg, S[d0], ka.x * vn); S[d0 + 1] = FMA_OP(eg, S[d0 + 1], ka.y * vn); S[d0 + 2] = FMA_OP(eg, S[d0 + 2], ka.z * vn); S[d0 + 3] = FMA_OP(eg, S[d0 + 3], ka.w * vn);
            o0 = FMA_OP(qa.x, S[d0], o0); o1 = FMA_OP(qa.y, S[d0 + 1], o1); o2 = FMA_OP(qa.z, S[d0 + 2], o2); o3 = FMA_OP(qa.w, S[d0 + 3], o3); }
        const float o = (o0 + o1) + (o2 + o3);
        const float ssq = wave_sum(o * o); const float rstd = RSQF(ssq * (1.f / 64.f) + 1e-6f);
        const float z = bf2f(U[(size_t)(m0 + i) * NU + UC_BZ + h * 64 + d]);
        MIX[(size_t)(m0 + i) * 1024 + 256 + h * 64 + d] = (bf16_t)f2bf(o * rstd * nw * silu_f(z));
    }
    float* so = C.outp + O_GS + ((size_t)(l * NBS + b) * 6 + h) * 4096 + d;
#pragma unroll
    for (int dk = 0; dk < 64; ++dk) so[dk * 64] = S[dk];
}

constexpr int AT_K = 0  , AT_Q = 36864  , AT_VT = 55296  , VTP = 296;
DEVFN void rope8(float* x1, float* x2, const float* cs) {
#pragma unroll
    for (int e = 0; e < 8; ++e) { const float a = x1[e], bq = x2[e]; x1[e] = a * cs[e] - bq * cs[8 + e]; x2[e] = bq * cs[e] + a * cs[8 + e]; }
}
DEVFN void attn_prompt_unit(const Ctx& C, int l, int unit) {
    const int g = unit >> 8, uu = unit & 255, b = uu >> 5, h2 = (uu >> 4) & 1, rest = uu & 15;
    const int dil = g == 0 ? 1 : g == 1 ? 4 : 16, nb = g == 0 ? 16 : g == 1 ? 4 : 1, win = g == 0 ? 128 : g == 1 ? 512 : 2048;
    const int r = rest / nb, n = rest % nb, hh = 2 * g + h2;
    const int lane = C.lane, quad = lane >> 4, l15 = lane & 15, w = C.wave;
    const bf16_t* U = WSP(bf16_t, WS_U); const float* ROPE = WSP(float, WS_ROPE); bf16_t* OC = WSP(bf16_t, WS_OC); float* LSE = WSP(float, WS_LSE);
    LDSQ bf16_t* Kl = (LDSQ bf16_t*)(C.lds + AT_K); LDSQ bf16_t* Ql = (LDSQ bf16_t*)(C.lds + AT_Q); LDSQ bf16_t* VT = (LDSQ bf16_t*)(C.lds + AT_VT);
    float* kvout = C.outp + (g == 0 ? O_K128P : g == 1 ? O_K512P : O_K2048P) + (size_t)(l * NBP + b) * win * 256;
    for (int p = 0; p < 4; ++p) { const int idx = C.tid + 512 * p, kk = idx >> 3, c = idx & 7;
        const int mpos = 128 * (n - 1) + kk; const bool ok = mpos >= 0; const int t = mpos * dil + r;
        const bf16_t* ur = U + ((size_t)b * 2048 + (ok ? t : 0)) * NU + hh * 64;
        float v8[8];
        if (ok) unpack8(*(const u32x4*)(ur + UC_CV + 8 * c), v8); else {
#pragma unroll
            for (int e = 0; e < 8; ++e) v8[e] = 0.f; }
#pragma unroll
        for (int e = 0; e < 8; ++e) VT[(8 * c + e) * VTP + kk] = (bf16_t)f2bf(v8[e]);
        const bool wout = (n == nb - 1) && kk >= 128; float* orow = kvout + (size_t)(t - (2048 - win)) * 256 + h2 * 64;
        if (wout) {
#pragma unroll
            for (int e = 0; e < 8; ++e) orow[128 + 8 * c + e] = v8[e]; }
        if (c == 0) { float x1[8], x2[8];
            if (ok) { unpack8(*(const u32x4*)(ur + UC_CK), x1); unpack8(*(const u32x4*)(ur + UC_CK + 8), x2); float cs[16];
#pragma unroll
                for (int e = 0; e < 16; ++e) cs[e] = ROPE[t * 16 + e];
                rope8(x1, x2, cs); }
            else {
#pragma unroll
                for (int e = 0; e < 8; ++e) { x1[e] = 0.f; x2[e] = 0.f; } }
            *(LDSQ u32x4*)(Kl + kk * LDP) = pack8(x1); *(LDSQ u32x4*)(Kl + kk * LDP + 8) = pack8(x2);
            if (wout) {
#pragma unroll
                for (int e = 0; e < 8; ++e) { orow[e] = x1[e]; orow[8 + e] = x2[e]; } } }
        else if (c >= 2) { u32x4 kx = {0u, 0u, 0u, 0u}; if (ok) kx = *(const u32x4*)(ur + UC_CK + 8 * c);
            *(LDSQ u32x4*)(Kl + kk * LDP + 8 * c) = kx;
            if (wout) { float k8[8]; unpack8(kx, k8);
#pragma unroll
                for (int e = 0; e < 8; ++e) orow[8 * c + e] = k8[e]; } }
    }
    for (int p = 0; p < 2; ++p) { const int idx = C.tid + 512 * p, qq = idx >> 3, c = idx & 7;
        const int t = (128 * n + qq) * dil + r; const bf16_t* ur = U + ((size_t)b * 2048 + t) * NU + UC_CQ + hh * 64;
        if (c == 0) { float x1[8], x2[8], cs[16]; unpack8(*(const u32x4*)(ur), x1); unpack8(*(const u32x4*)(ur + 8), x2);
#pragma unroll
            for (int e = 0; e < 16; ++e) cs[e] = ROPE[t * 16 + e];
            rope8(x1, x2, cs);
            *(LDSQ u32x4*)(Ql + qq * LDP) = pack8(x1); *(LDSQ u32x4*)(Ql + qq * LDP + 8) = pack8(x2); }
        else if (c >= 2) *(LDSQ u32x4*)(Ql + qq * LDP + 8 * c) = *(const u32x4*)(ur + 8 * c); }
    for (int e = C.tid; e < 64 * 40; e += 512) VT[(e / 40) * VTP + 256 + (e % 40)] = 0;
    SYNC();
    const int q0 = 16 * w, qi = q0 + l15;
    f32x4 st[9]; float mx = NEG_BIG;
#pragma unroll
    for (int kt = 0; kt < 9; ++kt) { f32x4 acc = {0.f, 0.f, 0.f, 0.f};
#pragma unroll
        for (int s = 0; s < 2; ++s) acc = mfma16(lds_frag(Kl, LDP, 16 * (w + kt) + l15, 32 * s + 8 * quad), lds_frag(Ql, LDP, qi, 32 * s + 8 * quad), acc);
#pragma unroll
        for (int rr = 0; rr < 4; ++rr) { const int kj = 16 * (w + kt) + 4 * quad + rr, dist = 128 + qi - kj; const bool valid = dist >= 0 && dist <= 128 && (n > 0 || kj >= 128);
            acc[rr] = valid ? acc[rr] * 0.125f : NEG_BIG; mx = fmaxf(mx, acc[rr]); }
        st[kt] = acc; }
    mx = fmaxf(mx, shfl_xor_f(mx, 16)); mx = fmaxf(mx, shfl_xor_f(mx, 32));
    float den = 0.f;
#pragma unroll
    for (int kt = 0; kt < 9; ++kt)
#pragma unroll
        for (int rr = 0; rr < 4; ++rr) { const float p = st[kt][rr] > -1e29f ? EXPF(st[kt][rr] - mx) : 0.f; st[kt][rr] = p; den += p; }
    den += shfl_xor_f(den, 16); den += shfl_xor_f(den, 32);
    const float inv = 1.0f / den;
    const int tq = (128 * n + qi) * dil + r; const size_t mrow = (size_t)b * 2048 + tq;
#pragma unroll
    for (int dt = 0; dt < 4; ++dt) { f32x4 acc = {0.f, 0.f, 0.f, 0.f};
#pragma unroll
        for (int pr = 0; pr < 5; ++pr) { const int ta = 2 * pr, tb = 2 * pr + 1;
            const u32x2 plo = pack4(st[ta]); u32x2 phi = {0u, 0u}; if (tb < 9) phi = pack4(st[tb < 9 ? tb : 8]);
            const u32x4 bu = {plo.x, plo.y, phi.x, phi.y};
            const LDSQ bf16_t* vr = VT + (16 * dt + l15) * VTP + 4 * quad;
            const u32x2 alo = *(const LDSQ u32x2*)(vr + 16 * (w + ta)), ahi = *(const LDSQ u32x2*)(vr + 16 * (w + tb));
            const u32x4 au = {alo.x, alo.y, ahi.x, ahi.y};
            acc = mfma16(__builtin_bit_cast(bf16x8, au), __builtin_bit_cast(bf16x8, bu), acc); }
        *(u32x2*)(OC + mrow * 384 + hh * 64 + 16 * dt + 4 * quad) = pack4(acc * inv); }
    if (quad == 0) LSE[mrow * 8 + hh] = mx + LOGF(den);
    SYNC();
}

constexpr int AS_NEW = 0  , AS_Q = 12288  , AS_CMB = 18432  , AS_O = 55296  , AS_L = 61440  ;
DEVFN void attn_sample_b(const Ctx& C, int l, int b) {
    const bf16_t* U = WSP(bf16_t, WS_U); const float* ROPE = WSP(float, WS_ROPE); bf16_t* MIX = WSP(bf16_t, WS_MIX);
    LDSQ float* NEW = (LDSQ float*)(C.lds + AS_NEW); LDSQ float* Qs = (LDSQ float*)(C.lds + AS_Q); LDSQ float* CMB = (LDSQ float*)(C.lds + AS_CMB);
    LDSQ float* OS = (LDSQ float*)(C.lds + AS_O); LDSQ float* LS = (LDSQ float*)(C.lds + AS_L);
    const int lane = C.lane, w = C.wave;
#pragma unroll 1
    for (int g = 0; g < 3; ++g) {
        const int i2 = C.tid >> 7, e0 = (C.tid & 127) * 2; const size_t m = M_P + 4 * b + i2; const int pos = 2048 + i2;
        float* orow = C.outp + (g == 0 ? O_K128S : g == 1 ? O_K512S : O_K2048S) + ((size_t)(l * NBS + b) * 4 + i2) * 256;
#pragma unroll
        for (int k2 = 0; k2 < 2; ++k2) { const int e = e0 + k2, kvs = e >> 7, h2 = (e >> 6) & 1, d = e & 63; const int hh = 2 * g + h2;
            const bf16_t* ur = U + m * NU + (kvs ? UC_CV : UC_CK) + hh * 64; float val = bf2f(ur[d]);
            if (!kvs && d < 16) { const int f = d & 7; const float cs = ROPE[pos * 16 + f], sn = ROPE[pos * 16 + 8 + f];
                val = d < 8 ? val * cs - bf2f(ur[d + 8]) * sn : val * cs + bf2f(ur[d - 8]) * sn; }
            NEW[(g * 4 + i2) * 256 + e] = val; orow[e] = val; }
        const int h2 = (C.tid >> 6) & 1, d = C.tid & 63, hh = 2 * g + h2; const bf16_t* ur = U + m * NU + UC_CQ + hh * 64; float val = bf2f(ur[d]);
        if (d < 16) { const int f = d & 7; const float cs = ROPE[pos * 16 + f], sn = ROPE[pos * 16 + 8 + f];
            val = d < 8 ? val * cs - bf2f(ur[d + 8]) * sn : val * cs + bf2f(ur[d - 8]) * sn; }
        Qs[(g * 4 + i2) * 128 + h2 * 64 + d] = val * 0.125f;
    }
    SYNC();
    const int i = w & 3, half = w >> 2;
#pragma unroll 1
    for (int g = 0; g < 3; ++g) {
        const int dil = g == 0 ? 1 : g == 1 ? 4 : 16, lb = g == 0 ? 128 : g == 1 ? 512 : 2048;
        const float* cache = (g == 0 ? C.kv128 : g == 1 ? C.kv512 : C.kv2048) + (size_t)(l * NBS + b) * lb * 256;
        const f32x4 q4 = *(const LDSQ f32x4*)(Qs + (g * 4 + i) * 128 + (lane & 31) * 4);
        float mrun = NEG_BIG, den = 0.f; f32x4 o4 = {0.f, 0.f, 0.f, 0.f};
        const int jn = (dil == 1) ? i + 1 : 1;
#define AS_STEP(x4) do { float part = (lane < 32) ? (q4.x * (x4).x + q4.y * (x4).y) + (q4.z * (x4).z + q4.w * (x4).w) : 0.f; \
        part += shfl_xor_f(part, 1); part += shfl_xor_f(part, 2); part += shfl_xor_f(part, 4); part += shfl_xor_f(part, 8); \
        const float s_ = shfl_f(part, lane & 31); const float mn_ = fmaxf(mrun, s_); const float sc_ = EXPF(mrun - mn_), p_ = EXPF(s_ - mn_); \
        den = den * sc_ + p_; o4 = o4 * sc_ + (x4) * p_; mrun = mn_; } while (0)
        if (half == 0) { for (int j = 0; j < jn; ++j) { const f32x4 x4 = *(const LDSQ f32x4*)(NEW + (g * 4 + i - j * dil) * 256 + lane * 4); AS_STEP(x4); } }
#undef AS_STEP
        const int j0 = half == 0 ? jn : 65, j1 = half == 0 ? 65 : 129;
        const float* rbase = cache + (size_t)(lb + i) * 256 + lane * 4; const int c16 = lane & 15, gsel = lane & 16;
#define AS_LOAD(X, jb) do { _Pragma("unroll") for (int u = 0; u < 16; ++u) { const int jj = ((jb) + u < j1) ? (jb) + u : j1 - 1; (X)[u] = *(const f32x4*)(rbase - (size_t)jj * dil * 256); } } while (0)
#define AS_BATCH(X, jb) do { float pt[16]; \
        _Pragma("unroll") for (int u = 0; u < 16; ++u) pt[u] = (q4.x * (X)[u].x + q4.y * (X)[u].y) + (q4.z * (X)[u].z + q4.w * (X)[u].w); \
        _Pragma("unroll") for (int u = 0; u < 8; ++u) { const float keep = (c16 & 8) ? pt[u + 8] : pt[u], send = (c16 & 8) ? pt[u] : pt[u + 8]; pt[u] = keep + shfl_xor_f(send, 8); } \
        _Pragma("unroll") for (int u = 0; u < 4; ++u) { const float keep = (c16 & 4) ? pt[u + 4] : pt[u], send = (c16 & 4) ? pt[u] : pt[u + 4]; pt[u] = keep + shfl_xor_f(send, 4); } \
        _Pragma("unroll") for (int u = 0; u < 2; ++u) { const float keep = (c16 & 2) ? pt[u + 2] : pt[u], send = (c16 & 2) ? pt[u] : pt[u + 2]; pt[u] = keep + shfl_xor_f(send, 2); } \
        { const float keep = (c16 & 1) ? pt[1] : pt[0], send = (c16 & 1) ? pt[0] : pt[1]; pt[0] = keep + shfl_xor_f(send, 1); } \
        const bool kval = (jb) + c16 < j1; float s_ = kval ? pt[0] : NEG_BIG; float bm = s_; \
        bm = fmaxf(bm, shfl_xor_f(bm, 1)); bm = fmaxf(bm, shfl_xor_f(bm, 2)); bm = fmaxf(bm, shfl_xor_f(bm, 4)); bm = fmaxf(bm, shfl_xor_f(bm, 8)); \
        const float mn_ = fmaxf(mrun, bm), sc_ = EXPF(mrun - mn_), p_ = kval ? EXPF(s_ - mn_) : 0.f; float bs = p_; \
        bs += shfl_xor_f(bs, 1); bs += shfl_xor_f(bs, 2); bs += shfl_xor_f(bs, 4); bs += shfl_xor_f(bs, 8); \
        den = den * sc_ + bs; mrun = mn_; const float scv = shfl_f(sc_, lane & 31); o4 = o4 * scv; \
        _Pragma("unroll") for (int u = 0; u < 16; ++u) { const float pu = shfl_f(p_, gsel + u); o4 = o4 + (X)[u] * pu; } } while (0)
        { f32x4 xa[16], xc[16];
            AS_LOAD(xa, j0);
            AS_LOAD(xc, j0 + 16); AS_BATCH(xa, j0);
            AS_LOAD(xa, j0 + 32); AS_BATCH(xc, j0 + 16);
            AS_LOAD(xc, j0 + 48); AS_BATCH(xa, j0 + 32);
            AS_BATCH(xc, j0 + 48); }
#undef AS_LOAD
#undef AS_BATCH
        mrun = shfl_f(mrun, lane & 31); den = shfl_f(den, lane & 31);
        { LDSQ float* cm = CMB + ((g * 8 + w) * 64 + lane) * 6; cm[0] = mrun; cm[1] = den; cm[2] = o4.x; cm[3] = o4.y; cm[4] = o4.z; cm[5] = o4.w; }
    }
    SYNC();
    if (half == 0 && lane >= 32) {
#pragma unroll 1
        for (int g = 0; g < 3; ++g) { const LDSQ float* c1 = CMB + ((g * 8 + w) * 64 + lane) * 6; const LDSQ float* c2 = CMB + ((g * 8 + w + 4) * 64 + lane) * 6;
            const float m1 = c1[0], d1 = c1[1], m2 = c2[0], d2 = c2[1]; const f32x4 o1 = {c1[2], c1[3], c1[4], c1[5]}, o2 = {c2[2], c2[3], c2[4], c2[5]};
            const float mm = fmaxf(m1, m2), a1 = EXPF(m1 - mm), a2 = EXPF(m2 - mm); const float dt = d1 * a1 + d2 * a2; const f32x4 o = (o1 * a1 + o2 * a2) * (1.0f / dt);
            const int h2 = (lane >> 4) & 1, hh = 2 * g + h2;
            *(LDSQ f32x4*)(OS + i * 384 + hh * 64 + (lane & 15) * 4) = o; if ((lane & 15) == 0) LS[i * 6 + hh] = mm + LOGF(dt); } }
    SYNC();
    for (int p = 0; p < 3; ++p) { const int idx = C.tid + 512 * p, i2 = idx / 384, c = idx % 384, hh = c >> 6, g = hh >> 1, hp = hh & 1; const size_t m = M_P + 4 * b + i2;
        const float l0 = LS[i2 * 6 + hp], l1 = LS[i2 * 6 + 2 + hp], l2 = LS[i2 * 6 + 4 + hp]; const float mx = fmaxf(l0, fmaxf(l1, l2));
        const float e0 = EXPF(l0 - mx), e1 = EXPF(l1 - mx), e2 = EXPF(l2 - mx); const float alpha = (g == 0 ? e0 : g == 1 ? e1 : e2) / (e0 + e1 + e2);
        const float z = bf2f(U[m * NU + UC_CZ + c]);
        MIX[m * 1024 + 640 + c] = (bf16_t)f2bf(OS[i2 * 384 + c] * alpha * silu_f(z)); }
    SYNC();
}

DEVFN void merge_item(const Ctx& C, int item) {
    const bf16_t* U = WSP(bf16_t, WS_U); const bf16_t* OC = WSP(bf16_t, WS_OC); const float* LSE = WSP(float, WS_LSE); bf16_t* MIX = WSP(bf16_t, WS_MIX);
    for (int p = 0; p < 3; ++p) { const int idx = C.tid + 512 * p, rl = idx / 48, c = idx % 48; const size_t m = (size_t)item * 32 + rl;
        const int hh = c >> 3, g = hh >> 1, hp = hh & 1;
        const float l0 = LSE[m * 8 + hp], l1 = LSE[m * 8 + 2 + hp], l2 = LSE[m * 8 + 4 + hp]; const float mx = fmaxf(l0, fmaxf(l1, l2));
        const float e0 = EXPF(l0 - mx), e1 = EXPF(l1 - mx), e2 = EXPF(l2 - mx); const float alpha = (g == 0 ? e0 : g == 1 ? e1 : e2) / (e0 + e1 + e2);
        float o[8], z[8]; unpack8(*(const u32x4*)(OC + m * 384 + 8 * c), o); unpack8(*(const u32x4*)(U + m * NU + UC_CZ + 8 * c), z);
#pragma unroll
        for (int e = 0; e < 8; ++e) o[e] = o[e] * alpha * silu_f(z[e]);
        *(u32x4*)(MIX + m * 1024 + 640 + 8 * c) = pack8(o); }
}

constexpr int N_PREP = 1536, N_ATTP = 768, N_ATTS = 128, N_CONVA = 264;
#ifndef DBL
#define DBL 0
#endif
DEVFN void phase_mid(const Ctx& C0, int l, bool second = false) {
    if (!second || DBL == 3 || DBL == 4) { const Ctx C = relaunder(C0);
        if (C.ncu == 256) { const int xcd = C.cu >> 5, j = C.cu & 31; for (int k = 0; k < 6; ++k) gdn_prep_item(C, l, (xcd + 8 * k) * 32 + j); }
        else for (int it = C.cu; it < N_PREP; it += C.ncu) gdn_prep_item(C, l, it); }
    if (!second || DBL == 3 || DBL == 5) { const Ctx C = relaunder(C0); for (int it = C.cu; it < N_ATTP; it += C.ncu) attn_prompt_unit(C, l, it); }
}
constexpr int N_SCAN = 48, N_GS = 96, N_MERGE = 512;
#define QUEUE_LOOP(qword, total, body) do { for (;;) { const Ctx C = relaunder(C0);        \
        if (C.tid == 0) *(volatile LDSQ int*)(C.lds + LDS_QIDX) = (int)QUEUE_PULL(qword); SYNC(); const int it = *(volatile LDSQ int*)(C.lds + LDS_QIDX); SYNC(); \
        if (it >= (total)) break; body; } } while (0)
DEVFN void phase_scan(const Ctx& C0, int l, bool second = false) {
    const bool split = C0.ncu > N_SCAN;
    const bool xl = C0.ncu == 256; const bool is_scan = xl ? (C0.cu & 31) < 6 : (C0.cu < N_SCAN || !split);
    if (is_scan && (!second || DBL == 8 || DBL == 9)) { const Ctx C = relaunder(C0);
        if (xl) gdn_scan_unit(C, l, (C.cu >> 5) + 8 * (C.cu & 31)); else for (int u = C.cu; u < N_SCAN; u += C.ncu) gdn_scan_unit(C, l, u); }
    if ((xl ? !is_scan : (C0.cu >= N_SCAN || !split)) && (!second || DBL == 8 || DBL == 10 || (DBL >= 15 && DBL <= 18))) { unsigned* qw = (unsigned*)(C0.wsp + WS_CTL) + CW_QUEUE + (l * 2 + (second ? 1 : 0)) * 4 * 64;
        if (!second || DBL == 8 || DBL == 10 || DBL == 15) QUEUE_LOOP(qw, N_ATTS, attn_sample_b(C, l, it));
        if (!second || DBL == 8 || DBL == 10 || DBL == 16) QUEUE_LOOP(qw + 64, N_GS, gdn_sample_item(C, l, it * 8 + C.wave, (LDSQ float*)(C.lds + C.wave * 512)));
        if (!second || DBL == 8 || DBL == 10 || DBL == 17) QUEUE_LOOP(qw + 128, N_CONVA, conv_a_item(C, l, it));
        if (!second || DBL == 8 || DBL == 10 || DBL == 18) QUEUE_LOOP(qw + 192, N_MERGE, merge_item(C, it)); }
}
constexpr int SG_A = 0  , SG_B = 18432  ;
struct SEpiU { bf16_t* U;
    DEVMFN void operator()(int row, int col, f32x4 v) const { *(u32x2*)(U + (size_t)(M_P + row) * NU + col) = pack4(v); } };
struct SEpiRes { const float* base; float* X; const float* gate0;
    DEVMFN void operator()(int row, int col, f32x4 v) const { const f32x4 bv = *(const f32x4*)(base + (size_t)row * 1024 + col), gv = *(const f32x4*)(gate0 + (size_t)(NBP + (row >> 2)) * NMOD + col);
        *(f32x4*)(X + (size_t)(M_P + row) * 1024 + col) = bv + (gv + 1.0f) * v; } };
template <class Epi> DEVFN void sgemm_unit(const Ctx& C, const bf16_t* A, const bf16_t* Bt, int tm, int tn, const Epi& E) {
    const int lane = C.lane, quad = lane >> 4, l15 = lane & 15, w = C.wave, wm = w & 1, wn = w >> 1;
    const int lr = C.tid >> 3, c8 = (C.tid & 7) * 8;
    const bf16_t* ga = A + (size_t)(64 * tm + lr) * 1024 + c8; const bf16_t* gb0 = Bt + (size_t)(128 * tn + lr) * 1024 + c8; const bf16_t* gb1 = gb0 + (size_t)64 * 1024;
    LDSQ bf16_t* As = (LDSQ bf16_t*)(C.lds + SG_A); LDSQ bf16_t* Bs = (LDSQ bf16_t*)(C.lds + SG_B);
    f32x4 acc[2][2];
#pragma unroll
    for (int mi = 0; mi < 2; ++mi)
#pragma unroll
        for (int ni = 0; ni < 2; ++ni) acc[mi][ni] = (f32x4){0.f, 0.f, 0.f, 0.f};
    u32x4 ra = *(const u32x4*)ga, rb0 = *(const u32x4*)gb0, rb1 = *(const u32x4*)gb1;
    *(LDSQ u32x4*)(As + lr * LDP + c8) = ra; *(LDSQ u32x4*)(Bs + lr * LDP + c8) = rb0; *(LDSQ u32x4*)(Bs + (64 + lr) * LDP + c8) = rb1;
    ra = *(const u32x4*)(ga + 64); rb0 = *(const u32x4*)(gb0 + 64); rb1 = *(const u32x4*)(gb1 + 64);
    SYNC();
#pragma unroll 1
    for (int c = 0; c < 16; ++c) {
        LDSQ bf16_t* Ac = As + (c & 1) * 4608; LDSQ bf16_t* Bc = Bs + (c & 1) * 9216;
        if (c + 1 < 16) { LDSQ bf16_t* An = As + ((c + 1) & 1) * 4608; LDSQ bf16_t* Bn = Bs + ((c + 1) & 1) * 9216;
            *(LDSQ u32x4*)(An + lr * LDP + c8) = ra; *(LDSQ u32x4*)(Bn + lr * LDP + c8) = rb0; *(LDSQ u32x4*)(Bn + (64 + lr) * LDP + c8) = rb1; }
        if (c + 2 < 16) { ra = *(const u32x4*)(ga + 64 * (c + 2)); rb0 = *(const u32x4*)(gb0 + 64 * (c + 2)); rb1 = *(const u32x4*)(gb1 + 64 * (c + 2)); }
#pragma unroll
        for (int s = 0; s < 2; ++s) { bf16x8 af[2], bfr[2];
#pragma unroll
            for (int mi = 0; mi < 2; ++mi) af[mi] = lds_frag(Ac, LDP, 32 * wm + 16 * mi + l15, 32 * s + 8 * quad);
#pragma unroll
            for (int ni = 0; ni < 2; ++ni) bfr[ni] = lds_frag(Bc, LDP, 32 * wn + 16 * ni + l15, 32 * s + 8 * quad);
#pragma unroll
            for (int mi = 0; mi < 2; ++mi)
#pragma unroll
                for (int ni = 0; ni < 2; ++ni) acc[mi][ni] = mfma16(bfr[ni], af[mi], acc[mi][ni]); }
        SYNC();
    }
#pragma unroll
    for (int mi = 0; mi < 2; ++mi)
#pragma unroll
        for (int ni = 0; ni < 2; ++ni) E(64 * tm + 32 * wm + 16 * mi + l15, 128 * tn + 32 * wn + 16 * ni + 4 * quad, acc[mi][ni]);
}
constexpr int NWAVES = 8;
constexpr int RING_BYTES = LDS_MISC, MISC_OFF = RING_BYTES + 320, LDS_BYTES = 159744;
constexpr int CW_BAR = 4096;
#ifndef DBL
#define DBL 0
#endif
#define GRID_BAR() xcd_barrier(bar)

__device__ __forceinline__ Ctx fresh_ctx(const Args* ap, LDSQ unsigned char* lds) {
    Ctx C; int tid = threadIdx.x; asm volatile("" : "+v"(tid));
    C.tid = tid; C.lane = tid & 63; C.wave = __builtin_amdgcn_readfirstlane(tid >> 6);
    C.ncu = gridDim.x; { const int bx = blockIdx.x; C.cu = (C.ncu % 8 == 0) ? (bx % 8) * (C.ncu / 8) + bx / 8 : bx; }
    C.lds = lds; C.a = ap; return C;
}
template <int L> __device__ __forceinline__ void layer_body(const Args* ap, LDSQ unsigned char* lds, const XcdBarrier& bar) {
        { const Ctx C = fresh_ctx(ap, lds); phase_norm(C, L); }
#if DBL == 1
        GRID_BAR(); { const Ctx C = fresh_ctx(ap, lds); phase_norm(C, L); }
#endif
        GRID_BAR();
        { const Ctx C = fresh_ctx(ap, lds);
            { const SEpiU SE{WSP(bf16_t, WS_U)};
                for (int u = C.cu; u < 256; u += C.ncu) sgemm_unit(C, WSP(bf16_t, WS_HN) + (size_t)M_P * 1024, WSP(bf16_t, WS_WIN) + (size_t)L * 4096 * 1024, u & 7, u >> 3, SE); }
            pg8::Gemm g{WSP(bf16_t, WS_HN), WSP(bf16_t, WS_WIN) + (size_t)L * 4096 * 1024, M_P, NU, 1024}; pg8::StaticOrder S; S.init(M_P, NU, C.ncu, (int)blockIdx.x);
            pg8::EpiU E{WSP(bf16_t, WS_U), NU};
            pg8::gemm_phase<pg8::EpiU, pg8::StaticOrder, true, true>(C.lds, g, S, E);
#if DBL == 2
            GRID_BAR(); pg8::gemm_phase<pg8::EpiU, pg8::StaticOrder, true, true>(C.lds, g, S, E);
#endif
        }
        GRID_BAR();
        { const Ctx C = fresh_ctx(ap, lds); phase_mid(C, L); }
#if DBL >= 3 && DBL <= 7
        GRID_BAR(); { const Ctx C = fresh_ctx(ap, lds); phase_mid(C, L, true); }
#endif
        GRID_BAR();
        { const Ctx C = fresh_ctx(ap, lds); phase_scan(C, L); }
#if (DBL >= 8 && DBL <= 10) || (DBL >= 15 && DBL <= 18)
        GRID_BAR(); { const Ctx C = fresh_ctx(ap, lds); phase_scan(C, L, true); }
#endif
        GRID_BAR();
        { const Ctx C = fresh_ctx(ap, lds);
            const float* X = WSP(float, WS_X);
            { const SEpiRes SE{L == 0 ? C.x_sample : X + (size_t)M_P * 1024, WSP(float, WS_X), WSP(float, WS_MOD) + L * 3072 + 2048};
                for (int u = C.ncu - 1 - C.cu; u < 64; u += C.ncu) sgemm_unit(C, WSP(bf16_t, WS_MIX) + (size_t)M_P * 1024, WSP(bf16_t, WS_WOUT) + (size_t)L * 1024 * 1024, u & 7, u >> 3, SE); }
            pg8::Gemm g{WSP(bf16_t, WS_MIX), WSP(bf16_t, WS_WOUT) + (size_t)L * 1024 * 1024, M_P, 1024, 1024}; pg8::StaticOrder S; S.init(M_P, 1024, C.ncu, (int)blockIdx.x);
            pg8::EpiRes E{L == 0 ? C.x_prompt : X, L == 0 ? C.x_sample : X + (size_t)M_P * 1024, WSP(float, WS_X), WSP(float, WS_MOD) + L * 3072 + 2048};
#if DBL == 13
            { pg8::EpiRes E2 = E; E2.X = WSP(float, WS_U); pg8::gemm_phase<pg8::EpiRes, pg8::StaticOrder, true, true>(C.lds, g, S, E2); GRID_BAR(); }
#endif
            pg8::gemm_phase<pg8::EpiRes, pg8::StaticOrder, true, true>(C.lds, g, S, E);
        }
        GRID_BAR();
    }

__global__ void __launch_bounds__(NWAVES * 64, 2) mega_fwd(Args args) {
    extern __shared__ __attribute__((aligned(16))) unsigned char lds_raw[];
    Ctx C;
    C.lds = (LDSQ unsigned char*)lds_raw;
    C.tid = threadIdx.x; C.lane = C.tid & 63; C.wave = __builtin_amdgcn_readfirstlane(C.tid >> 6);
    C.ncu = gridDim.x; { const int bx = blockIdx.x; C.cu = (C.ncu % 8 == 0) ? (bx % 8) * (C.ncu / 8) + bx / 8 : bx; }
    C.a = &args;
    volatile LDSQ unsigned* MISC = (volatile LDSQ unsigned*)(C.lds + MISC_OFF);
    for (int u = C.tid; u < (LDS_BYTES - RING_BYTES) / 4; u += NWAVES * 64) ((LDSQ unsigned*)(C.lds + RING_BYTES))[u] = 0u;
    __syncthreads();
    unsigned* ctl = (unsigned*)(C.wsp + WS_CTL);
    XcdBarrier bar = xcd_barrier_post(ctl + CW_BAR, MISC + 8);

    phase_p0a(C);
#if DBL == 11
    GRID_BAR(); phase_p0a(C);
#endif
    GRID_BAR();
    layer_body<0>(&args, C.lds, bar); layer_body<1>(&args, C.lds, bar); layer_body<2>(&args, C.lds, bar); layer_body<3>(&args, C.lds, bar);
    { const Ctx C2 = fresh_ctx(&args, C.lds); phase_final(C2); }
#if DBL == 14
    { const Ctx C2 = fresh_ctx(&args, C.lds); phase_final(C2); }
#endif
}

extern "C" void kernel_launch(void* const* d_in, const int* in_sizes, int n_in, void* d_out, int out_size, void* d_ws, size_t ws_size, hipStream_t stream) {
    static int grid = 0;
    if (grid == 0) {
        if (n_in != 23 || out_size != (int)O_END || ws_size < WS_END) { fprintf(stderr, "kernel_launch: unexpected shapes: n_in %d out %d ws %zu\n", n_in, out_size, ws_size); grid = -1; return; }
        int dev = 0, cus = 0, per_cu = 0;
        if (hipGetDevice(&dev) != hipSuccess || hipDeviceGetAttribute(&cus, hipDeviceAttributeMultiprocessorCount, dev) != hipSuccess) { grid = -1; return; }
        if (hipFuncSetAttribute((const void*)mega_fwd, hipFuncAttributeMaxDynamicSharedMemorySize, LDS_BYTES) != hipSuccess) { fprintf(stderr, "kernel_launch: hipFuncSetAttribute failed\n"); grid = -1; return; }
        if (hipOccupancyMaxActiveBlocksPerMultiprocessor(&per_cu, (const void*)mega_fwd, NWAVES * 64, LDS_BYTES) != hipSuccess || per_cu < 1) { fprintf(stderr, "kernel_launch: occupancy query says %d\n", per_cu); }
        (void)hipGetLastError();
        grid = cus;
    }
    if (grid < 0) return;
    if (hipMemsetAsync((char*)d_ws + WS_CTL, 0, CTL_ZERO_BYTES, stream) != hipSuccess) return;
    Args ha{};
    for (int i = 0; i < 23; ++i) ha.in[i] = (const float*)d_in[i];
    ha.out_ = (float*)d_out; ha.ws_ = (unsigned char*)d_ws;
    hipLaunchKernelGGL(mega_fwd, dim3(grid), dim3(NWAVES * 64), LDS_BYTES, stream, ha);
}
```
